# Optimizing an MI355X kernel written in HIP

```python
import math
import jax
import jax.numpy as jnp
from jax import lax
import numpy as np

D_MODEL = 1024
BATCH = 2
SEQ = 8192
DEPTH = 2

RWKV_HEADS = 8
RWKV_HEAD_DIM = 64
RWKV_DIM = RWKV_HEADS * RWKV_HEAD_DIM
DECAY_LORA = 64
AAA_LORA = 64
GATE_LORA = 128
RWKV_GN_EPS = 64e-5
MLA_HEADS = 8
QK_NOPE_DIM = 64
QK_ROPE_DIM = 32
V_HEAD_DIM = 64
Q_LORA_RANK = 256
KV_LORA_RANK = 128
MLA_DIM = MLA_HEADS * V_HEAD_DIM
ROPE_THETA = 10000.0
Q_BLOCK = 128
ATTN_SCALE = 1.0 / math.sqrt(QK_NOPE_DIM + QK_ROPE_DIM)
S5_DIM = 512
S5_GROUP = 16
S5_GROUPS = S5_DIM // S5_GROUP
S5_STATE = 64
S5_DT_MIN = 1e-3
S5_DT_MAX = 1e-1
N_BRANCHES = 3
D_FF = ((8 * D_MODEL + 3 * 256 - 1) // (3 * 256)) * 256
LN_EPS = 1e-5
RMS_EPS = 1e-6
DEEPNORM_ALPHA = (2.0 * DEPTH) ** 0.25
DEEPNORM_BETA = (8.0 * DEPTH) ** -0.25
RWKV_COLS = 3 * RWKV_DIM + DECAY_LORA + AAA_LORA + GATE_LORA
MLA_COLS = Q_LORA_RANK + KV_LORA_RANK + QK_ROPE_DIM
S5_COLS = S5_DIM
GATE_COLS = N_BRANCHES * D_MODEL
IN_COLS = RWKV_COLS + MLA_COLS + S5_COLS + GATE_COLS

kernel_name = 'hybrid_rwkv7_mla_s5_gated_block'


def layer_norm(x, g, b):
    xf = x.astype(jnp.float32)
    mu = jnp.mean(xf, -1, keepdims=True)
    var = jnp.mean(jnp.square(xf - mu), -1, keepdims=True)
    return ((xf - mu) * lax.rsqrt(var + LN_EPS) * g + b).astype(x.dtype)


def rms_norm(x, g):
    xf = x.astype(jnp.float32)
    return (xf * lax.rsqrt(jnp.mean(xf * xf, -1, keepdims=True) + RMS_EPS) * g).astype(x.dtype)


def token_shift(p):
    return jnp.pad(p, ((0, 0), (1, 0), (0, 0)))[:, :-1]


def apply_rope(x, cos, sin):
    half = x.shape[-1] // 2
    xf = x.astype(jnp.float32)
    x1, x2 = xf[..., :half], xf[..., half:]
    return jnp.concatenate([x1 * cos - x2 * sin, x2 * cos + x1 * sin], -1).astype(x.dtype)


def rwkv7_scan(r, w, k, v, a, b):
    def step(state, inp):
        r_t, w_t, k_t, v_t, a_t, b_t = inp
        sa = jnp.einsum('bhvk,bhk->bhv', state, a_t)
        state = state * w_t[:, :, None, :] + sa[..., None] * b_t[:, :, None, :] + v_t[..., None] * k_t[:, :, None, :]
        return state, jnp.einsum('bhvk,bhk->bhv', state, r_t)
    bsz, _, h, n = r.shape
    xs = tuple(jnp.swapaxes(z, 0, 1) for z in (r, w, k, v, a, b))
    s0 = jnp.zeros((bsz, h, n, n), jnp.float32)
    _, ys = lax.scan(step, s0, xs)
    return jnp.swapaxes(ys, 0, 1)


def rwkv7_time_mix(p, mu, w0, w2, a0, a2, g2, k_k, k_a, r_k, gn_g, gn_b, w_o):
    bsz, t, _ = p.shape
    f32 = jnp.float32
    p = p + (token_shift(p) - p) * mu
    c0 = RWKV_DIM
    c1 = 2 * RWKV_DIM
    c2 = 3 * RWKV_DIM
    c3 = c2 + DECAY_LORA
    c4 = c3 + AAA_LORA
    r, k, v, dw, da, dg = p[..., :c0], p[..., c0:c1], p[..., c1:c2], p[..., c2:c3], p[..., c3:c4], p[..., c4:]
    w_log = -jax.nn.softplus(-(w0 + jnp.tanh(dw) @ w2).astype(f32)) - 0.5
    decay = jnp.exp(-jnp.exp(w_log))
    a = jax.nn.sigmoid((a0 + da @ a2).astype(f32))
    g = jax.nn.sigmoid(dg) @ g2

    def heads(z):
        return z.astype(f32).reshape(bsz, t, RWKV_HEADS, RWKV_HEAD_DIM)

    r, k, v, a, decay = heads(r), heads(k), heads(v), heads(a), heads(decay)
    kk = k * k_k.astype(f32).reshape(RWKV_HEADS, RWKV_HEAD_DIM)
    kk = kk * lax.rsqrt(jnp.maximum(jnp.sum(kk * kk, -1, keepdims=True), 1e-12))
    k = k * (1.0 + (a - 1.0) * k_a.astype(f32).reshape(RWKV_HEADS, RWKV_HEAD_DIM))
    y = rwkv7_scan(r, decay, k, v, -kk, kk * a)
    m = jnp.mean(y, -1, keepdims=True)
    var = jnp.mean(jnp.square(y - m), -1, keepdims=True)
    y = ((y - m) * lax.rsqrt(var + RWKV_GN_EPS)).reshape(bsz, t, RWKV_DIM) * gn_g + gn_b
    bonus = jnp.sum(r * k * r_k.astype(f32), -1, keepdims=True) * v
    y = y + bonus.reshape(bsz, t, RWKV_DIM)
    return (y * g).astype(p.dtype) @ w_o


def causal_block_attention(q_nope, q_rope, k_nope, k_rope, v):
    bsz, t, h, _ = q_nope.shape
    nb = t // Q_BLOCK
    kpos = jnp.arange(t)

    def to_blocks(z):
        return jnp.moveaxis(z.reshape(bsz, nb, Q_BLOCK, *z.shape[2:]), 1, 0)

    def one_block(args):
        qn, qr, start = args
        s = jnp.einsum('bqhd,bkhd->bhqk', qn, k_nope) + jnp.einsum('bqhr,bkr->bhqk', qr, k_rope)
        s = s.astype(jnp.float32) * ATTN_SCALE
        qpos = start + jnp.arange(Q_BLOCK)
        s = jnp.where(kpos[None, :] <= qpos[:, None], s, jnp.finfo(jnp.float32).min)
        pr = jax.nn.softmax(s, axis=-1).astype(v.dtype)
        return jnp.einsum('bhqk,bkhd->bqhd', pr, v)

    starts = jnp.arange(nb, dtype=jnp.int32) * Q_BLOCK
    out = lax.map(one_block, (to_blocks(q_nope), to_blocks(q_rope), starts))
    return jnp.moveaxis(out, 0, 1).reshape(bsz, t, h, v.shape[-1])


def mla_branch(p, cos, sin, q_norm, q_up, kv_norm, kv_up, w_o):
    bsz, t, _ = p.shape
    c_q = p[..., :Q_LORA_RANK]
    c_kv = p[..., Q_LORA_RANK:Q_LORA_RANK + KV_LORA_RANK]
    k_r = p[..., Q_LORA_RANK + KV_LORA_RANK:]
    q = (rms_norm(c_q, q_norm) @ q_up).reshape(bsz, t, MLA_HEADS, QK_NOPE_DIM + QK_ROPE_DIM)
    kv = (rms_norm(c_kv, kv_norm) @ kv_up).reshape(bsz, t, MLA_HEADS, QK_NOPE_DIM + V_HEAD_DIM)
    q_nope = q[..., :QK_NOPE_DIM]
    q_rope = apply_rope(q[..., QK_NOPE_DIM:], cos[:, None, :], sin[:, None, :])
    k_nope, v = kv[..., :QK_NOPE_DIM], kv[..., QK_NOPE_DIM:]
    k_rope = apply_rope(k_r, cos, sin)
    o = causal_block_attention(q_nope, q_rope, k_nope, k_rope, v)
    return o.reshape(bsz, t, MLA_DIM) @ w_o


def _complex_linear_combine(e1, e2):
    a1r, a1i, b1r, b1i = e1
    a2r, a2i, b2r, b2i = e2
    return (a2r * a1r - a2i * a1i,
            a2r * a1i + a2i * a1r,
            a2r * b1r - a2i * b1i + b2r,
            a2r * b1i + a2i * b1r + b2i)


def s5_branch(u, lambda_re, lambda_im, log_step, b_re, b_im, c_re, c_im, d_skip, w_glu):
    bsz, t, _ = u.shape
    f32 = jnp.float32
    lam_re = jnp.minimum(lambda_re.astype(f32), -1e-4)
    lam_im = lambda_im.astype(f32)
    step = jnp.exp(log_step.astype(f32))[:, None]
    mag = jnp.exp(lam_re * step)
    ang = lam_im * step
    lb_re, lb_im = mag * jnp.cos(ang), mag * jnp.sin(ang)
    den = lam_re * lam_re + lam_im * lam_im
    n_re = lb_re - 1.0
    f_re = (n_re * lam_re + lb_im * lam_im) / den
    f_im = (lb_im * lam_re - n_re * lam_im) / den
    br, bi = b_re.astype(f32), b_im.astype(f32)
    bb_re = f_re[..., None] * br - f_im[..., None] * bi
    bb_im = f_re[..., None] * bi + f_im[..., None] * br
    uf = u.astype(f32)
    ug = uf.reshape(bsz, t, S5_GROUPS, S5_GROUP)
    bu_re = jnp.einsum('btgc,gpc->btgp', ug, bb_re)
    bu_im = jnp.einsum('btgc,gpc->btgp', ug, bb_im)
    a_re = jnp.broadcast_to(lb_re, bu_re.shape)
    a_im = jnp.broadcast_to(lb_im, bu_im.shape)
    _, _, s_re, s_im = lax.associative_scan(_complex_linear_combine, (a_re, a_im, bu_re, bu_im), axis=1)
    y = jnp.einsum('btgp,gcp->btgc', s_re, c_re.astype(f32)) - jnp.einsum('btgp,gcp->btgc', s_im, c_im.astype(f32))
    y = y.reshape(bsz, t, S5_DIM) + d_skip.astype(f32) * uf
    y = jax.nn.gelu(y).astype(u.dtype)
    h = y @ w_glu
    return h[..., :D_MODEL] * jax.nn.sigmoid(h[..., D_MODEL:])


def setup_inputs(seed: int = 0) -> dict:
    key = jax.random.key(seed)
    ks = iter(jax.random.split(key, 48))
    L = DEPTH
    f32 = jnp.float32

    def nrm(shape, scale):
        return jax.random.normal(next(ks), shape, f32) * scale

    n = jnp.arange(RWKV_DIM, dtype=f32) / (RWKV_DIM - 1)
    ratio = jnp.arange(L, dtype=f32) / max(L - 1, 1)
    decay_speed = -7.0 + 5.0 * n[None, :] ** (0.85 + jnp.sqrt(ratio)[:, None])
    inp = {}
    inp['x'] = nrm((BATCH, SEQ, D_MODEL), 1.0)
    inp['w_in'] = nrm((L, D_MODEL, IN_COLS), D_MODEL ** -0.5)
    inp['rwkv_mu'] = jax.random.uniform(next(ks), (L, RWKV_COLS), f32)
    inp['rwkv_w0'] = decay_speed + 0.5 + nrm((L, RWKV_DIM), 0.01)
    inp['rwkv_w2'] = nrm((L, DECAY_LORA, RWKV_DIM), 0.1 * DECAY_LORA ** -0.5)
    inp['rwkv_a0'] = nrm((L, RWKV_DIM), 0.01)
    inp['rwkv_a2'] = nrm((L, AAA_LORA, RWKV_DIM), 0.1 * AAA_LORA ** -0.5)
    inp['rwkv_g2'] = nrm((L, GATE_LORA, RWKV_DIM), GATE_LORA ** -0.5)
    inp['rwkv_k_k'] = 0.85 + nrm((L, RWKV_DIM), 0.02)
    inp['rwkv_k_a'] = 1.0 + nrm((L, RWKV_DIM), 0.02)
    inp['rwkv_r_k'] = -0.04 + nrm((L, RWKV_HEADS, RWKV_HEAD_DIM), 0.02)
    inp['rwkv_gn_g'] = 1.0 + nrm((L, RWKV_DIM), 0.02)
    inp['rwkv_gn_b'] = nrm((L, RWKV_DIM), 0.02)
    inp['rwkv_out'] = nrm((L, RWKV_DIM, D_MODEL), DEEPNORM_BETA * RWKV_DIM ** -0.5)
    inp['mla_q_norm'] = 1.0 + nrm((L, Q_LORA_RANK), 0.02)
    inp['mla_q_up'] = nrm((L, Q_LORA_RANK, MLA_HEADS * (QK_NOPE_DIM + QK_ROPE_DIM)), Q_LORA_RANK ** -0.5)
    inp['mla_kv_norm'] = 1.0 + nrm((L, KV_LORA_RANK), 0.02)
    inp['mla_kv_up'] = nrm((L, KV_LORA_RANK, MLA_HEADS * (QK_NOPE_DIM + V_HEAD_DIM)), KV_LORA_RANK ** -0.5)
    inp['mla_out'] = nrm((L, MLA_DIM, D_MODEL), DEEPNORM_BETA * MLA_DIM ** -0.5)
    inp['s5_lambda_re'] = -0.5 + nrm((L, S5_GROUPS, S5_STATE), 0.01)
    inp['s5_lambda_im'] = jnp.broadcast_to(math.pi * jnp.arange(S5_STATE, dtype=f32), (L, S5_GROUPS, S5_STATE))
    inp['s5_log_step'] = jax.random.uniform(next(ks), (L, S5_GROUPS), f32, math.log(S5_DT_MIN), math.log(S5_DT_MAX))
    inp['s5_b_re'] = nrm((L, S5_GROUPS, S5_STATE, S5_GROUP), (2 * S5_GROUP) ** -0.5)
    inp['s5_b_im'] = nrm((L, S5_GROUPS, S5_STATE, S5_GROUP), (2 * S5_GROUP) ** -0.5)
    inp['s5_c_re'] = nrm((L, S5_GROUPS, S5_GROUP, S5_STATE), S5_STATE ** -0.5)
    inp['s5_c_im'] = nrm((L, S5_GROUPS, S5_GROUP, S5_STATE), S5_STATE ** -0.5)
    inp['s5_d'] = nrm((L, S5_DIM), 1.0)
    inp['s5_glu'] = nrm((L, S5_DIM, 2 * D_MODEL), DEEPNORM_BETA * S5_DIM ** -0.5)
    inp['gate_b'] = nrm((L, N_BRANCHES, D_MODEL), 0.01)
    inp['w_out'] = nrm((L, D_MODEL, D_MODEL), DEEPNORM_BETA * D_MODEL ** -0.5)
    inp['ln1_g'] = 1.0 + nrm((L, D_MODEL), 0.02)
    inp['ln1_b'] = nrm((L, D_MODEL), 0.02)
    inp['ffn_w1'] = nrm((L, D_MODEL, D_FF), D_MODEL ** -0.5)
    inp['ffn_w3'] = nrm((L, D_MODEL, D_FF), DEEPNORM_BETA * D_MODEL ** -0.5)
    inp['ffn_w2'] = nrm((L, D_FF, D_MODEL), DEEPNORM_BETA * D_FF ** -0.5)
    inp['ln2_g'] = 1.0 + nrm((L, D_MODEL), 0.02)
    inp['ln2_b'] = nrm((L, D_MODEL), 0.02)
    return inp


def reference(x, w_in, rwkv_mu, rwkv_w0, rwkv_w2, rwkv_a0, rwkv_a2, rwkv_g2, rwkv_k_k, rwkv_k_a, rwkv_r_k,
              rwkv_gn_g, rwkv_gn_b, rwkv_out, mla_q_norm, mla_q_up, mla_kv_norm, mla_kv_up, mla_out,
              s5_lambda_re, s5_lambda_im, s5_log_step, s5_b_re, s5_b_im, s5_c_re, s5_c_im, s5_d, s5_glu,
              gate_b, w_out, ln1_g, ln1_b, ffn_w1, ffn_w3, ffn_w2, ln2_g, ln2_b):
    bsz, t, _ = x.shape
    pos = jnp.arange(t, dtype=jnp.float32)
    inv_freq = ROPE_THETA ** (-jnp.arange(0, QK_ROPE_DIM, 2, dtype=jnp.float32) / QK_ROPE_DIM)
    ang = pos[:, None] * inv_freq[None, :]
    cos, sin = jnp.cos(ang), jnp.sin(ang)
    o_mla = RWKV_COLS
    o_s5 = o_mla + MLA_COLS
    o_gate = o_s5 + S5_COLS
    for l in range(DEPTH):
        p = x @ w_in[l]
        y_a = rwkv7_time_mix(p[..., :o_mla], rwkv_mu[l], rwkv_w0[l], rwkv_w2[l], rwkv_a0[l], rwkv_a2[l],
                             rwkv_g2[l], rwkv_k_k[l], rwkv_k_a[l], rwkv_r_k[l], rwkv_gn_g[l], rwkv_gn_b[l],
                             rwkv_out[l])
        y_b = mla_branch(p[..., o_mla:o_s5], cos, sin, mla_q_norm[l], mla_q_up[l], mla_kv_norm[l],
                         mla_kv_up[l], mla_out[l])
        y_c = s5_branch(p[..., o_s5:o_gate], s5_lambda_re[l], s5_lambda_im[l], s5_log_step[l], s5_b_re[l],
                        s5_b_im[l], s5_c_re[l], s5_c_im[l], s5_d[l], s5_glu[l])
        gates = jax.nn.sigmoid(p[..., o_gate:].reshape(bsz, t, N_BRANCHES, D_MODEL) + gate_b[l])
        merged = gates[..., 0, :] * y_a + gates[..., 1, :] * y_b + gates[..., 2, :] * y_c
        x = layer_norm(DEEPNORM_ALPHA * x + merged @ w_out[l], ln1_g[l], ln1_b[l])
        h = jax.nn.silu(x @ ffn_w1[l]) * (x @ ffn_w3[l])
        x = layer_norm(DEEPNORM_ALPHA * x + h @ ffn_w2[l], ln2_g[l], ln2_b[l])
    return x
```

```cpp
#include <hip/hip_runtime.h>
#include <cstdio>
#include <cstdint>


#define LAS __attribute__((address_space(3)))
#define GAS __attribute__((address_space(1)))
typedef _Float16 h16;
typedef _Float16 h16x2 __attribute__((ext_vector_type(2)));
typedef _Float16 h16x4 __attribute__((ext_vector_type(4)));
typedef _Float16 h16x8 __attribute__((ext_vector_type(8)));
typedef float f32x2 __attribute__((ext_vector_type(2)));
typedef float f32x4 __attribute__((ext_vector_type(4)));
typedef float f32x16 __attribute__((ext_vector_type(16)));
typedef unsigned u32x2 __attribute__((ext_vector_type(2)));
typedef unsigned u32x4 __attribute__((ext_vector_type(4)));
typedef short s16x4 __attribute__((ext_vector_type(4)));

constexpr int BATCH = 2, T = 8192, D = 1024, M = BATCH * T, DEPTH = 2;
constexpr int RH = 8, RN = 64, RD = 512;
constexpr int RWKV_COLS = 1792, MLA_COLS = 416, IN_COLS = 5792, DFF = 2816;
constexpr int O_MLA = 1792, O_S5 = 2208, O_GATE = 2720;
constexpr float ALPHA = 1.4142135623730951f;
constexpr float LN_EPS = 1e-5f, RMS_EPS = 1e-6f, GN_EPS = 64e-5f;
constexpr float QSCALE = 0.10206207261596577f * 1.4426950408889634f;

__device__ __forceinline__ unsigned pkh(float lo, float hi) { h16x2 v = {(h16)lo, (h16)hi}; return __builtin_bit_cast(unsigned, v); }
__device__ __forceinline__ float sigm(float x) { return __builtin_amdgcn_rcpf(1.0f + __expf(-x)); }

namespace pg8 {
constexpr int BM = 256, BK = 64, HALF = 128, HTB = HALF * BK * 2, STAGE_BYTES = 8 * HTB, NXCD = 8, WGM = 8;
__host__ __device__ __forceinline__ int lds_byte(int r, int c) { const int st = (r >> 4) * 2 + (c >> 5), rr = r & 15, cc = c & 31, ob = rr * 64 + cc * 2; return st * 1024 + (ob ^ (((ob >> 9) & 1) << 5)); }
__host__ __device__ __forceinline__ void stage_rc(int b, int& R, int& C) { const int st = b / 1024, sb = b % 1024, swz = sb ^ (((sb >> 9) & 1) << 5); R = (st >> 1) * 16 + swz / 64; C = (st & 1) * 32 + (swz % 64) / 2; }
__host__ __device__ __forceinline__ int perm32(int rho) { const int n = rho >> 4, i = rho & 15; return 8 * (i >> 2) + 4 * n + (i & 3); }

struct Unit { int pm, pn; };
struct Gemm { const h16* A; const h16* Bt; int lda, ldb, K; };

struct StaticOrder {
    int nM, nN, nwg, G, c;
    __device__ void init(int Mr, int N, int G_, int c_) { nM = Mr / BM; nN = N / BM; nwg = nM * nN; G = G_; c = c_; }
    __device__ bool next(int i, Unit& u) const {
        const long L = (long)i * G + c; if (L >= nwg) return false;
        int wgid = (int)L; { const int q = nwg / NXCD, r = nwg % NXCD, xcd = wgid % NXCD, off = wgid / NXCD; wgid = (xcd < r ? xcd * (q + 1) : r * (q + 1) + (xcd - r) * q) + off; }
        const int nig = WGM * nN, gid = wgid / nig, fm = gid * WGM, gsz = (nM - fm) < WGM ? (nM - fm) : WGM;
        u.pm = fm + ((wgid % nig) % gsz); u.pn = (wgid % nig) / gsz; return true;
    }
};
struct ListOrder {
    Unit u0, u1; int n;
    __device__ bool next(int i, Unit& u) const { if (i >= n) return false; u = (i == 0) ? u0 : u1; return true; }
};

template <class Epi, class Sched>
__device__ __forceinline__ void gemm_phase(LAS unsigned char* lds, const Gemm g, const Sched& S, const Epi& E) {
    int tid = threadIdx.x; asm volatile("" : "+v"(tid));
    const int wid = __builtin_amdgcn_readfirstlane(tid >> 6), lane = tid & 63, wr = wid >> 2, wc = wid & 3, fr = lane & 15, fq = lane >> 4;
    int K = g.K; asm volatile("" : "+s"(K)); const int nt = K / BK;
    unsigned voffA[2], voffB[2];
#pragma unroll
    for (int i = 0; i < 2; ++i) { int R, C; stage_rc(tid * 16 + i * 8192, R, C); const int Rb = Epi::PERM ? ((R & ~31) + perm32(R & 31)) : R;
        voffA[i] = (unsigned)(R * g.lda + C) * 2u; voffB[i] = (unsigned)(Rb * g.ldb + C) * 2u; }
    const size_t kstep = (size_t)(BK * 2);
    const size_t hstepA = (size_t)HALF * g.lda * 2, hstepB = (size_t)HALF * g.ldb * 2;
    const size_t tstepA = 2 * hstepA, tstepB = 2 * hstepB;
    const unsigned ldsw = (unsigned)wid * 1024u;
    const int aoff = lds_byte(wr * 64 + fr, fq * 8), boff = lds_byte(wc * 32 + fr, fq * 8);
#define PG8_SA(b, h) (((b) * 2 + (h)) * HTB)
#define PG8_SB(b, h) ((4 + (b) * 2 + (h)) * HTB)
#define PG8_STAGE(bufoff, gbase, voff) do { _Pragma("unroll") for (int _i = 0; _i < 2; ++_i) \
        __builtin_amdgcn_global_load_lds((const unsigned*)((const char*)(gbase) + (voff)[_i]), (LAS unsigned*)(lds + (bufoff) + ldsw + _i * 8192), 16, 0, 0); } while (0)
#define PG8_LDA(dst, b, h) do { _Pragma("unroll") for (int m = 0; m < 4; ++m) _Pragma("unroll") for (int k = 0; k < 2; ++k) dst[m][k] = *(const LAS h16x8*)(lds + PG8_SA(b, h) + aoff + m * 2048 + k * 1024); } while (0)
#define PG8_LDB(dst, b, h) do { _Pragma("unroll") for (int n = 0; n < 2; ++n) _Pragma("unroll") for (int k = 0; k < 2; ++k) dst[n][k] = *(const LAS h16x8*)(lds + PG8_SB(b, h) + boff + n * 2048 + k * 1024); } while (0)
#define PG8_MMA(ai, bj, At, Bt) do { __builtin_amdgcn_s_setprio(1); _Pragma("unroll") for (int m = 0; m < 4; ++m) _Pragma("unroll") for (int n = 0; n < 2; ++n) _Pragma("unroll") for (int k = 0; k < 2; ++k) \
        acc[ai][bj][m][n] = __builtin_amdgcn_mfma_f32_16x16x32_f16(Bt[n][k], At[m][k], acc[ai][bj][m][n], 0, 0, 0); __builtin_amdgcn_s_setprio(0); } while (0)
#define PG8_WAIT_V(n) asm volatile("s_waitcnt vmcnt(" #n ")" ::: "memory")
#define PG8_WAIT_L(n) asm volatile("s_waitcnt lgkmcnt(" #n ")" ::: "memory")
#define PG8_BAR __builtin_amdgcn_s_barrier()
#define PG8_SCHED __builtin_amdgcn_sched_barrier(0)
    Unit cur, nxt; int ui = 0;
    if (!S.next(0, cur)) return;
    f32x4 acc[2][2][4][2];
#pragma unroll
    for (int a = 0; a < 2; ++a)
#pragma unroll
        for (int b = 0; b < 2; ++b)
#pragma unroll
            for (int m = 0; m < 4; ++m)
#pragma unroll
                for (int n = 0; n < 2; ++n) acc[a][b][m][n] = (f32x4){0.f, 0.f, 0.f, 0.f};
    h16x8 At[4][2], B0[2][2], B1[2][2];
    const char* cA = (const char*)g.A + (size_t)cur.pm * tstepA; const char* cB = (const char*)g.Bt + (size_t)cur.pn * tstepB;
    {
        PG8_STAGE(PG8_SB(0, 0), cB, voffB); PG8_STAGE(PG8_SB(0, 1), cB + hstepB, voffB); PG8_STAGE(PG8_SA(0, 0), cA, voffA); PG8_STAGE(PG8_SA(0, 1), cA + hstepA, voffA);
        if (wr == 1) PG8_BAR;
        PG8_WAIT_V(2); PG8_BAR;
        PG8_STAGE(PG8_SB(1, 0), cB + kstep, voffB); PG8_STAGE(PG8_SA(1, 0), cA + kstep, voffA); PG8_STAGE(PG8_SB(1, 1), cB + hstepB + kstep, voffB);
        PG8_WAIT_V(6); PG8_BAR;
    }
    for (;;) {
        const bool has_next = S.next(ui + 1, nxt);
        const char* nA = has_next ? (const char*)g.A + (size_t)nxt.pm * tstepA : cA; const char* nB = has_next ? (const char*)g.Bt + (size_t)nxt.pn * tstepB : cB;
        for (int t = 0; t < nt; t += 2) {
            const bool last = (t == nt - 2);
            const char* a1 = cA + (size_t)(t + 1) * kstep;
            const char* a2 = last ? nA : cA + (size_t)(t + 2) * kstep; const char* b2 = last ? nB : cB + (size_t)(t + 2) * kstep;
            const char* a3 = a2 + kstep; const char* b3 = b2 + kstep;
            PG8_LDB(B0, 0, 0); PG8_LDB(B1, 0, 1); PG8_SCHED; PG8_LDA(At, 0, 0); PG8_STAGE(PG8_SA(1, 1), a1 + hstepA, voffA);
            PG8_WAIT_V(8); PG8_WAIT_L(0); PG8_BAR; PG8_MMA(0, 0, At, B0); PG8_MMA(0, 1, At, B1); PG8_BAR; PG8_SCHED;
            PG8_LDA(At, 0, 1); PG8_STAGE(PG8_SB(0, 0), b2, voffB); PG8_STAGE(PG8_SB(0, 1), b2 + hstepB, voffB); PG8_STAGE(PG8_SA(0, 0), a2, voffA);
            PG8_WAIT_V(8); PG8_WAIT_L(0); PG8_BAR; PG8_MMA(1, 0, At, B0); PG8_MMA(1, 1, At, B1); PG8_BAR; PG8_SCHED;
            PG8_LDB(B0, 1, 0); PG8_LDB(B1, 1, 1); PG8_SCHED; PG8_LDA(At, 1, 0); PG8_STAGE(PG8_SA(0, 1), a2 + hstepA, voffA);
            PG8_WAIT_V(8); PG8_WAIT_L(0); PG8_BAR; PG8_MMA(0, 0, At, B0); PG8_MMA(0, 1, At, B1); PG8_BAR; PG8_SCHED;
            PG8_LDA(At, 1, 1); PG8_STAGE(PG8_SB(1, 0), b3, voffB); PG8_STAGE(PG8_SB(1, 1), b3 + hstepB, voffB); PG8_STAGE(PG8_SA(1, 0), a3, voffA);
            PG8_WAIT_V(8); PG8_WAIT_L(0); PG8_BAR; PG8_MMA(1, 0, At, B0); PG8_MMA(1, 1, At, B1); PG8_BAR; PG8_SCHED;
        }
        if (wr == 0) PG8_BAR;
        { int fr_ = fr, fq_ = fq; asm volatile("" : "+v"(fr_), "+v"(fq_)); E(acc, cur, wr, wc, fr_, fq_); }
        if (!has_next) break;
#pragma unroll
        for (int a = 0; a < 2; ++a)
#pragma unroll
            for (int b = 0; b < 2; ++b)
#pragma unroll
                for (int m = 0; m < 4; ++m)
#pragma unroll
                    for (int n = 0; n < 2; ++n) acc[a][b][m][n] = (f32x4){0.f, 0.f, 0.f, 0.f};
        cur = nxt; cA = nA; cB = nB; ++ui;
        if (wr == 1) PG8_BAR;
    }
    PG8_WAIT_V(0);
    PG8_BAR;
#undef PG8_SA
#undef PG8_SB
#undef PG8_STAGE
#undef PG8_LDA
#undef PG8_LDB
#undef PG8_MMA
#undef PG8_WAIT_V
#undef PG8_WAIT_L
#undef PG8_BAR
#undef PG8_SCHED
}
}

using pg8::Unit; using pg8::HALF; using pg8::BM;
struct EpiStoreSplit {
    static constexpr bool PERM = true;
    h16* p_rwkv; h16* p_mla; h16* u;
    __device__ __forceinline__ void operator()(const f32x4 (&acc)[2][2][4][2], const Unit& un, int wr, int wc, int fr, int fq) const {
        h16* base; int ldc, colt;
        if (un.pn < 7) { base = p_rwkv; ldc = RWKV_COLS; colt = un.pn * BM; } else if (un.pn < 9) { base = p_mla; ldc = 512; colt = (un.pn - 7) * BM; } else { base = u; ldc = 512; colt = (un.pn - 9) * BM; }
        const int row0 = un.pm * BM + wr * 64 + fr, col0 = colt + wc * 32 + 8 * fq;
#pragma unroll
        for (int ai = 0; ai < 2; ++ai)
#pragma unroll
            for (int m = 0; m < 4; ++m) { h16* rowp = base + (size_t)(row0 + ai * HALF + m * 16) * ldc + col0;
#pragma unroll
                for (int bj = 0; bj < 2; ++bj) { const f32x4 v0 = acc[ai][bj][m][0], v1 = acc[ai][bj][m][1];
                    u32x4 w; w.x = pkh(v0[0], v0[1]); w.y = pkh(v0[2], v0[3]); w.z = pkh(v1[0], v1[1]); w.w = pkh(v1[2], v1[3]);
                    *(u32x4*)(rowp + bj * HALF) = w; } }
    }
};
struct EpiLora {
    static constexpr bool PERM = true;
    h16* lw; const float* w0; const float* a0;
    __device__ __forceinline__ void operator()(const f32x4 (&acc)[2][2][4][2], const Unit& un, int wr, int wc, int fr, int fq) const {
        const int kind = un.pn >> 1; h16* base = lw + (size_t)kind * (size_t)(8u << 20); const float* bias = kind == 0 ? w0 : a0;
        const int colt = (un.pn & 1) * BM; const int row0 = un.pm * BM + wr * 64 + fr, col0 = colt + wc * 32 + 8 * fq;
        f32x4 bv[2][2];
#pragma unroll
        for (int bj = 0; bj < 2; ++bj)
#pragma unroll
            for (int n = 0; n < 2; ++n) bv[bj][n] = kind < 2 ? *(const f32x4*)(bias + col0 + bj * HALF + 4 * n) : (f32x4){0.f, 0.f, 0.f, 0.f};
#pragma unroll
        for (int ai = 0; ai < 2; ++ai)
#pragma unroll
            for (int m = 0; m < 4; ++m) { h16* rowp = base + (size_t)(row0 + ai * HALF + m * 16) * RD + col0;
#pragma unroll
                for (int bj = 0; bj < 2; ++bj) { f32x4 v0 = acc[ai][bj][m][0] + bv[bj][0], v1 = acc[ai][bj][m][1] + bv[bj][1];
                    if (kind < 2) { const float sc = kind == 0 ? -0.6065306597126334f : 1.0f;
#pragma unroll
                        for (int e = 0; e < 4; ++e) { v0[e] = sc * sigm(v0[e]); v1[e] = sc * sigm(v1[e]); } }
                    u32x4 w; w.x = pkh(v0[0], v0[1]); w.y = pkh(v0[2], v0[3]); w.z = pkh(v1[0], v1[1]); w.w = pkh(v1[2], v1[3]);
                    *(u32x4*)(rowp + bj * HALF) = w; } }
    }
};
struct EpiQ {
    static constexpr bool PERM = false;
    h16* Qc; const float* rstd; const float* cosT; const float* sinT;
    __device__ __forceinline__ void operator()(const f32x4 (&acc)[2][2][4][2], const Unit& un, int wr, int wc, int fr, int fq) const {
        const int row0 = un.pm * BM + wr * 64 + fr;
#pragma unroll
        for (int ai = 0; ai < 2; ++ai)
#pragma unroll
            for (int m = 0; m < 4; ++m) { const int row = row0 + ai * HALF + m * 16; const float rs = rstd[row] * QSCALE; const int pos = row & (T - 1);
                const f32x4 cs = *(const f32x4*)(cosT + pos * 16 + 4 * fq), sn = *(const f32x4*)(sinT + pos * 16 + 4 * fq);
#pragma unroll
                for (int bj = 0; bj < 2; ++bj) { const int cb = un.pn * 8 + bj * 4 + wc;
                    f32x4 v0 = acc[ai][bj][m][0] * rs, v1 = acc[ai][bj][m][1] * rs;
                    if (cb % 3 == 2) { const f32x4 a = v0, b = v1; v0 = a * cs - b * sn; v1 = b * cs + a * sn; }
                    h16* p = Qc + (size_t)row * 768 + cb * 32 + 4 * fq;
                    u32x2 w0; w0.x = pkh(v0[0], v0[1]); w0.y = pkh(v0[2], v0[3]); *(u32x2*)p = w0;
                    u32x2 w1; w1.x = pkh(v1[0], v1[1]); w1.y = pkh(v1[2], v1[3]); *(u32x2*)(p + 16) = w1; } }
    }
};
struct EpiKV {
    static constexpr bool PERM = true;
    h16* Kc; h16* Va; const float* rstd;
    __device__ __forceinline__ void operator()(const f32x4 (&acc)[2][2][4][2], const Unit& un, int wr, int wc, int fr, int fq) const {
        const int row0 = un.pm * BM + wr * 64 + fr;
#pragma unroll
        for (int ai = 0; ai < 2; ++ai)
#pragma unroll
            for (int m = 0; m < 4; ++m) { const int row = row0 + ai * HALF + m * 16; const float rs = rstd[row];
#pragma unroll
                for (int bj = 0; bj < 2; ++bj) { const int c = un.pn * BM + bj * HALF + wc * 32 + 8 * fq, h = c >> 7, w = c & 127;
                    const f32x4 v0 = acc[ai][bj][m][0] * rs, v1 = acc[ai][bj][m][1] * rs;
                    u32x4 o; o.x = pkh(v0[0], v0[1]); o.y = pkh(v0[2], v0[3]); o.z = pkh(v1[0], v1[1]); o.w = pkh(v1[2], v1[3]);
                    h16* p = (w < 64) ? Kc + (size_t)row * 768 + h * 96 + w : Va + (size_t)row * 512 + h * 64 + (w - 64);
                    *(u32x4*)p = o; } }
    }
};
struct EpiGate {
    static constexpr bool PERM = true;
    h16* gates; const float* gb;
    __device__ __forceinline__ void operator()(const f32x4 (&acc)[2][2][4][2], const Unit& un, int wr, int wc, int fr, int fq) const {
        const int row0 = un.pm * BM + wr * 64 + fr, col0 = un.pn * BM + wc * 32 + 8 * fq;
        f32x4 bv[2][2];
#pragma unroll
        for (int bj = 0; bj < 2; ++bj)
#pragma unroll
            for (int n = 0; n < 2; ++n) bv[bj][n] = *(const f32x4*)(gb + col0 + bj * HALF + 4 * n);
#pragma unroll
        for (int ai = 0; ai < 2; ++ai)
#pragma unroll
            for (int m = 0; m < 4; ++m) { h16* rowp = gates + (size_t)(row0 + ai * HALF + m * 16) * 3072 + col0;
#pragma unroll
                for (int bj = 0; bj < 2; ++bj) { f32x4 v0 = acc[ai][bj][m][0] + bv[bj][0], v1 = acc[ai][bj][m][1] + bv[bj][1];
#pragma unroll
                    for (int e = 0; e < 4; ++e) { v0[e] = sigm(v0[e]); v1[e] = sigm(v1[e]); }
                    u32x4 w; w.x = pkh(v0[0], v0[1]); w.y = pkh(v0[2], v0[3]); w.z = pkh(v1[0], v1[1]); w.w = pkh(v1[2], v1[3]);
                    *(u32x4*)(rowp + bj * HALF) = w; } }
    }
};
__device__ __forceinline__ void unpk8(const u32x4 w, float (&o)[8]) {
    const unsigned a0 = w.x, a1 = w.y, a2 = w.z, a3 = w.w;
    const h16x2 h0 = __builtin_bit_cast(h16x2, a0), h1 = __builtin_bit_cast(h16x2, a1), h2 = __builtin_bit_cast(h16x2, a2), h3 = __builtin_bit_cast(h16x2, a3);
    o[0] = (float)h0[0]; o[1] = (float)h0[1]; o[2] = (float)h1[0]; o[3] = (float)h1[1]; o[4] = (float)h2[0]; o[5] = (float)h2[1]; o[6] = (float)h3[0]; o[7] = (float)h3[1];
}
template <int KIND> struct EpiBranch {
    static constexpr bool PERM = true;
    h16* merged; const h16* gates;
    __device__ __forceinline__ void operator()(const f32x4 (&acc)[2][2][4][2], const Unit& un, int wr, int wc, int fr, int fq) const {
        const int row0 = un.pm * BM + wr * 64 + fr;
#pragma unroll
        for (int ai = 0; ai < 2; ++ai)
#pragma unroll
            for (int m = 0; m < 4; ++m) { const int row = row0 + ai * HALF + m * 16;
#pragma unroll
                for (int bj = 0; bj < (KIND == 2 ? 1 : 2); ++bj) {
                    const int col = (KIND == 2 ? un.pn * HALF : un.pn * BM + bj * HALF) + wc * 32 + 8 * fq;
                    float v[8];
                    if (KIND == 2) { const f32x4 a0 = acc[ai][0][m][0], a1 = acc[ai][0][m][1], b0 = acc[ai][1][m][0], b1 = acc[ai][1][m][1];
#pragma unroll
                        for (int e = 0; e < 4; ++e) { v[e] = a0[e] * sigm(b0[e]); v[4 + e] = a1[e] * sigm(b1[e]); } }
                    else { const f32x4 a0 = acc[ai][bj][m][0], a1 = acc[ai][bj][m][1];
#pragma unroll
                        for (int e = 0; e < 4; ++e) { v[e] = a0[e]; v[4 + e] = a1[e]; } }
                    float gt[8]; unpk8(*(const u32x4*)(gates + (size_t)row * 3072 + KIND * 1024 + col), gt);
                    h16* mp = merged + (size_t)row * 1024 + col;
                    if (KIND != 0) { float old[8]; unpk8(*(const u32x4*)mp, old);
#pragma unroll
                        for (int e = 0; e < 8; ++e) v[e] = old[e] + gt[e] * v[e]; }
                    else {
#pragma unroll
                        for (int e = 0; e < 8; ++e) v[e] = gt[e] * v[e]; }
                    u32x4 w; w.x = pkh(v[0], v[1]); w.y = pkh(v[2], v[3]); w.z = pkh(v[4], v[5]); w.w = pkh(v[6], v[7]);
                    *(u32x4*)mp = w; } }
    }
};
struct EpiPre {
    static constexpr bool PERM = false;
    const float* xres; float* pre;
    __device__ __forceinline__ void operator()(const f32x4 (&acc)[2][2][4][2], const Unit& un, int wr, int wc, int fr, int fq) const {
        const int row0 = un.pm * BM + wr * 64 + fr, col0 = un.pn * BM + wc * 32 + 4 * fq;
#pragma unroll
        for (int ai = 0; ai < 2; ++ai)
#pragma unroll
            for (int m = 0; m < 4; ++m) { const size_t off = (size_t)(row0 + ai * HALF + m * 16) * D + col0;
#pragma unroll
                for (int bj = 0; bj < 2; ++bj)
#pragma unroll
                    for (int n = 0; n < 2; ++n) { const f32x4 xr = *(const f32x4*)(xres + off + bj * HALF + n * 16);
                        *(f32x4*)(pre + off + bj * HALF + n * 16) = xr * ALPHA + acc[ai][bj][m][n]; } }
    }
};
struct EpiSwiGLU {
    static constexpr bool PERM = true;
    h16* hb;
    __device__ __forceinline__ void operator()(const f32x4 (&acc)[2][2][4][2], const Unit& un, int wr, int wc, int fr, int fq) const {
        const int row0 = un.pm * BM + wr * 64 + fr, col0 = un.pn * HALF + wc * 32 + 8 * fq;
#pragma unroll
        for (int ai = 0; ai < 2; ++ai)
#pragma unroll
            for (int m = 0; m < 4; ++m) { const f32x4 a0 = acc[ai][0][m][0], a1 = acc[ai][0][m][1], b0 = acc[ai][1][m][0], b1 = acc[ai][1][m][1]; float v[8];
#pragma unroll
                for (int e = 0; e < 4; ++e) { v[e] = a0[e] * sigm(a0[e]) * b0[e]; v[4 + e] = a1[e] * sigm(a1[e]) * b1[e]; }
                u32x4 w; w.x = pkh(v[0], v[1]); w.y = pkh(v[2], v[3]); w.z = pkh(v[4], v[5]); w.w = pkh(v[6], v[7]);
                *(u32x4*)(hb + (size_t)(row0 + ai * HALF + m * 16) * DFF + col0) = w; }
    }
};

constexpr size_t MiB = 1u << 20;
constexpr size_t WS_CTL = 0, CTL_ZERO_BYTES = 1 * MiB;
constexpr size_t WS_COS = 1 * MiB, WS_SIN = 1 * MiB + 512 * 1024;
constexpr size_t WS_RSTDQ = 2 * MiB, WS_RSTDKV = 2 * MiB + 64 * 1024;
constexpr size_t WS_S5END = 2 * MiB + 512 * 1024;
constexpr size_t WS_WIN = 4 * MiB;
constexpr size_t WS_WG = WS_WIN + 5632 * 1024;
constexpr size_t WS_WLORA = WS_WG + 6 * MiB;
constexpr size_t WS_WQ = WS_WLORA + 768 * 1024;
constexpr size_t WS_WKV = WS_WQ + 384 * 1024;
constexpr size_t WS_WRO = WS_WKV + 256 * 1024;
constexpr size_t WS_WMO = WS_WRO + 1 * MiB;
constexpr size_t WS_WGLU = WS_WMO + 1 * MiB;
constexpr size_t WS_WO = WS_WGLU + 2 * MiB;
constexpr size_t WS_W13 = WS_WO + 2 * MiB;
constexpr size_t WS_W2 = WS_W13 + 11 * MiB;
static_assert(WS_W2 + 5632 * 1024 <= 40 * MiB, "weights region");
constexpr size_t SLOT0 = 40 * MiB, SLOT = 8 * MiB;
#define WS_SLOT(s) (SLOT0 + (size_t)(s) * SLOT)
constexpr size_t WS_XH = WS_SLOT(0), WS_PRWKV = WS_SLOT(4), WS_PMLA = WS_SLOT(11), WS_U = WS_SLOT(13);
constexpr size_t WS_KC = WS_SLOT(1), WS_ALORA = WS_SLOT(0), WS_R = WS_SLOT(15), WS_K = WS_SLOT(17), WS_V = WS_SLOT(19);
constexpr size_t WS_LW = WS_SLOT(5), WS_ASIG = WS_SLOT(7), WS_G = WS_SLOT(9), WS_QC = WS_SLOT(21), WS_VA = WS_SLOT(24);
constexpr size_t WS_YS5 = WS_SLOT(11), WS_OATT = WS_SLOT(13), WS_YRW0 = WS_SLOT(0), WS_YRW1 = WS_SLOT(26);
constexpr size_t WS_XH2 = WS_SLOT(3), WS_YAIN = WS_SLOT(1), WS_GATES = WS_SLOT(15), WS_MERGED = WS_SLOT(7);
constexpr size_t WS_PRE = WS_SLOT(11), WS_X1H = WS_SLOT(0), WS_HB = WS_SLOT(4), WS_PRE2 = WS_SLOT(15);
constexpr size_t WS_END = WS_SLOT(27);
static_assert(WS_ASIG == WS_LW + 16 * MiB && WS_G == WS_LW + 32 * MiB, "EpiLora strides");
static_assert(WS_END == 256 * MiB, "ws map");
constexpr int CW_BAR = 4096;
constexpr int CW_QUEUE = 64;

constexpr int LDS_BYTES = 147456;
constexpr int MISC_OFF = 131072 + 320;
constexpr int NWAVES = 8, NTHREADS = 512;

struct Args {
    const float* in[37]; float* out; unsigned char* ws; float invfreq[16]; int ph_lo, ph_hi; int one_launch, pad;
};
enum { I_X = 0, I_WIN, I_MU, I_W0, I_W2, I_A0, I_A2, I_G2, I_KK, I_KA, I_RK, I_GNG, I_GNB, I_ROUT, I_QNORM, I_QUP, I_KVNORM, I_KVUP, I_MOUT,
       I_LRE, I_LIM, I_LSTEP, I_BRE, I_BIM, I_CRE, I_CIM, I_S5D, I_GLU, I_GATEB, I_WOUT, I_LN1G, I_LN1B, I_W1, I_W3, I_FW2, I_LN2G, I_LN2B };

struct Frame {
    LAS unsigned char* lds; int tid, lane, wave, G, bid; unsigned char* ws; const Args* a;
};
__device__ __forceinline__ float wave_sum(float v) {
#pragma unroll
    for (int o = 1; o < 64; o <<= 1) v += __shfl_xor(v, o);
    return v;
}

__device__ __forceinline__ void cvt_item(const float* src, int ldsrc, int k0, int n0, h16* dst, int lddst, int drow0, int dk0, const float* kscale, LAS float* scr, int lane) {
    if (src) {
#pragma unroll 8
        for (int i = 0; i < 32; ++i) { const int kk = 2 * i + (lane >> 5); float v = src[(size_t)(k0 + kk) * ldsrc + n0 + (lane & 31)]; if (kscale) v *= kscale[k0 + kk]; scr[kk * 33 + (lane & 31)] = v; }
    }
    asm volatile("s_waitcnt lgkmcnt(0)" ::: "memory");
    const int c = lane & 7;
#pragma unroll
    for (int j = 0; j < 4; ++j) { const int n = (lane >> 3) + 8 * j; const LAS float* s = scr + (8 * c) * 33 + n;
        u32x4 o = {0u, 0u, 0u, 0u};
        if (src) { o.x = pkh(s[0 * 33], s[1 * 33]); o.y = pkh(s[2 * 33], s[3 * 33]); o.z = pkh(s[4 * 33], s[5 * 33]); o.w = pkh(s[6 * 33], s[7 * 33]); }
        *(u32x4*)(dst + (size_t)(drow0 + n) * lddst + dk0 + 8 * c) = o; }
    asm volatile("s_waitcnt lgkmcnt(0)" ::: "memory");
}
__device__ __forceinline__ void phase_convert(Frame& F, int l) {
    LAS float* scr = (LAS float*)(F.lds + F.wave * 16384);
    const int gw = F.bid * NWAVES + F.wave, NGW = F.G * NWAVES; unsigned char* ws = F.ws; const Args& A = *F.a;
    const float* win = A.in[I_WIN] + (size_t)l * D * IN_COLS;
    constexpr int N_WIN = 16 * 88, N_WG = 16 * 96, N_LORA = 4 * 48, N_Q = 4 * 24, N_KV = 2 * 32, N_RO = 8 * 32, N_MO = 8 * 32, N_GLU = 8 * 64, N_O = 16 * 32, N_13 = 16 * 176, N_2 = 44 * 32;
    constexpr int NITEMS = N_WIN + N_WG + N_LORA + N_Q + N_KV + N_RO + N_MO + N_GLU + N_O + N_13 + N_2;
    for (int it = gw; it < NITEMS; it += NGW) {
        int r = it;
        if (r < N_WIN) { const int kb = r / 88, db = r % 88;
            int sc; if (db < 56) sc = 32 * db; else if (db < 69) sc = O_MLA + 32 * (db - 56); else if (db < 72) sc = -1; else sc = O_S5 + 32 * (db - 72);
            cvt_item(sc >= 0 ? win : nullptr, IN_COLS, 64 * kb, sc, (h16*)(ws + WS_WIN), 1024, 32 * db, 64 * kb, nullptr, scr, F.lane); continue; } r -= N_WIN;
        if (r < N_WG) { const int kb = r / 96, db = r % 96;
            cvt_item(win, IN_COLS, 64 * kb, O_GATE + 32 * db, (h16*)(ws + WS_WG), 1024, 32 * db, 64 * kb, nullptr, scr, F.lane); continue; } r -= N_WG;
        if (r < N_LORA) { const int kb = r / 48, db = r % 48; const float* s = nullptr; int k0 = 0, n0 = 0;
            if (db < 16) { if (kb == 0) { s = A.in[I_W2] + (size_t)l * 64 * 512; k0 = 0; n0 = 32 * db; } }
            else if (db < 32) { if (kb == 1) { s = A.in[I_A2] + (size_t)l * 64 * 512; k0 = 0; n0 = 32 * (db - 16); } }
            else { if (kb >= 2) { s = A.in[I_G2] + (size_t)l * 128 * 512; k0 = 64 * (kb - 2); n0 = 32 * (db - 32); } }
            cvt_item(s, 512, k0, n0, (h16*)(ws + WS_WLORA), 256, 32 * db, 64 * kb, nullptr, scr, F.lane); continue; } r -= N_LORA;
        if (r < N_Q) { const int kb = r / 24, db = r % 24;
            cvt_item(A.in[I_QUP] + (size_t)l * 256 * 768, 768, 64 * kb, 32 * db, (h16*)(ws + WS_WQ), 256, 32 * db, 64 * kb, A.in[I_QNORM] + l * 256, scr, F.lane); continue; } r -= N_Q;
        if (r < N_KV) { const int kb = r / 32, db = r % 32;
            cvt_item(A.in[I_KVUP] + (size_t)l * 128 * 1024, 1024, 64 * kb, 32 * db, (h16*)(ws + WS_WKV), 128, 32 * db, 64 * kb, A.in[I_KVNORM] + l * 128, scr, F.lane); continue; } r -= N_KV;
        if (r < N_RO) { const int kb = r / 32, db = r % 32;
            cvt_item(A.in[I_ROUT] + (size_t)l * 512 * 1024, 1024, 64 * kb, 32 * db, (h16*)(ws + WS_WRO), 512, 32 * db, 64 * kb, nullptr, scr, F.lane); continue; } r -= N_RO;
        if (r < N_MO) { const int kb = r / 32, db = r % 32;
            cvt_item(A.in[I_MOUT] + (size_t)l * 512 * 1024, 1024, 64 * kb, 32 * db, (h16*)(ws + WS_WMO), 512, 32 * db, 64 * kb, nullptr, scr, F.lane); continue; } r -= N_MO;
        if (r < N_GLU) { const int kb = r / 64, db = r % 64, t = db >> 3, w = db & 7; const int sc = (w < 4) ? 128 * t + 32 * w : 1024 + 128 * t + 32 * (w - 4);
            cvt_item(A.in[I_GLU] + (size_t)l * 512 * 2048, 2048, 64 * kb, sc, (h16*)(ws + WS_WGLU), 512, 32 * db, 64 * kb, nullptr, scr, F.lane); continue; } r -= N_GLU;
        if (r < N_O) { const int kb = r / 32, db = r % 32;
            cvt_item(A.in[I_WOUT] + (size_t)l * 1024 * 1024, 1024, 64 * kb, 32 * db, (h16*)(ws + WS_WO), 1024, 32 * db, 64 * kb, nullptr, scr, F.lane); continue; } r -= N_O;
        if (r < N_13) { const int kb = r / 176, db = r % 176, t = db >> 3, w = db & 7; const float* s = (w < 4 ? A.in[I_W1] : A.in[I_W3]) + (size_t)l * 1024 * DFF;
            cvt_item(s, DFF, 64 * kb, 128 * t + 32 * (w & 3), (h16*)(ws + WS_W13), 1024, 32 * db, 64 * kb, nullptr, scr, F.lane); continue; } r -= N_13;
        { const int kb = r / 32, db = r % 32;
            cvt_item(A.in[I_FW2] + (size_t)l * DFF * 1024, 1024, 64 * kb, 32 * db, (h16*)(ws + WS_W2), DFF, 32 * db, 64 * kb, nullptr, scr, F.lane); }
    }
}
__device__ __forceinline__ void rows_to_h16(Frame& F, const float* x, h16* xh) {
    const int gw = F.bid * NWAVES + F.wave, NGW = F.G * NWAVES;
    for (int m = gw; m < M; m += NGW) { const f32x4* xr = (const f32x4*)(x + (size_t)m * D) + F.lane; u32x2* o = (u32x2*)(xh + (size_t)m * D) + F.lane;
#pragma unroll
        for (int j = 0; j < 4; ++j) { const f32x4 v = xr[64 * j]; u32x2 w; w.x = pkh(v.x, v.y); w.y = pkh(v.z, v.w); o[64 * j] = w; } }
}
__device__ __forceinline__ void rope_table(Frame& F) {
    float* cosT = (float*)(F.ws + WS_COS); float* sinT = (float*)(F.ws + WS_SIN);
    for (int i = F.bid * NTHREADS + F.tid; i < T * 16; i += F.G * NTHREADS) { const int pos = i >> 4, f = i & 15; const float ang = (float)pos * exp2f(-(float)f * 0.8304820237218406f); float s, c; sincosf(ang, &s, &c); cosT[i] = c; sinT[i] = s; }
}
__device__ __forceinline__ void phase_ln(Frame& F, const float* pre, const float* g, const float* b, float* xo, h16* xoh) {
    const int gw = F.bid * NWAVES + F.wave, NGW = F.G * NWAVES;
    f32x4 gv[4], bv[4];
#pragma unroll
    for (int j = 0; j < 4; ++j) { gv[j] = ((const f32x4*)g)[F.lane + 64 * j]; bv[j] = ((const f32x4*)b)[F.lane + 64 * j]; }
    for (int m = gw; m < M; m += NGW) {
        const f32x4* xr = (const f32x4*)(pre + (size_t)m * D) + F.lane; f32x4 v[4]; float s = 0.f;
#pragma unroll
        for (int j = 0; j < 4; ++j) { v[j] = xr[64 * j]; s += (v[j].x + v[j].y) + (v[j].z + v[j].w); }
        const float mean = wave_sum(s) * (1.f / D); float s2 = 0.f;
#pragma unroll
        for (int j = 0; j < 4; ++j) { v[j] = v[j] - mean; s2 += (v[j].x * v[j].x + v[j].y * v[j].y) + (v[j].z * v[j].z + v[j].w * v[j].w); }
        const float rstd = 1.f / sqrtf(wave_sum(s2) * (1.f / D) + LN_EPS);
        f32x4* o = (f32x4*)(xo + (size_t)m * D) + F.lane; u32x2* oh = (u32x2*)(xoh + (size_t)m * D) + F.lane;
#pragma unroll
        for (int j = 0; j < 4; ++j) { const f32x4 y = v[j] * rstd * gv[j] + bv[j]; o[64 * j] = y; u32x2 w; w.x = pkh(y.x, y.y); w.y = pkh(y.z, y.w); oh[64 * j] = w; }
    }
}

__device__ __forceinline__ void ld8(const h16* p, float (&o)[8]) { unpk8(*(const u32x4*)p, o); }
__device__ __forceinline__ void st8(h16* p, const float (&v)[8]) { u32x4 w; w.x = pkh(v[0], v[1]); w.y = pkh(v[2], v[3]); w.z = pkh(v[4], v[5]); w.w = pkh(v[6], v[7]); *(u32x4*)p = w; }
__device__ __forceinline__ void phase_prep(Frame& F, int l) {
    const int gw = F.bid * NWAVES + F.wave, NGW = F.G * NWAVES; unsigned char* ws = F.ws; const Args& A = *F.a; const int lane = F.lane;
    const h16* P = (const h16*)(ws + WS_PRWKV); const float* mu = A.in[I_MU] + l * RWKV_COLS;
    h16* R = (h16*)(ws + WS_R); h16* Kk = (h16*)(ws + WS_K); h16* V = (h16*)(ws + WS_V); h16* AL = (h16*)(ws + WS_ALORA);
    const h16* PM = (const h16*)(ws + WS_PMLA); h16* Kc = (h16*)(ws + WS_KC); float* rq = (float*)(ws + WS_RSTDQ); float* rkv = (float*)(ws + WS_RSTDKV);
    const float* cosT = (const float*)(ws + WS_COS); const float* sinT = (const float*)(ws + WS_SIN);
    for (int m = gw; m < M; m += NGW) {
        const int t = m & (T - 1);
#pragma unroll
        for (int j = 0; j < 4; ++j) { const int ch = lane + 64 * j;
            if (ch < 224) { const int c = 8 * ch; float p[8], q[8], o[8];
                ld8(P + (size_t)m * RWKV_COLS + c, p);
                if (t > 0) ld8(P + (size_t)(m - 1) * RWKV_COLS + c, q); else {
#pragma unroll
                    for (int e = 0; e < 8; ++e) q[e] = 0.f; }
                const f32x4 m0 = *(const f32x4*)(mu + c), m1 = *(const f32x4*)(mu + c + 4);
#pragma unroll
                for (int e = 0; e < 8; ++e) o[e] = p[e] + (q[e] - p[e]) * (e < 4 ? m0[e] : m1[e - 4]);
                if (c < 512) st8(R + (size_t)m * RD + c, o);
                else if (c < 1024) st8(Kk + (size_t)m * RD + (c - 512), o);
                else if (c < 1536) st8(V + (size_t)m * RD + (c - 1024), o);
                else { if (c < 1600) {
#pragma unroll
                        for (int e = 0; e < 8; ++e) o[e] = tanhf(o[e]); }
                    else if (c >= 1664) {
#pragma unroll
                        for (int e = 0; e < 8; ++e) o[e] = sigm(o[e]); }
                    st8(AL + (size_t)m * 256 + (c - 1536), o); } } }
        { float x[8]; float ss = 0.f;
            if (lane < 52) { ld8(PM + (size_t)m * 512 + 8 * lane, x);
#pragma unroll
                for (int e = 0; e < 8; ++e) ss += x[e] * x[e]; }
            else {
#pragma unroll
                for (int e = 0; e < 8; ++e) x[e] = 0.f; }
            const float sq = wave_sum(lane < 32 ? ss : 0.f), skv = wave_sum((lane >= 32 && lane < 48) ? ss : 0.f);
            if (lane == 0) { rq[m] = 1.0f / sqrtf(sq * (1.f / 256.f) + RMS_EPS); rkv[m] = 1.0f / sqrtf(skv * (1.f / 128.f) + RMS_EPS); }
            float y[8], o[8];
#pragma unroll
            for (int e = 0; e < 8; ++e) y[e] = __shfl_xor(x[e], 2);
            if (lane >= 48 && lane < 52) { const int i0 = 8 * (lane & 1); const bool second = lane >= 50;
#pragma unroll
                for (int e = 0; e < 8; ++e) { const float cs = cosT[t * 16 + i0 + e], sn = sinT[t * 16 + i0 + e];
                    o[e] = second ? (x[e] * cs + y[e] * sn) : (x[e] * cs - y[e] * sn); }
#pragma unroll
                for (int h = 0; h < 8; ++h) st8(Kc + (size_t)m * 768 + h * 96 + 64 + 8 * (lane - 48), o); } }
    }
}
__device__ __forceinline__ void phase_rwkv_post(Frame& F, int l, const float* xsrc) {
    const int gw = F.bid * NWAVES + F.wave, NGW = F.G * NWAVES; unsigned char* ws = F.ws; const Args& A = *F.a; const int lane = F.lane;
    const h16* R = (const h16*)(ws + WS_R); const h16* Kk = (const h16*)(ws + WS_K); const h16* V = (const h16*)(ws + WS_V);
    const h16* AS = (const h16*)(ws + WS_ASIG); const h16* G = (const h16*)(ws + WS_G); h16* YA = (h16*)(ws + WS_YAIN);
    const int c = 8 * lane;
    float ka[8], rk[8], gg[8], gb[8];
    { const f32x4 a0 = *(const f32x4*)(A.in[I_KA] + l * RD + c), a1 = *(const f32x4*)(A.in[I_KA] + l * RD + c + 4), r0 = *(const f32x4*)(A.in[I_RK] + l * RD + c), r1 = *(const f32x4*)(A.in[I_RK] + l * RD + c + 4);
      const f32x4 g0 = *(const f32x4*)(A.in[I_GNG] + l * RD + c), g1 = *(const f32x4*)(A.in[I_GNG] + l * RD + c + 4), b0 = *(const f32x4*)(A.in[I_GNB] + l * RD + c), b1 = *(const f32x4*)(A.in[I_GNB] + l * RD + c + 4);
#pragma unroll
      for (int e = 0; e < 4; ++e) { ka[e] = a0[e]; ka[4 + e] = a1[e]; rk[e] = r0[e]; rk[4 + e] = r1[e]; gg[e] = g0[e]; gg[4 + e] = g1[e]; gb[e] = b0[e]; gb[4 + e] = b1[e]; } }
    for (int m = gw; m < M; m += NGW) {
        const h16* Y = (const h16*)(ws + (m < T ? WS_YRW0 : WS_YRW1)) + (size_t)(m & (T - 1)) * RD;
        float y[8], r[8], k[8], v[8], as[8], g[8], o[8];
        ld8(Y + c, y); ld8(R + (size_t)m * RD + c, r); ld8(Kk + (size_t)m * RD + c, k); ld8(V + (size_t)m * RD + c, v); ld8(AS + (size_t)m * RD + c, as); ld8(G + (size_t)m * RD + c, g);
        float s = 0.f, bs = 0.f;
#pragma unroll
        for (int e = 0; e < 8; ++e) { s += y[e]; const float kp = k[e] * (1.0f + (as[e] - 1.0f) * ka[e]); bs += r[e] * kp * rk[e]; }
        s += __shfl_xor(s, 1); s += __shfl_xor(s, 2); s += __shfl_xor(s, 4); bs += __shfl_xor(bs, 1); bs += __shfl_xor(bs, 2); bs += __shfl_xor(bs, 4);
        const float mean = s * (1.f / 64.f); float q = 0.f;
#pragma unroll
        for (int e = 0; e < 8; ++e) { y[e] -= mean; q += y[e] * y[e]; }
        q += __shfl_xor(q, 1); q += __shfl_xor(q, 2); q += __shfl_xor(q, 4);
        const float rstd = 1.0f / sqrtf(q * (1.f / 64.f) + GN_EPS);
#pragma unroll
        for (int e = 0; e < 8; ++e) o[e] = (y[e] * rstd * gg[e] + gb[e] + bs * v[e]) * g[e];
        st8(YA + (size_t)m * RD + c, o);
    }
    rows_to_h16(F, xsrc, (h16*)(ws + WS_XH2));
}

constexpr int S5_NC = 32, S5_CL = T / S5_NC;
__device__ __forceinline__ float rdlane(float v, int l) { return __builtin_bit_cast(float, __builtin_amdgcn_readlane(__builtin_bit_cast(int, v), l)); }
__device__ __forceinline__ float gelu_tanh(float x) { const float u = 0.7978845608028654f * (x + 0.044715f * x * x * x); return 0.5f * x * (1.0f + tanhf(u)); }
template <int PASS> __device__ __forceinline__ void phase_s5(Frame& F, int l) {
    const int gw = F.bid * NWAVES + F.wave, NGW = F.G * NWAVES; unsigned char* ws = F.ws; const Args& A = *F.a; const int lane = F.lane;
    const h16* U = (const h16*)(ws + WS_U); h16* Y = (h16*)(ws + WS_YS5); float* END = (float*)(ws + WS_S5END);
    LAS h16* sl = (LAS h16*)(F.lds + F.wave * 8704);
    for (int task = gw; task < BATCH * 32 * S5_NC; task += NGW) {
        const int ch = task % S5_NC, g = (task / S5_NC) % 32, b = task / (S5_NC * 32);
        const int gp = (l * 32 + g) * 64 + lane;
        const float lam_re = fminf(A.in[I_LRE][gp], -1e-4f), lam_im = A.in[I_LIM][gp], step = __expf(A.in[I_LSTEP][l * 32 + g]);
        float sn, cs; sincosf(lam_im * step, &sn, &cs); const float mag = __expf(lam_re * step);
        const float lb_re = mag * cs, lb_im = mag * sn, den = lam_re * lam_re + lam_im * lam_im, n_re = lb_re - 1.0f;
        const float f_re = (n_re * lam_re + lb_im * lam_im) / den, f_im = (lb_im * lam_re - n_re * lam_im) / den;
        float bbr[16], bbi[16];
#pragma unroll
        for (int q = 0; q < 4; ++q) { const f32x4 br = *(const f32x4*)(A.in[I_BRE] + (size_t)gp * 16 + 4 * q), bi = *(const f32x4*)(A.in[I_BIM] + (size_t)gp * 16 + 4 * q);
#pragma unroll
            for (int e = 0; e < 4; ++e) { bbr[4 * q + e] = f_re * br[e] - f_im * bi[e]; bbi[4 * q + e] = f_re * bi[e] + f_im * br[e]; } }
        float s_re = 0.f, s_im = 0.f;
        h16x8 cf[4]; float dsk = 0.f;
        if (PASS == 2) {
            float snL, csL; sincosf(lam_im * step * (float)S5_CL, &snL, &csL); const float magL = __expf(lam_re * step * (float)S5_CL); const float L_re = magL * csL, L_im = magL * snL;
            const float* e0 = END + ((size_t)(b * 32 + g) * S5_NC) * 128 + 2 * lane;
            for (int j = 0; j < ch; ++j) { const f32x2 e = *(const f32x2*)(e0 + j * 128); const float nr = s_re * L_re - s_im * L_im + e.x, ni = s_re * L_im + s_im * L_re + e.y; s_re = nr; s_im = ni; }
            const int c = lane & 15, kg = lane >> 4;
#pragma unroll
            for (int ks = 0; ks < 4; ++ks) { const int k = 32 * ks + 8 * kg; const float* src = (k < 64 ? A.in[I_CRE] : A.in[I_CIM]) + ((size_t)(l * 32 + g) * 16 + c) * 64 + (k & 63); const float sg = k < 64 ? 1.f : -1.f;
                const f32x4 a0 = *(const f32x4*)src, a1 = *(const f32x4*)(src + 4);
                cf[ks] = (h16x8){(h16)(sg * a0[0]), (h16)(sg * a0[1]), (h16)(sg * a0[2]), (h16)(sg * a0[3]), (h16)(sg * a1[0]), (h16)(sg * a1[1]), (h16)(sg * a1[2]), (h16)(sg * a1[3])}; }
            dsk = A.in[I_S5D][l * 512 + 16 * g + c];
        }
        const size_t m0 = (size_t)b * T + (size_t)ch * S5_CL;
        for (int tile = 0; tile < S5_CL / 64; ++tile) {
            float uv[16]; { const h16* up = U + (m0 + 64 * tile + lane) * 512 + 16 * g; float a[8], c2[8]; ld8(up, a); ld8(up + 8, c2);
#pragma unroll
                for (int e = 0; e < 8; ++e) { uv[e] = a[e]; uv[8 + e] = c2[e]; } }
#pragma unroll 1
            for (int half = 0; half < 2; ++half) {
#pragma unroll 2
                for (int tt = 0; tt < 32; ++tt) { const int tl = 32 * half + tt; float br = 0.f, bi = 0.f;
#pragma unroll
                    for (int c = 0; c < 16; ++c) { const float uc = rdlane(uv[c], tl); br += bbr[c] * uc; bi += bbi[c] * uc; }
                    const float nr = s_re * lb_re - s_im * lb_im + br, ni = s_re * lb_im + s_im * lb_re + bi; s_re = nr; s_im = ni;
                    if (PASS == 2) { sl[tt * 136 + lane] = (h16)s_re; sl[tt * 136 + 64 + lane] = (h16)s_im; } }
                if (PASS == 2) {
                    asm volatile("s_waitcnt lgkmcnt(0)" ::: "memory");
                    const int c = lane & 15, kg = lane >> 4;
#pragma unroll
                    for (int mb = 0; mb < 2; ++mb) { f32x4 acc = {0.f, 0.f, 0.f, 0.f};
#pragma unroll
                        for (int ks = 0; ks < 4; ++ks) { const h16x8 af = *(const LAS h16x8*)(sl + (mb * 16 + c) * 136 + 32 * ks + 8 * kg); acc = __builtin_amdgcn_mfma_f32_16x16x32_f16(af, cf[ks], acc, 0, 0, 0); }
#pragma unroll
                        for (int e = 0; e < 4; ++e) { const size_t m = m0 + 64 * tile + 32 * half + mb * 16 + 4 * kg + e; const float uu = (float)U[m * 512 + 16 * g + c];
                            Y[m * 512 + 16 * g + c] = (h16)gelu_tanh(acc[e] + dsk * uu); } }
                    asm volatile("s_waitcnt lgkmcnt(0)" ::: "memory");
                }
            }
        }
        if (PASS == 1) { *(f32x2*)(END + ((size_t)(b * 32 + g) * S5_NC + ch) * 128 + 2 * lane) = (f32x2){s_re, s_im}; }
    }
}

constexpr int RW_TS = 32, RW_BUF = 5 * 8192 + 2048 + 256;
template <int CTRL> __device__ __forceinline__ float dpp_add(float v) { return v + __builtin_bit_cast(float, __builtin_amdgcn_update_dpp(0, __builtin_bit_cast(int, v), CTRL, 0xf, 0xf, false)); }
__device__ __forceinline__ float red16(float v) { v = dpp_add<0xB1>(v); v = dpp_add<0x4E>(v); v = dpp_add<0x141>(v); v = dpp_add<0x140>(v); return v; }
__device__ __forceinline__ void rwkv_scan_unit(Frame& F, int l, int b, int h, int q) {
    unsigned char* ws = F.ws; const Args& A = *F.a; const int tid = F.tid, lane = F.lane, wave = F.wave;
    const h16* R = (const h16*)(ws + WS_R); const h16* Kk = (const h16*)(ws + WS_K); const h16* V = (const h16*)(ws + WS_V);
    const h16* LW = (const h16*)(ws + WS_LW); const h16* AS = (const h16*)(ws + WS_ASIG);
    h16* Yg = (h16*)(ws + (b == 0 ? WS_YRW0 : WS_YRW1));
    LAS unsigned char* lds = F.lds;
    const size_t base = (size_t)b * T * RD + h * 64;
    if (wave >= 4) {
        const int c = lane; const float kkc = A.in[I_KK][l * RD + h * 64 + c], kac = A.in[I_KA][l * RD + h * 64 + c];
        for (int tile = 0; tile < T / RW_TS; ++tile) {
            LAS float* buf = (LAS float*)(lds + (tile & 1) * RW_BUF);
            float r[8], k[8], v[8], lw[8], as[8];
#pragma unroll
            for (int i = 0; i < 8; ++i) { const size_t idx = base + (size_t)(tile * RW_TS + (wave - 4) * 8 + i) * RD + c;
                r[i] = (float)R[idx]; k[i] = (float)Kk[idx]; v[i] = (float)V[idx]; lw[i] = (float)LW[idx]; as[i] = (float)AS[idx]; }
#pragma unroll
            for (int i = 0; i < 8; ++i) { const int tt = (wave - 4) * 8 + i;
                const float kkr = k[i] * kkc; const float n2 = wave_sum(kkr * kkr); const float kk = kkr * (1.0f / sqrtf(fmaxf(n2, 1e-12f)));
                const float bq = kk * as[i], kp = k[i] * (1.0f + (as[i] - 1.0f) * kac), w = __expf(lw[i]);
                const float brs = wave_sum(bq * r[i]), krs = wave_sum(kp * r[i]);
                buf[tt * 64 + c] = -kk; buf[2048 + tt * 64 + c] = w * r[i]; buf[4096 + tt * 64 + c] = w; buf[6144 + tt * 64 + c] = bq; buf[8192 + tt * 64 + c] = kp;
                if ((c >> 4) == q) buf[10240 + tt * 16 + (c & 15)] = v[i];
                if (c == 0) { buf[10752 + tt * 2] = brs; buf[10752 + tt * 2 + 1] = krs; } }
            __syncthreads();
        }
        __syncthreads();
    } else {
        const int row = tid >> 4, kq = tid & 15;
        float S0 = 0.f, S1 = 0.f, S2 = 0.f, S3 = 0.f;
        __syncthreads();
        for (int tile = 0; tile < T / RW_TS; ++tile) {
            const LAS float* buf = (const LAS float*)(lds + (tile & 1) * RW_BUF);
            float y0 = 0.f, y1 = 0.f;
#pragma unroll
            for (int tt = 0; tt < RW_TS; ++tt) {
                const f32x4 a4 = *(const LAS f32x4*)(buf + tt * 64 + 4 * kq), wr4 = *(const LAS f32x4*)(buf + 2048 + tt * 64 + 4 * kq), w4 = *(const LAS f32x4*)(buf + 4096 + tt * 64 + 4 * kq);
                const f32x4 b4 = *(const LAS f32x4*)(buf + 6144 + tt * 64 + 4 * kq), k4 = *(const LAS f32x4*)(buf + 8192 + tt * 64 + 4 * kq);
                const float vv = buf[10240 + tt * 16 + row]; const f32x2 sc = *(const LAS f32x2*)(buf + 10752 + tt * 2);
                float d1 = (S0 * a4[0] + S1 * a4[1]) + (S2 * a4[2] + S3 * a4[3]);
                float d2 = (S0 * wr4[0] + S1 * wr4[1]) + (S2 * wr4[2] + S3 * wr4[3]);
                d1 = red16(d1); d2 = red16(d2);
                S0 = S0 * w4[0] + d1 * b4[0] + vv * k4[0]; S1 = S1 * w4[1] + d1 * b4[1] + vv * k4[1];
                S2 = S2 * w4[2] + d1 * b4[2] + vv * k4[2]; S3 = S3 * w4[3] + d1 * b4[3] + vv * k4[3];
                const float y = d2 + d1 * sc.x + vv * sc.y;
                if (kq == (tt & 15)) { if (tt < 16) y0 = y; else y1 = y; }
            }
            { const size_t o = (size_t)(tile * RW_TS + kq) * RD + h * 64 + 16 * q + row; Yg[o] = (h16)y0; Yg[o + 16 * RD] = (h16)y1; }
            __syncthreads();
        }
    }
}

constexpr int AT_KB = 64 * 208, AT_VB = 8192, AT_K0 = 0, AT_V0 = 2 * AT_KB, AT_WS = AT_V0 + 2 * AT_VB, AT_TICKET = AT_WS + 8 * 256;
__device__ __forceinline__ int crow(int r, int hi) { return (r & 3) + 8 * (r >> 2) + 4 * hi; }
typedef short v4i16_t __attribute__((ext_vector_type(4)));
__device__ __forceinline__ h16x4 vtr(const LAS unsigned char* p) { return __builtin_bit_cast(h16x4, __builtin_amdgcn_ds_read_tr16_b64_v4i16((LAS v4i16_t*)p)); }
__device__ __forceinline__ void attn_unit(Frame& F, int b, int h, int qb) {
    unsigned char* ws = F.ws; const int tid = F.tid, lane = F.lane, wid = F.wave, r32 = lane & 31, hi = lane >> 5;
    const h16* Qc = (const h16*)(ws + WS_QC); const h16* Kc = (const h16*)(ws + WS_KC); const h16* Va = (const h16*)(ws + WS_VA); h16* O = (h16*)(ws + WS_OATT);
    LAS unsigned char* lds = F.lds; LAS float* wsf = (LAS float*)(lds + AT_WS + wid * 256);
    const size_t rowbase = (size_t)b * T; const int q0 = qb * 256;
    h16x8 qr[6];
    { const h16* Qw = Qc + (rowbase + q0 + wid * 32 + r32) * 768 + h * 96 + hi * 8;
#pragma unroll
        for (int d0 = 0; d0 < 6; ++d0) qr[d0] = *(const h16x8*)(Qw + d0 * 16); }
    const int kp0 = tid, kp1 = tid + 512; const int kk0 = kp0 / 12, kc0 = kp0 % 12, kk1 = kp1 / 12, kc1 = kp1 % 12; const bool has1 = kp1 < 768;
    const h16* ksrc0 = Kc + (rowbase + kk0) * 768 + h * 96 + 8 * kc0; const h16* ksrc1 = Kc + (rowbase + (has1 ? kk1 : 0)) * 768 + h * 96 + 8 * (has1 ? kc1 : 0);
    const int kdst0 = kk0 * 208 + kc0 * 16, kdst1 = kk1 * 208 + kc1 * 16;
    const int vk = tid >> 3, vc = tid & 7; const h16* vsrc = Va + (rowbase + vk) * 512 + h * 64 + 8 * vc;
    const int vdst = (vc >> 2) * 4096 + (vk >> 4) * 1024 + (vk & 15) * 64 + (vc & 3) * 16;
    const int NT = 4 * (qb + 1), my_last = 4 * qb + (wid >> 1);
    float m_run = -1e30f, l_run = 0.f; f32x16 o0 = {}, o1 = {};
    u32x4 kr0, kr1 = {0u, 0u, 0u, 0u}, vr;
    kr0 = *(const u32x4*)ksrc0; if (has1) kr1 = *(const u32x4*)ksrc1; vr = *(const u32x4*)vsrc;
    *(LAS u32x4*)(lds + AT_K0 + kdst0) = kr0; if (has1) *(LAS u32x4*)(lds + AT_K0 + kdst1) = kr1; *(LAS u32x4*)(lds + AT_V0 + vdst) = vr;
    __syncthreads();
    const int vfo = ((lane >> 4) & 1) * 32 + (lane & 3) * 8 + (4 * hi + ((lane & 15) >> 2)) * 64;
    for (int jt = 0; jt < NT; ++jt) {
        const bool more = jt + 1 < NT;
        if (more) { const size_t adv = (size_t)(jt + 1) * 64; kr0 = *(const u32x4*)(ksrc0 + adv * 768); if (has1) kr1 = *(const u32x4*)(ksrc1 + adv * 768); vr = *(const u32x4*)(vsrc + adv * 512); }
        if (jt <= my_last) {
            const LAS unsigned char* Kb = lds + AT_K0 + (jt & 1) * AT_KB; const LAS unsigned char* Vb = lds + AT_V0 + (jt & 1) * AT_VB;
            f32x16 p0 = {}, p1 = {};
#pragma unroll
            for (int d0 = 0; d0 < 6; ++d0) { const h16x8 k0 = *(const LAS h16x8*)(Kb + r32 * 208 + (2 * d0 + hi) * 16), k1 = *(const LAS h16x8*)(Kb + (32 + r32) * 208 + (2 * d0 + hi) * 16);
                p0 = __builtin_amdgcn_mfma_f32_32x32x16_f16(k0, qr[d0], p0, 0, 0, 0); p1 = __builtin_amdgcn_mfma_f32_32x32x16_f16(k1, qr[d0], p1, 0, 0, 0); }
            if (64 * jt + 63 > q0 + 32 * wid) { const int qpos = q0 + 32 * wid + r32, kb = 64 * jt + 4 * hi;
#pragma unroll
                for (int r = 0; r < 16; ++r) { const int kv = kb + (r & 3) + 8 * (r >> 2); if (kv > qpos) p0[r] = -INFINITY; if (kv + 32 > qpos) p1[r] = -INFINITY; } }
            float rm = fmaxf(p0[0], p1[0]);
#pragma unroll
            for (int r = 1; r < 16; ++r) rm = fmaxf(rm, fmaxf(p0[r], p1[r]));
            rm = fmaxf(rm, __shfl_xor(rm, 32));
            const float m_new = fmaxf(m_run, rm), alpha = __builtin_amdgcn_exp2f(m_run - m_new);
            const bool grow = __any(m_new > m_run);
            m_run = m_new;
            float sum = 0.f;
#pragma unroll
            for (int r = 0; r < 16; ++r) { p0[r] = __builtin_amdgcn_exp2f(p0[r] - m_new); p1[r] = __builtin_amdgcn_exp2f(p1[r] - m_new); sum += p0[r] + p1[r]; }
            l_run = l_run * alpha + sum;
            if (grow) { if (hi == 0) wsf[r32] = alpha; asm volatile("s_waitcnt lgkmcnt(0)" ::: "memory");
#pragma unroll
                for (int r = 0; r < 16; ++r) { const float f = wsf[crow(r, hi)]; o0[r] *= f; o1[r] *= f; } }
            h16x8 pa[4];
#pragma unroll
            for (int j = 0; j < 8; ++j) { pa[0][j] = (h16)p0[j]; pa[1][j] = (h16)p0[8 + j]; pa[2][j] = (h16)p1[j]; pa[3][j] = (h16)p1[8 + j]; }
#pragma unroll
            for (int ks = 0; ks < 4; ++ks) {
                const h16x4 a0 = vtr(Vb + vfo + ks * 1024), a1 = vtr(Vb + vfo + ks * 1024 + 512), c0 = vtr(Vb + vfo + 4096 + ks * 1024), c1 = vtr(Vb + vfo + 4096 + ks * 1024 + 512);
                const h16x8 v0 = {a0[0], a0[1], a0[2], a0[3], a1[0], a1[1], a1[2], a1[3]}, v1 = {c0[0], c0[1], c0[2], c0[3], c1[0], c1[1], c1[2], c1[3]};
                o0 = __builtin_amdgcn_mfma_f32_32x32x16_f16(pa[ks], v0, o0, 0, 0, 0); o1 = __builtin_amdgcn_mfma_f32_32x32x16_f16(pa[ks], v1, o1, 0, 0, 0); }
        }
        if (more) { LAS unsigned char* Kn = lds + AT_K0 + ((jt + 1) & 1) * AT_KB; LAS unsigned char* Vn = lds + AT_V0 + ((jt + 1) & 1) * AT_VB;
            *(LAS u32x4*)(Kn + kdst0) = kr0; if (has1) *(LAS u32x4*)(Kn + kdst1) = kr1; *(LAS u32x4*)(Vn + vdst) = vr; }
        __syncthreads();
    }
    l_run += __shfl_xor(l_run, 32);
    if (hi == 0) wsf[r32] = 1.0f / l_run;
    asm volatile("s_waitcnt lgkmcnt(0)" ::: "memory");
    h16* Ow = O + (rowbase + q0 + wid * 32) * 512 + h * 64 + r32;
#pragma unroll
    for (int r = 0; r < 16; ++r) { const int qr_ = crow(r, hi); const float f = wsf[qr_]; Ow[(size_t)qr_ * 512] = (h16)(o0[r] * f); Ow[(size_t)qr_ * 512 + 32] = (h16)(o1[r] * f); }
    __syncthreads();
}


typedef GAS unsigned gu32;
#define XB_TMO      128
#define XB_XCNT(j)  (256  + 64 * (j))
#define XB_XSUB(j)  (1280 + 64 * (j))
#define XB_XGEN(j)  (2304 + 64 * (j))
#define XB_TOP      3328
#define XB_TOPGEN   3392
#define XCD_BAR_WORDS 3456
#define XB_SPIN_CAP (1u << 22)
__device__ __forceinline__ unsigned xb_ld(unsigned* p)              { return __hip_atomic_load(p, __ATOMIC_RELAXED, __HIP_MEMORY_SCOPE_AGENT); }
__device__ __forceinline__ unsigned xb_add(unsigned* p, unsigned v) { return __hip_atomic_fetch_add(p, v, __ATOMIC_RELAXED, __HIP_MEMORY_SCOPE_AGENT); }
__device__ __forceinline__ unsigned xb_xcc_id() { return (unsigned)__builtin_amdgcn_s_getreg((3 << 11) | 20) & 0xFu; }
#define XB_SPIN(cond, bar) do { unsigned _sp = 0; while (cond) { __builtin_amdgcn_s_sleep(1); \
    if ((++_sp & 255u) == 0u) { if (xb_ld(&(bar)[XB_TMO])) break; if (_sp > XB_SPIN_CAP) { atomicAdd(&(bar)[XB_TMO], 1u); break; } } } } while (0)
struct XcdBarrier { unsigned* bar; unsigned x; volatile LAS unsigned* st; };
__device__ __forceinline__ XcdBarrier xcd_barrier_post(unsigned* bar, volatile LAS unsigned* st) {
    XcdBarrier b; b.bar = bar; b.x = xb_xcc_id(); b.st = st;
    if (threadIdx.x == 0) (void)xb_add(&bar[XB_XCNT(b.x)], 1u);
    return b;
}
__device__ __forceinline__ void xcd_barrier_complete(unsigned* bar, unsigned x, unsigned& nloc, unsigned& nx) {
    const unsigned G = gridDim.x * gridDim.y * gridDim.z;
    unsigned sum, cnt, mine, sp = 0u;
    for (;;) {
        sum = 0u; cnt = 0u; mine = 0u;
#pragma unroll
        for (unsigned j = 0; j < 16; ++j) { const unsigned c = xb_ld(&bar[XB_XCNT(j)]); sum += c; cnt += (c > 0u) ? 1u : 0u; mine = (j == x) ? c : mine; }
        if (sum == G) break;
        __builtin_amdgcn_s_sleep(1);
        if ((++sp & 255u) == 0u) { if (xb_ld(&bar[XB_TMO])) break; if (sp > XB_SPIN_CAP) { atomicAdd(&bar[XB_TMO], 1u); break; } }
    }
    nloc = mine > 0u ? mine : 1u; nx = cnt > 0u ? cnt : 1u;
}
__device__ __forceinline__ void xcd_barrier(const XcdBarrier& b) {
    asm volatile("s_waitcnt vmcnt(0)" ::: "memory");
    __syncthreads();
    if (threadIdx.x == 0) {
        unsigned* bar = b.bar;
        __builtin_amdgcn_s_waitcnt(0);
        unsigned nloc = b.st[0], nx = b.st[1];
        if (nloc == 0u) { xcd_barrier_complete(bar, b.x, nloc, nx); b.st[0] = nloc; b.st[1] = nx; }
        const unsigned old = xb_add(&bar[XB_XSUB(b.x)], 1u);
        const unsigned gen = old / nloc;
        if (old + 1u == (gen + 1u) * nloc) {
            __builtin_amdgcn_fence(__ATOMIC_RELEASE, "agent");
            asm volatile("s_waitcnt vmcnt(0)" ::: "memory");
            const unsigned og = xb_add(&bar[XB_TOP], 1u);
            const unsigned tg = og / nx;
            if (og + 1u == (tg + 1u) * nx) xb_add(&bar[XB_TOPGEN], 1u);
            else XB_SPIN(xb_ld(&bar[XB_TOPGEN]) == tg, bar);
            __builtin_amdgcn_fence(__ATOMIC_ACQUIRE, "agent");
            xb_add(&bar[XB_XGEN(b.x)], 1u);
            asm volatile("s_waitcnt vmcnt(0)" ::: "memory");
        } else {
            XB_SPIN(xb_ld(&bar[XB_XGEN(b.x)]) == gen, bar);
            __builtin_amdgcn_fence(__ATOMIC_ACQUIRE, "agent");
            asm volatile("s_waitcnt vmcnt(0)" ::: "memory");
        }
    }
    __syncthreads();
}

constexpr int NPH = 1 + 13 * DEPTH;
__device__ __forceinline__ void run_phase(Frame& F, int ph) {
    { int w_ = F.wave, b_ = F.bid; asm volatile("" : "+v"(F.tid), "+v"(F.lane), "+v"(w_), "+v"(b_)); F.wave = __builtin_amdgcn_readfirstlane(w_); F.bid = __builtin_amdgcn_readfirstlane(b_); }
    unsigned char* ws = F.ws; const Args& A = *F.a; LAS unsigned char* lds = F.lds;
    if (ph == 0) { phase_convert(F, 0); rows_to_h16(F, A.in[I_X], (h16*)(ws + WS_XH)); rope_table(F); return; }
    const int l = (ph - 1) / 13, k = (ph - 1) % 13 + 1;
    const float* xres = (l == 0) ? A.in[I_X] : A.out;
    switch (k) {
    case 1: { pg8::Gemm g{(const h16*)(ws + WS_XH), (const h16*)(ws + WS_WIN), 1024, 1024, 1024}; pg8::StaticOrder S; S.init(M, 2816, F.G, F.bid);
        EpiStoreSplit E{(h16*)(ws + WS_PRWKV), (h16*)(ws + WS_PMLA), (h16*)(ws + WS_U)}; pg8::gemm_phase(lds, g, S, E);
        } break;
    case 2: phase_prep(F, l); phase_s5<1>(F, l); break;
    case 3: {
        { pg8::Gemm g{(const h16*)(ws + WS_ALORA), (const h16*)(ws + WS_WLORA), 256, 256, 256}; pg8::StaticOrder S; S.init(M, 1536, F.G, F.bid);
          EpiLora E{(h16*)(ws + WS_LW), A.in[I_W0] + l * RD, A.in[I_A0] + l * RD}; pg8::gemm_phase(lds, g, S, E); }
        { pg8::Gemm g{(const h16*)(ws + WS_PMLA), (const h16*)(ws + WS_WQ), 512, 256, 256}; pg8::StaticOrder S; S.init(M, 768, F.G, F.bid);
          EpiQ E{(h16*)(ws + WS_QC), (const float*)(ws + WS_RSTDQ), (const float*)(ws + WS_COS), (const float*)(ws + WS_SIN)}; pg8::gemm_phase(lds, g, S, E); }
        { pg8::Gemm g{(const h16*)(ws + WS_PMLA) + 256, (const h16*)(ws + WS_WKV), 512, 128, 128}; pg8::StaticOrder S; S.init(M, 1024, F.G, F.bid);
          EpiKV E{(h16*)(ws + WS_KC), (h16*)(ws + WS_VA), (const float*)(ws + WS_RSTDKV)}; pg8::gemm_phase(lds, g, S, E); }
    } break;
    case 4: phase_s5<2>(F, l); break;
    case 5: {
        for (int rw = F.bid; rw < 64; rw += F.G) rwkv_scan_unit(F, l, rw >> 5, (rw >> 2) & 7, rw & 3);
        unsigned* qh = (unsigned*)(ws + WS_CTL) + CW_QUEUE * (1 + l); LAS unsigned* tk = (LAS unsigned*)(lds + AT_TICKET);
        for (;;) {
            if (F.tid == 0) tk[0] = __hip_atomic_fetch_add(qh, 1u, __ATOMIC_RELAXED, __HIP_MEMORY_SCOPE_AGENT);
            __syncthreads(); const unsigned u = tk[0]; __syncthreads();
            if (u >= 512u) break;
            attn_unit(F, (int)(u & 15u) >> 3, (int)(u & 7u), 31 - (int)(u >> 4));
        }
    } break;
    case 6: phase_rwkv_post(F, l, xres); break;
    case 7: { pg8::Gemm g{(const h16*)(ws + WS_XH2), (const h16*)(ws + WS_WG), 1024, 1024, 1024}; pg8::StaticOrder S; S.init(M, 3072, F.G, F.bid);
        EpiGate E{(h16*)(ws + WS_GATES), A.in[I_GATEB] + l * 3072}; pg8::gemm_phase(lds, g, S, E);
        } break;
    case 8: { pg8::StaticOrder S; S.init(M, 1024, F.G, F.bid); h16* mg = (h16*)(ws + WS_MERGED); const h16* gt = (const h16*)(ws + WS_GATES);
        for (int i = 0;; ++i) { Unit u; if (!S.next(i, u)) break;
            pg8::ListOrder L1{u, u, 1}; pg8::ListOrder L2{Unit{u.pm, 2 * u.pn}, Unit{u.pm, 2 * u.pn + 1}, 2};
            { pg8::Gemm g{(const h16*)(ws + WS_YAIN), (const h16*)(ws + WS_WRO), 512, 512, 512}; EpiBranch<0> E{mg, gt}; pg8::gemm_phase(lds, g, L1, E); }
            { pg8::Gemm g{(const h16*)(ws + WS_OATT), (const h16*)(ws + WS_WMO), 512, 512, 512}; EpiBranch<1> E{mg, gt}; pg8::gemm_phase(lds, g, L1, E); }
            { pg8::Gemm g{(const h16*)(ws + WS_YS5), (const h16*)(ws + WS_WGLU), 512, 512, 512}; EpiBranch<2> E{mg, gt}; pg8::gemm_phase(lds, g, L2, E); } }
    } break;
    case 9: { pg8::Gemm g{(const h16*)(ws + WS_MERGED), (const h16*)(ws + WS_WO), 1024, 1024, 1024}; pg8::StaticOrder S; S.init(M, 1024, F.G, F.bid);
        EpiPre E{xres, (float*)(ws + WS_PRE)}; pg8::gemm_phase(lds, g, S, E); } break;
    case 10: phase_ln(F, (const float*)(ws + WS_PRE), A.in[I_LN1G] + l * D, A.in[I_LN1B] + l * D, A.out, (h16*)(ws + WS_X1H)); break;
    case 11: { pg8::Gemm g{(const h16*)(ws + WS_X1H), (const h16*)(ws + WS_W13), 1024, 1024, 1024}; pg8::StaticOrder S; S.init(M, 5632, F.G, F.bid);
        EpiSwiGLU E{(h16*)(ws + WS_HB)}; pg8::gemm_phase(lds, g, S, E); } break;
    case 12: { pg8::Gemm g{(const h16*)(ws + WS_HB), (const h16*)(ws + WS_W2), DFF, DFF, DFF}; pg8::StaticOrder S; S.init(M, 1024, F.G, F.bid);
        EpiPre E{A.out, (float*)(ws + WS_PRE2)}; pg8::gemm_phase(lds, g, S, E); } break;
    case 13: phase_ln(F, (const float*)(ws + WS_PRE2), A.in[I_LN2G] + l * D, A.in[I_LN2B] + l * D, A.out, (h16*)(ws + WS_XH)); if (l + 1 < DEPTH) phase_convert(F, l + 1); break;
    }
}
__global__ void __launch_bounds__(NTHREADS, 2) fwd(Args args) {
    extern __shared__ __attribute__((aligned(16))) unsigned char lds_raw[];
    Frame F; F.lds = (LAS unsigned char*)lds_raw; F.tid = threadIdx.x; F.lane = F.tid & 63; F.wave = __builtin_amdgcn_readfirstlane(F.tid >> 6);
    F.G = gridDim.x; F.bid = blockIdx.x; F.ws = args.ws; F.a = &args;
    volatile LAS unsigned* MISC = (volatile LAS unsigned*)(F.lds + MISC_OFF);
    if (F.tid < 32) MISC[F.tid] = 0u;
    __syncthreads();
    XcdBarrier bar; bar.bar = (unsigned*)(args.ws + WS_CTL) + CW_BAR; bar.x = 0; bar.st = nullptr;
    if (args.one_launch) bar = xcd_barrier_post((unsigned*)(args.ws + WS_CTL) + CW_BAR, MISC + 8);
    for (int ph = args.ph_lo; ph < args.ph_hi; ++ph) {
        run_phase(F, ph);
        if (ph + 1 < args.ph_hi) xcd_barrier(bar);
    }
}

#ifndef MK_ONE_LAUNCH
#define MK_ONE_LAUNCH 1
#endif
extern "C" void kernel_launch(void* const* d_in, const int* in_sizes, int n_in, void* d_out, int out_size, void* d_ws, size_t ws_size, hipStream_t stream) {
    static int grid = 0;
    if (grid == 0) {
        if (n_in != 37 || out_size != M * D || ws_size < WS_END) { fprintf(stderr, "kernel_launch: unexpected shapes n_in %d out %d ws %zu\n", n_in, out_size, ws_size); grid = -1; return; }
        int dev = 0, cus = 0, per_cu = 0;
        if (hipGetDevice(&dev) != hipSuccess || hipDeviceGetAttribute(&cus, hipDeviceAttributeMultiprocessorCount, dev) != hipSuccess) { grid = -1; return; }
        if (hipFuncSetAttribute((const void*)fwd, hipFuncAttributeMaxDynamicSharedMemorySize, LDS_BYTES) != hipSuccess) { fprintf(stderr, "kernel_launch: hipFuncSetAttribute failed\n"); grid = -1; return; }
        if (hipOccupancyMaxActiveBlocksPerMultiprocessor(&per_cu, (const void*)fwd, NTHREADS, LDS_BYTES) != hipSuccess || per_cu < 1) { fprintf(stderr, "kernel_launch: occupancy query says %d\n", per_cu); (void)hipGetLastError(); grid = -1; return; }
        grid = cus;
    }
    if (grid < 0) return;
    (void)hipMemsetAsync((char*)d_ws + WS_CTL, 0, CTL_ZERO_BYTES, stream);
    Args a{};
    for (int i = 0; i < 37; ++i) a.in[i] = (const float*)d_in[i];
    a.out = (float*)d_out; a.ws = (unsigned char*)d_ws;
    for (int i = 0; i < 16; ++i) a.invfreq[i] = (float)pow(10000.0, -(double)i / 16.0);
    a.one_launch = MK_ONE_LAUNCH;
    if (MK_ONE_LAUNCH) { a.ph_lo = 0; a.ph_hi = NPH; hipLaunchKernelGGL(fwd, dim3(grid), dim3(NTHREADS), LDS_BYTES, stream, a); }
    else for (int ph = 0; ph < NPH; ++ph) { a.ph_lo = ph; a.ph_hi = ph + 1; hipLaunchKernelGGL(fwd, dim3(grid), dim3(NTHREADS), LDS_BYTES, stream, a);
    }
}
```

```cpp
#include <hip/hip_runtime.h>
#include <cstdio>
#include <cstdint>


#define LAS __attribute__((address_space(3)))
#define GAS __attribute__((address_space(1)))
typedef _Float16 h16;
typedef _Float16 h16x2 __attribute__((ext_vector_type(2)));
typedef _Float16 h16x4 __attribute__((ext_vector_type(4)));
typedef _Float16 h16x8 __attribute__((ext_vector_type(8)));
typedef float f32x2 __attribute__((ext_vector_type(2)));
typedef float f32x4 __attribute__((ext_vector_type(4)));
typedef float f32x16 __attribute__((ext_vector_type(16)));
typedef unsigned u32x2 __attribute__((ext_vector_type(2)));
typedef unsigned u32x4 __attribute__((ext_vector_type(4)));
typedef short s16x4 __attribute__((ext_vector_type(4)));

constexpr int BATCH = 2, T = 8192, D = 1024, M = BATCH * T, DEPTH = 2;
constexpr int RH = 8, RN = 64, RD = 512;
constexpr int RWKV_COLS = 1792, MLA_COLS = 416, IN_COLS = 5792, DFF = 2816;
constexpr int O_MLA = 1792, O_S5 = 2208, O_GATE = 2720;
constexpr float ALPHA = 1.4142135623730951f;
constexpr float LN_EPS = 1e-5f, RMS_EPS = 1e-6f, GN_EPS = 64e-5f;
constexpr float QSCALE = 0.10206207261596577f * 1.4426950408889634f;

__device__ __forceinline__ unsigned pkh(float lo, float hi) { h16x2 v = {(h16)lo, (h16)hi}; return __builtin_bit_cast(unsigned, v); }
__device__ __forceinline__ float sigm(float x) { return __builtin_amdgcn_rcpf(1.0f + __expf(-x)); }

namespace pg8 {
constexpr int BM = 256, BK = 64, HALF = 128, HTB = HALF * BK * 2, STAGE_BYTES = 8 * HTB, NXCD = 8, WGM = 8;
__host__ __device__ __forceinline__ int lds_byte(int r, int c) { const int st = (r >> 4) * 2 + (c >> 5), rr = r & 15, cc = c & 31, ob = rr * 64 + cc * 2; return st * 1024 + (ob ^ (((ob >> 9) & 1) << 5)); }
__host__ __device__ __forceinline__ void stage_rc(int b, int& R, int& C) { const int st = b / 1024, sb = b % 1024, swz = sb ^ (((sb >> 9) & 1) << 5); R = (st >> 1) * 16 + swz / 64; C = (st & 1) * 32 + (swz % 64) / 2; }
__host__ __device__ __forceinline__ int perm32(int rho) { const int n = rho >> 4, i = rho & 15; return 8 * (i >> 2) + 4 * n + (i & 3); }

struct Unit { int pm, pn; };
struct Gemm { const h16* A; const h16* Bt; int lda, ldb, K; };

struct StaticOrder {
    int nM, nN, nwg, G, c;
    __device__ __forceinline__ void init(int Mr, int N, int G_, int c_) { nM = Mr / BM; nN = N / BM; nwg = nM * nN; G = G_; c = c_; }
    __device__ __forceinline__ bool next(int i, Unit& u) const {
        const long L = (long)i * G + c; if (L >= nwg) return false;
        int wgid = (int)L; { const int q = nwg / NXCD, r = nwg % NXCD, xcd = wgid % NXCD, off = wgid / NXCD; wgid = (xcd < r ? xcd * (q + 1) : r * (q + 1) + (xcd - r) * q) + off; }
        const int nig = WGM * nN, gid = wgid / nig, fm = gid * WGM, gsz = (nM - fm) < WGM ? (nM - fm) : WGM;
        u.pm = fm + ((wgid % nig) % gsz); u.pn = (wgid % nig) / gsz; return true;
    }
};
struct ListOrder {
    Unit u0, u1; int n;
    __device__ __forceinline__ bool next(int i, Unit& u) const { if (i >= n) return false; u = (i == 0) ? u0 : u1; return true; }
};

template <class Epi, class Sched>
__device__ __forceinline__ void gemm_phase(LAS unsigned char* lds, const Gemm g, const Sched& S, const Epi& E) {
    int tid = threadIdx.x; asm volatile("" : "+v"(tid));
    const int wid = __builtin_amdgcn_readfirstlane(tid >> 6), lane = tid & 63, wr = wid >> 2, wc = wid & 3, fr = lane & 15, fq = lane >> 4;
    int K = g.K; asm volatile("" : "+s"(K)); const int nt = K / BK;
    unsigned voffA[2], voffB[2];
#pragma unroll
    for (int i = 0; i < 2; ++i) { int R, C; stage_rc(tid * 16 + i * 8192, R, C); const int Rb = Epi::PERM ? ((R & ~31) + perm32(R & 31)) : R;
        voffA[i] = (unsigned)(R * g.lda + C) * 2u; voffB[i] = (unsigned)(Rb * g.ldb + C) * 2u; }
    const size_t kstep = (size_t)(BK * 2);
    const size_t hstepA = (size_t)HALF * g.lda * 2, hstepB = (size_t)HALF * g.ldb * 2;
    const size_t tstepA = 2 * hstepA, tstepB = 2 * hstepB;
    const unsigned ldsw = (unsigned)wid * 1024u;
    const int aoff = lds_byte(wr * 64 + fr, fq * 8), boff = lds_byte(wc * 32 + fr, fq * 8);
#define PG8_SA(b, h) (((b) * 2 + (h)) * HTB)
#define PG8_SB(b, h) ((4 + (b) * 2 + (h)) * HTB)
#define PG8_STAGE(bufoff, gbase, voff) do { _Pragma("unroll") for (int _i = 0; _i < 2; ++_i) \
        __builtin_amdgcn_global_load_lds((const unsigned*)((const char*)(gbase) + (voff)[_i]), (LAS unsigned*)(lds + (bufoff) + ldsw + _i * 8192), 16, 0, 0); } while (0)
#define PG8_LDA(dst, b, h) do { _Pragma("unroll") for (int m = 0; m < 4; ++m) _Pragma("unroll") for (int k = 0; k < 2; ++k) dst[m][k] = *(const LAS h16x8*)(lds + PG8_SA(b, h) + aoff + m * 2048 + k * 1024); } while (0)
#define PG8_LDB(dst, b, h) do { _Pragma("unroll") for (int n = 0; n < 2; ++n) _Pragma("unroll") for (int k = 0; k < 2; ++k) dst[n][k] = *(const LAS h16x8*)(lds + PG8_SB(b, h) + boff + n * 2048 + k * 1024); } while (0)
#define PG8_MMA(ai, bj, At, Bt) do { __builtin_amdgcn_s_setprio(1); _Pragma("unroll") for (int m = 0; m < 4; ++m) _Pragma("unroll") for (int n = 0; n < 2; ++n) _Pragma("unroll") for (int k = 0; k < 2; ++k) \
        acc[ai][bj][m][n] = __builtin_amdgcn_mfma_f32_16x16x32_f16(Bt[n][k], At[m][k], acc[ai][bj][m][n], 0, 0, 0); __builtin_amdgcn_s_setprio(0); } while (0)
#define PG8_WAIT_V(n) asm volatile("s_waitcnt vmcnt(" #n ")" ::: "memory")
#define PG8_WAIT_L(n) asm volatile("s_waitcnt lgkmcnt(" #n ")" ::: "memory")
#define PG8_BAR __builtin_amdgcn_s_barrier()
#define PG8_SCHED __builtin_amdgcn_sched_barrier(0)
    Unit cur, nxt; int ui = 0;
    if (!S.next(0, cur)) return;
    f32x4 acc[2][2][4][2];
#pragma unroll
    for (int a = 0; a < 2; ++a)
#pragma unroll
        for (int b = 0; b < 2; ++b)
#pragma unroll
            for (int m = 0; m < 4; ++m)
#pragma unroll
                for (int n = 0; n < 2; ++n) acc[a][b][m][n] = (f32x4){0.f, 0.f, 0.f, 0.f};
    h16x8 At[4][2], B0[2][2], B1[2][2];
    const char* cA = (const char*)g.A + (size_t)cur.pm * tstepA; const char* cB = (const char*)g.Bt + (size_t)cur.pn * tstepB;
    {
        PG8_STAGE(PG8_SB(0, 0), cB, voffB); PG8_STAGE(PG8_SB(0, 1), cB + hstepB, voffB); PG8_STAGE(PG8_SA(0, 0), cA, voffA); PG8_STAGE(PG8_SA(0, 1), cA + hstepA, voffA);
        if (wr == 1) PG8_BAR;
        PG8_WAIT_V(2); PG8_BAR;
        PG8_STAGE(PG8_SB(1, 0), cB + kstep, voffB); PG8_STAGE(PG8_SA(1, 0), cA + kstep, voffA); PG8_STAGE(PG8_SB(1, 1), cB + hstepB + kstep, voffB);
        PG8_WAIT_V(6); PG8_BAR;
    }
    for (;;) {
        const bool has_next = S.next(ui + 1, nxt);
        const char* nA = has_next ? (const char*)g.A + (size_t)nxt.pm * tstepA : cA; const char* nB = has_next ? (const char*)g.Bt + (size_t)nxt.pn * tstepB : cB;
        for (int t = 0; t < nt; t += 2) {
            const bool last = (t == nt - 2);
            const char* a1 = cA + (size_t)(t + 1) * kstep;
            const char* a2 = last ? nA : cA + (size_t)(t + 2) * kstep; const char* b2 = last ? nB : cB + (size_t)(t + 2) * kstep;
            const char* a3 = a2 + kstep; const char* b3 = b2 + kstep;
            PG8_LDB(B0, 0, 0); PG8_LDB(B1, 0, 1); PG8_SCHED; PG8_LDA(At, 0, 0); PG8_STAGE(PG8_SA(1, 1), a1 + hstepA, voffA);
            PG8_WAIT_V(8); PG8_WAIT_L(0); PG8_BAR; PG8_MMA(0, 0, At, B0); PG8_MMA(0, 1, At, B1); PG8_BAR; PG8_SCHED;
            PG8_LDA(At, 0, 1); PG8_STAGE(PG8_SB(0, 0), b2, voffB); PG8_STAGE(PG8_SB(0, 1), b2 + hstepB, voffB); PG8_STAGE(PG8_SA(0, 0), a2, voffA);
            PG8_WAIT_V(8); PG8_WAIT_L(0); PG8_BAR; PG8_MMA(1, 0, At, B0); PG8_MMA(1, 1, At, B1); PG8_BAR; PG8_SCHED;
            PG8_LDB(B0, 1, 0); PG8_LDB(B1, 1, 1); PG8_SCHED; PG8_LDA(At, 1, 0); PG8_STAGE(PG8_SA(0, 1), a2 + hstepA, voffA);
            PG8_WAIT_V(8); PG8_WAIT_L(0); PG8_BAR; PG8_MMA(0, 0, At, B0); PG8_MMA(0, 1, At, B1); PG8_BAR; PG8_SCHED;
            PG8_LDA(At, 1, 1); PG8_STAGE(PG8_SB(1, 0), b3, voffB); PG8_STAGE(PG8_SB(1, 1), b3 + hstepB, voffB); PG8_STAGE(PG8_SA(1, 0), a3, voffA);
            PG8_WAIT_V(8); PG8_WAIT_L(0); PG8_BAR; PG8_MMA(1, 0, At, B0); PG8_MMA(1, 1, At, B1); PG8_BAR; PG8_SCHED;
        }
        if (wr == 0) PG8_BAR;
        { int fr_ = fr, fq_ = fq; asm volatile("" : "+v"(fr_), "+v"(fq_)); E(acc, cur, wr, wc, fr_, fq_); }
        if (!has_next) break;
#pragma unroll
        for (int a = 0; a < 2; ++a)
#pragma unroll
            for (int b = 0; b < 2; ++b)
#pragma unroll
                for (int m = 0; m < 4; ++m)
#pragma unroll
                    for (int n = 0; n < 2; ++n) acc[a][b][m][n] = (f32x4){0.f, 0.f, 0.f, 0.f};
        cur = nxt; cA = nA; cB = nB; ++ui;
        if (wr == 1) PG8_BAR;
    }
    PG8_WAIT_V(0);
    PG8_BAR;
#undef PG8_SA
#undef PG8_SB
#undef PG8_STAGE
#undef PG8_LDA
#undef PG8_LDB
#undef PG8_MMA
#undef PG8_WAIT_V
#undef PG8_WAIT_L
#undef PG8_BAR
#undef PG8_SCHED
}
}

using pg8::Unit; using pg8::HALF; using pg8::BM;
struct EpiStoreSplit {
    static constexpr bool PERM = true;
    h16* p_rwkv; h16* p_mla; h16* u;
    __device__ __forceinline__ void operator()(const f32x4 (&acc)[2][2][4][2], const Unit& un, int wr, int wc, int fr, int fq) const {
        h16* base; int ldc, colt;
        if (un.pn < 7) { base = p_rwkv; ldc = RWKV_COLS; colt = un.pn * BM; } else if (un.pn < 9) { base = p_mla; ldc = 512; colt = (un.pn - 7) * BM; } else { base = u; ldc = 512; colt = (un.pn - 9) * BM; }
        const int row0 = un.pm * BM + wr * 64 + fr, col0 = colt + wc * 32 + 8 * fq;
#pragma unroll
        for (int ai = 0; ai < 2; ++ai)
#pragma unroll
            for (int m = 0; m < 4; ++m) { h16* rowp = base + (size_t)(row0 + ai * HALF + m * 16) * ldc + col0;
#pragma unroll
                for (int bj = 0; bj < 2; ++bj) { const f32x4 v0 = acc[ai][bj][m][0], v1 = acc[ai][bj][m][1];
                    u32x4 w; w.x = pkh(v0[0], v0[1]); w.y = pkh(v0[2], v0[3]); w.z = pkh(v1[0], v1[1]); w.w = pkh(v1[2], v1[3]);
                    *(u32x4*)(rowp + bj * HALF) = w; } }
    }
};
struct EpiLora {
    static constexpr bool PERM = true;
    h16* lw; const float* w0; const float* a0;
    __device__ __forceinline__ void operator()(const f32x4 (&acc)[2][2][4][2], const Unit& un, int wr, int wc, int fr, int fq) const {
        const int kind = un.pn >> 1; h16* base = lw + (size_t)kind * (size_t)(8u << 20); const float* bias = kind == 0 ? w0 : a0;
        const int colt = (un.pn & 1) * BM; const int row0 = un.pm * BM + wr * 64 + fr, col0 = colt + wc * 32 + 8 * fq;
        f32x4 bv[2][2];
#pragma unroll
        for (int bj = 0; bj < 2; ++bj)
#pragma unroll
            for (int n = 0; n < 2; ++n) bv[bj][n] = kind < 2 ? *(const f32x4*)(bias + col0 + bj * HALF + 4 * n) : (f32x4){0.f, 0.f, 0.f, 0.f};
#pragma unroll
        for (int ai = 0; ai < 2; ++ai)
#pragma unroll
            for (int m = 0; m < 4; ++m) { h16* rowp = base + (size_t)(row0 + ai * HALF + m * 16) * RD + col0;
#pragma unroll
                for (int bj = 0; bj < 2; ++bj) { f32x4 v0 = acc[ai][bj][m][0] + bv[bj][0], v1 = acc[ai][bj][m][1] + bv[bj][1];
                    if (kind < 2) { const float sc = kind == 0 ? -0.6065306597126334f : 1.0f;
#pragma unroll
                        for (int e = 0; e < 4; ++e) { v0[e] = sc * sigm(v0[e]); v1[e] = sc * sigm(v1[e]); } }
                    u32x4 w; w.x = pkh(v0[0], v0[1]); w.y = pkh(v0[2], v0[3]); w.z = pkh(v1[0], v1[1]); w.w = pkh(v1[2], v1[3]);
                    *(u32x4*)(rowp + bj * HALF) = w; } }
    }
};
struct EpiQ {
    static constexpr bool PERM = false;
    h16* Qc; const float* rstd; const float* cosT; const float* sinT;
    __device__ __forceinline__ void operator()(const f32x4 (&acc)[2][2][4][2], const Unit& un, int wr, int wc, int fr, int fq) const {
        const int row0 = un.pm * BM + wr * 64 + fr;
#pragma unroll
        for (int ai = 0; ai < 2; ++ai)
#pragma unroll
            for (int m = 0; m < 4; ++m) { const int row = row0 + ai * HALF + m * 16; const float rs = rstd[row] * QSCALE; const int pos = row & (T - 1);
                const f32x4 cs = *(const f32x4*)(cosT + pos * 16 + 4 * fq), sn = *(const f32x4*)(sinT + pos * 16 + 4 * fq);
#pragma unroll
                for (int bj = 0; bj < 2; ++bj) { const int cb = un.pn * 8 + bj * 4 + wc;
                    f32x4 v0 = acc[ai][bj][m][0] * rs, v1 = acc[ai][bj][m][1] * rs;
                    if (cb % 3 == 2) { const f32x4 a = v0, b = v1; v0 = a * cs - b * sn; v1 = b * cs + a * sn; }
                    h16* p = Qc + (size_t)row * 768 + cb * 32 + 4 * fq;
                    u32x2 w0; w0.x = pkh(v0[0], v0[1]); w0.y = pkh(v0[2], v0[3]); *(u32x2*)p = w0;
                    u32x2 w1; w1.x = pkh(v1[0], v1[1]); w1.y = pkh(v1[2], v1[3]); *(u32x2*)(p + 16) = w1; } }
    }
};
struct EpiKV {
    static constexpr bool PERM = true;
    h16* Kc; h16* Va; const float* rstd;
    __device__ __forceinline__ void operator()(const f32x4 (&acc)[2][2][4][2], const Unit& un, int wr, int wc, int fr, int fq) const {
        const int row0 = un.pm * BM + wr * 64 + fr;
#pragma unroll
        for (int ai = 0; ai < 2; ++ai)
#pragma unroll
            for (int m = 0; m < 4; ++m) { const int row = row0 + ai * HALF + m * 16; const float rs = rstd[row];
#pragma unroll
                for (int bj = 0; bj < 2; ++bj) { const int c = un.pn * BM + bj * HALF + wc * 32 + 8 * fq, h = c >> 7, w = c & 127;
                    const f32x4 v0 = acc[ai][bj][m][0] * rs, v1 = acc[ai][bj][m][1] * rs;
                    u32x4 o; o.x = pkh(v0[0], v0[1]); o.y = pkh(v0[2], v0[3]); o.z = pkh(v1[0], v1[1]); o.w = pkh(v1[2], v1[3]);
                    h16* p = (w < 64) ? Kc + (size_t)row * 768 + h * 96 + w : Va + (size_t)row * 512 + h * 64 + (w - 64);
                    *(u32x4*)p = o; } }
    }
};
struct EpiGate {
    static constexpr bool PERM = true;
    h16* gates; const float* gb;
    __device__ __forceinline__ void operator()(const f32x4 (&acc)[2][2][4][2], const Unit& un, int wr, int wc, int fr, int fq) const {
        const int row0 = un.pm * BM + wr * 64 + fr, col0 = un.pn * BM + wc * 32 + 8 * fq;
        f32x4 bv[2][2];
#pragma unroll
        for (int bj = 0; bj < 2; ++bj)
#pragma unroll
            for (int n = 0; n < 2; ++n) bv[bj][n] = *(const f32x4*)(gb + col0 + bj * HALF + 4 * n);
#pragma unroll
        for (int ai = 0; ai < 2; ++ai)
#pragma unroll
            for (int m = 0; m < 4; ++m) { h16* rowp = gates + (size_t)(row0 + ai * HALF + m * 16) * 3072 + col0;
#pragma unroll
                for (int bj = 0; bj < 2; ++bj) { f32x4 v0 = acc[ai][bj][m][0] + bv[bj][0], v1 = acc[ai][bj][m][1] + bv[bj][1];
#pragma unroll
                    for (int e = 0; e < 4; ++e) { v0[e] = sigm(v0[e]); v1[e] = sigm(v1[e]); }
                    u32x4 w; w.x = pkh(v0[0], v0[1]); w.y = pkh(v0[2], v0[3]); w.z = pkh(v1[0], v1[1]); w.w = pkh(v1[2], v1[3]);
                    *(u32x4*)(rowp + bj * HALF) = w; } }
    }
};
__device__ __forceinline__ void unpk8(const u32x4 w, float (&o)[8]) {
    const unsigned a0 = w.x, a1 = w.y, a2 = w.z, a3 = w.w;
    const h16x2 h0 = __builtin_bit_cast(h16x2, a0), h1 = __builtin_bit_cast(h16x2, a1), h2 = __builtin_bit_cast(h16x2, a2), h3 = __builtin_bit_cast(h16x2, a3);
    o[0] = (float)h0[0]; o[1] = (float)h0[1]; o[2] = (float)h1[0]; o[3] = (float)h1[1]; o[4] = (float)h2[0]; o[5] = (float)h2[1]; o[6] = (float)h3[0]; o[7] = (float)h3[1];
}
__device__ __forceinline__ f32x4 h4_to_f4(u32x2 q) { const unsigned q0 = q.x, q1 = q.y; const h16x2 a = __builtin_bit_cast(h16x2, q0), b = __builtin_bit_cast(h16x2, q1); return (f32x4){(float)a[0], (float)a[1], (float)b[0], (float)b[1]}; }
template <int KIND> struct EpiBranch {
    static constexpr bool PERM = true;
    h16* merged; const h16* gates;
    __device__ __forceinline__ void operator()(const f32x4 (&acc)[2][2][4][2], const Unit& un, int wr, int wc, int fr, int fq) const {
        const int row0 = un.pm * BM + wr * 64 + fr;
#pragma unroll
        for (int ai = 0; ai < 2; ++ai)
#pragma unroll
            for (int m = 0; m < 4; ++m) { const int row = row0 + ai * HALF + m * 16;
#pragma unroll
                for (int bj = 0; bj < (KIND == 2 ? 1 : 2); ++bj) {
                    const int col = (KIND == 2 ? un.pn * HALF : un.pn * BM + bj * HALF) + wc * 32 + 8 * fq;
                    float v[8];
                    if (KIND == 2) { const f32x4 a0 = acc[ai][0][m][0], a1 = acc[ai][0][m][1], b0 = acc[ai][1][m][0], b1 = acc[ai][1][m][1];
#pragma unroll
                        for (int e = 0; e < 4; ++e) { v[e] = a0[e] * sigm(b0[e]); v[4 + e] = a1[e] * sigm(b1[e]); } }
                    else { const f32x4 a0 = acc[ai][bj][m][0], a1 = acc[ai][bj][m][1];
#pragma unroll
                        for (int e = 0; e < 4; ++e) { v[e] = a0[e]; v[4 + e] = a1[e]; } }
                    float gt[8]; unpk8(*(const u32x4*)(gates + (size_t)row * 3072 + KIND * 1024 + col), gt);
                    h16* mp = merged + (size_t)row * 1024 + col;
                    if (KIND != 0) { float old[8]; unpk8(*(const u32x4*)mp, old);
#pragma unroll
                        for (int e = 0; e < 8; ++e) v[e] = old[e] + gt[e] * v[e]; }
                    else {
#pragma unroll
                        for (int e = 0; e < 8; ++e) v[e] = gt[e] * v[e]; }
                    u32x4 w; w.x = pkh(v[0], v[1]); w.y = pkh(v[2], v[3]); w.z = pkh(v[4], v[5]); w.w = pkh(v[6], v[7]);
                    *(u32x4*)mp = w; } }
    }
};
struct EpiPre {
    static constexpr bool PERM = false;
    const float* xres; float* pre;
    __device__ __forceinline__ void operator()(const f32x4 (&acc)[2][2][4][2], const Unit& un, int wr, int wc, int fr, int fq) const {
        const int row0 = un.pm * BM + wr * 64 + fr, col0 = un.pn * BM + wc * 32 + 4 * fq;
#pragma unroll
        for (int ai = 0; ai < 2; ++ai)
#pragma unroll
            for (int m = 0; m < 4; ++m) { const size_t off = (size_t)(row0 + ai * HALF + m * 16) * D + col0;
#pragma unroll
                for (int bj = 0; bj < 2; ++bj)
#pragma unroll
                    for (int n = 0; n < 2; ++n) { const f32x4 xr = *(const f32x4*)(xres + off + bj * HALF + n * 16);
                        *(f32x4*)(pre + off + bj * HALF + n * 16) = xr * ALPHA + acc[ai][bj][m][n]; } }
    }
};
struct EpiSwiGLU {
    static constexpr bool PERM = true;
    h16* hb;
    __device__ __forceinline__ void operator()(const f32x4 (&acc)[2][2][4][2], const Unit& un, int wr, int wc, int fr, int fq) const {
        const int row0 = un.pm * BM + wr * 64 + fr, col0 = un.pn * HALF + wc * 32 + 8 * fq;
#pragma unroll
        for (int ai = 0; ai < 2; ++ai)
#pragma unroll
            for (int m = 0; m < 4; ++m) { const f32x4 a0 = acc[ai][0][m][0], a1 = acc[ai][0][m][1], b0 = acc[ai][1][m][0], b1 = acc[ai][1][m][1]; float v[8];
#pragma unroll
                for (int e = 0; e < 4; ++e) { v[e] = a0[e] * sigm(a0[e]) * b0[e]; v[4 + e] = a1[e] * sigm(a1[e]) * b1[e]; }
                u32x4 w; w.x = pkh(v[0], v[1]); w.y = pkh(v[2], v[3]); w.z = pkh(v[4], v[5]); w.w = pkh(v[6], v[7]);
                *(u32x4*)(hb + (size_t)(row0 + ai * HALF + m * 16) * DFF + col0) = w; }
    }
};

constexpr size_t MiB = 1u << 20;
constexpr size_t WS_CTL = 0, CTL_ZERO_BYTES = 1 * MiB;
constexpr size_t WS_COS = 1 * MiB, WS_SIN = 1 * MiB + 512 * 1024;
constexpr size_t WS_RSTDQ = 2 * MiB, WS_RSTDKV = 2 * MiB + 64 * 1024;
constexpr size_t WS_BS = 3 * MiB + 512 * 1024;
constexpr size_t WS_S5END = 2 * MiB + 512 * 1024;
constexpr size_t WS_WIN = 4 * MiB;
constexpr size_t WS_WG = WS_WIN + 5632 * 1024;
constexpr size_t WS_WLORA = WS_WG + 6 * MiB;
constexpr size_t WS_WQ = WS_WLORA + 768 * 1024;
constexpr size_t WS_WKV = WS_WQ + 384 * 1024;
constexpr size_t WS_WRO = WS_WKV + 256 * 1024;
constexpr size_t WS_WMO = WS_WRO + 1 * MiB;
constexpr size_t WS_WGLU = WS_WMO + 1 * MiB;
constexpr size_t WS_WO = WS_WGLU + 2 * MiB;
constexpr size_t WS_W13 = WS_WO + 2 * MiB;
constexpr size_t WS_W2 = WS_W13 + 11 * MiB;
static_assert(WS_W2 + 5632 * 1024 <= 40 * MiB, "weights region");
constexpr size_t SLOT0 = 40 * MiB, SLOT = 8 * MiB;
#define WS_SLOT(s) (SLOT0 + (size_t)(s) * SLOT)
constexpr size_t WS_XH = WS_SLOT(0), WS_PRWKV = WS_SLOT(4), WS_PMLA = WS_SLOT(11), WS_U = WS_SLOT(13);
constexpr size_t WS_KC = WS_SLOT(1), WS_ALORA = WS_SLOT(0), WS_R = WS_SLOT(15), WS_K = WS_SLOT(17), WS_V = WS_SLOT(19);
constexpr size_t WS_LW = WS_SLOT(5), WS_ASIG = WS_SLOT(7), WS_G = WS_SLOT(9), WS_QC = WS_SLOT(21), WS_VA = WS_SLOT(24);
constexpr size_t WS_YS5 = WS_SLOT(11), WS_OATT = WS_SLOT(13), WS_YRW0 = WS_SLOT(0), WS_YRW1 = WS_SLOT(26);
constexpr size_t WS_XH2 = WS_SLOT(3), WS_YAIN = WS_SLOT(1), WS_GATES = WS_SLOT(15), WS_MERGED = WS_SLOT(7);
constexpr size_t WS_PRE = WS_SLOT(11), WS_X1H = WS_SLOT(0), WS_HB = WS_SLOT(4), WS_PRE2 = WS_SLOT(15);
constexpr size_t WS_END = WS_SLOT(27);
static_assert(WS_ASIG == WS_LW + 16 * MiB && WS_G == WS_LW + 32 * MiB, "EpiLora strides");
static_assert(WS_END == 256 * MiB, "ws map");
constexpr int CW_BAR = 4096;
constexpr int CW_QUEUE = 64;

constexpr int LDS_BYTES = 147456;
constexpr int MISC_OFF = 131072 + 320;
constexpr int NWAVES = 8, NTHREADS = 512;

struct Args {
    const float* in[37]; float* out; unsigned char* ws; float invfreq[16]; int ph_lo, ph_hi; int one_launch, pad;
};
enum { I_X = 0, I_WIN, I_MU, I_W0, I_W2, I_A0, I_A2, I_G2, I_KK, I_KA, I_RK, I_GNG, I_GNB, I_ROUT, I_QNORM, I_QUP, I_KVNORM, I_KVUP, I_MOUT,
       I_LRE, I_LIM, I_LSTEP, I_BRE, I_BIM, I_CRE, I_CIM, I_S5D, I_GLU, I_GATEB, I_WOUT, I_LN1G, I_LN1B, I_W1, I_W3, I_FW2, I_LN2G, I_LN2B };

struct Frame {
    LAS unsigned char* lds; int tid, lane, wave, G, bid; unsigned char* ws; const Args* a;
};
__device__ __forceinline__ float wave_sum(float v) {
#pragma unroll
    for (int o = 1; o < 64; o <<= 1) v += __shfl_xor(v, o);
    return v;
}

__device__ __forceinline__ void cvt_item(const float* src, int ldsrc, int k0, int n0, h16* dst, int lddst, int drow0, int dk0, const float* kscale, LAS float* scr, int lane) {
    if (src) {
#pragma unroll 8
        for (int i = 0; i < 32; ++i) { const int kk = 2 * i + (lane >> 5); float v = src[(size_t)(k0 + kk) * ldsrc + n0 + (lane & 31)]; if (kscale) v *= kscale[k0 + kk]; scr[kk * 33 + (lane & 31)] = v; }
    }
    asm volatile("s_waitcnt lgkmcnt(0)" ::: "memory");
    const int c = lane & 7;
#pragma unroll
    for (int j = 0; j < 4; ++j) { const int n = (lane >> 3) + 8 * j; const LAS float* s = scr + (8 * c) * 33 + n;
        u32x4 o = {0u, 0u, 0u, 0u};
        if (src) { o.x = pkh(s[0 * 33], s[1 * 33]); o.y = pkh(s[2 * 33], s[3 * 33]); o.z = pkh(s[4 * 33], s[5 * 33]); o.w = pkh(s[6 * 33], s[7 * 33]); }
        *(u32x4*)(dst + (size_t)(drow0 + n) * lddst + dk0 + 8 * c) = o; }
    asm volatile("s_waitcnt lgkmcnt(0)" ::: "memory");
}
__device__ __forceinline__ void phase_convert(Frame& F, int l) {
    LAS float* scr = (LAS float*)(F.lds + F.wave * 16384);
    const int gw = F.bid * NWAVES + F.wave, NGW = F.G * NWAVES; unsigned char* ws = F.ws; const Args& A = *F.a;
    const float* win = A.in[I_WIN] + (size_t)l * D * IN_COLS;
    constexpr int N_WIN = 16 * 88, N_WG = 16 * 96, N_LORA = 4 * 48, N_Q = 4 * 24, N_KV = 2 * 32, N_RO = 8 * 32, N_MO = 8 * 32, N_GLU = 8 * 64, N_O = 16 * 32, N_13 = 16 * 176, N_2 = 44 * 32;
    constexpr int NITEMS = N_WIN + N_WG + N_LORA + N_Q + N_KV + N_RO + N_MO + N_GLU + N_O + N_13 + N_2;
    for (int it = gw; it < NITEMS; it += NGW) {
        int r = it;
        if (r < N_WIN) { const int kb = r / 88, db = r % 88;
            int sc; if (db < 56) sc = 32 * db; else if (db < 69) sc = O_MLA + 32 * (db - 56); else if (db < 72) sc = -1; else sc = O_S5 + 32 * (db - 72);
            cvt_item(sc >= 0 ? win : nullptr, IN_COLS, 64 * kb, sc, (h16*)(ws + WS_WIN), 1024, 32 * db, 64 * kb, nullptr, scr, F.lane); continue; } r -= N_WIN;
        if (r < N_WG) { const int kb = r / 96, db = r % 96;
            cvt_item(win, IN_COLS, 64 * kb, O_GATE + 32 * db, (h16*)(ws + WS_WG), 1024, 32 * db, 64 * kb, nullptr, scr, F.lane); continue; } r -= N_WG;
        if (r < N_LORA) { const int kb = r / 48, db = r % 48; const float* s = nullptr; int k0 = 0, n0 = 0;
            if (db < 16) { if (kb == 0) { s = A.in[I_W2] + (size_t)l * 64 * 512; k0 = 0; n0 = 32 * db; } }
            else if (db < 32) { if (kb == 1) { s = A.in[I_A2] + (size_t)l * 64 * 512; k0 = 0; n0 = 32 * (db - 16); } }
            else { if (kb >= 2) { s = A.in[I_G2] + (size_t)l * 128 * 512; k0 = 64 * (kb - 2); n0 = 32 * (db - 32); } }
            cvt_item(s, 512, k0, n0, (h16*)(ws + WS_WLORA), 256, 32 * db, 64 * kb, nullptr, scr, F.lane); continue; } r -= N_LORA;
        if (r < N_Q) { const int kb = r / 24, db = r % 24;
            cvt_item(A.in[I_QUP] + (size_t)l * 256 * 768, 768, 64 * kb, 32 * db, (h16*)(ws + WS_WQ), 256, 32 * db, 64 * kb, A.in[I_QNORM] + l * 256, scr, F.lane); continue; } r -= N_Q;
        if (r < N_KV) { const int kb = r / 32, db = r % 32;
            cvt_item(A.in[I_KVUP] + (size_t)l * 128 * 1024, 1024, 64 * kb, 32 * db, (h16*)(ws + WS_WKV), 128, 32 * db, 64 * kb, A.in[I_KVNORM] + l * 128, scr, F.lane); continue; } r -= N_KV;
        if (r < N_RO) { const int kb = r / 32, db = r % 32;
            cvt_item(A.in[I_ROUT] + (size_t)l * 512 * 1024, 1024, 64 * kb, 32 * db, (h16*)(ws + WS_WRO), 512, 32 * db, 64 * kb, nullptr, scr, F.lane); continue; } r -= N_RO;
        if (r < N_MO) { const int kb = r / 32, db = r % 32;
            cvt_item(A.in[I_MOUT] + (size_t)l * 512 * 1024, 1024, 64 * kb, 32 * db, (h16*)(ws + WS_WMO), 512, 32 * db, 64 * kb, nullptr, scr, F.lane); continue; } r -= N_MO;
        if (r < N_GLU) { const int kb = r / 64, db = r % 64, t = db >> 3, w = db & 7; const int sc = (w < 4) ? 128 * t + 32 * w : 1024 + 128 * t + 32 * (w - 4);
            cvt_item(A.in[I_GLU] + (size_t)l * 512 * 2048, 2048, 64 * kb, sc, (h16*)(ws + WS_WGLU), 512, 32 * db, 64 * kb, nullptr, scr, F.lane); continue; } r -= N_GLU;
        if (r < N_O) { const int kb = r / 32, db = r % 32;
            cvt_item(A.in[I_WOUT] + (size_t)l * 1024 * 1024, 1024, 64 * kb, 32 * db, (h16*)(ws + WS_WO), 1024, 32 * db, 64 * kb, nullptr, scr, F.lane); continue; } r -= N_O;
        if (r < N_13) { const int kb = r / 176, db = r % 176, t = db >> 3, w = db & 7; const float* s = (w < 4 ? A.in[I_W1] : A.in[I_W3]) + (size_t)l * 1024 * DFF;
            cvt_item(s, DFF, 64 * kb, 128 * t + 32 * (w & 3), (h16*)(ws + WS_W13), 1024, 32 * db, 64 * kb, nullptr, scr, F.lane); continue; } r -= N_13;
        { const int kb = r / 32, db = r % 32;
            cvt_item(A.in[I_FW2] + (size_t)l * DFF * 1024, 1024, 64 * kb, 32 * db, (h16*)(ws + WS_W2), DFF, 32 * db, 64 * kb, nullptr, scr, F.lane); }
    }
}
__device__ __forceinline__ void rows_to_h16(Frame& F, const float* x, h16* xh) {
    const int gw = F.bid * NWAVES + F.wave, NGW = F.G * NWAVES;
    for (int m = gw; m < M; m += NGW) { const f32x4* xr = (const f32x4*)(x + (size_t)m * D) + F.lane; u32x2* o = (u32x2*)(xh + (size_t)m * D) + F.lane;
#pragma unroll
        for (int j = 0; j < 4; ++j) { const f32x4 v = xr[64 * j]; u32x2 w; w.x = pkh(v.x, v.y); w.y = pkh(v.z, v.w); o[64 * j] = w; } }
}
__device__ __forceinline__ void rope_table(Frame& F) {
    float* cosT = (float*)(F.ws + WS_COS); float* sinT = (float*)(F.ws + WS_SIN);
    for (int i = F.bid * NTHREADS + F.tid; i < T * 16; i += F.G * NTHREADS) { const int pos = i >> 4, f = i & 15; const float ang = (float)pos * exp2f(-(float)f * 0.8304820237218406f); float s, c; sincosf(ang, &s, &c); cosT[i] = c; sinT[i] = s; }
}
__device__ __forceinline__ void phase_ln(Frame& F, const float* pre, const float* g, const float* b, float* xo, h16* xoh) {
    const int gw = F.bid * NWAVES + F.wave, NGW = F.G * NWAVES;
    f32x4 gv[4], bv[4];
#pragma unroll
    for (int j = 0; j < 4; ++j) { gv[j] = ((const f32x4*)g)[F.lane + 64 * j]; bv[j] = ((const f32x4*)b)[F.lane + 64 * j]; }
    for (int m = gw; m < M; m += NGW) {
        const f32x4* xr = (const f32x4*)(pre + (size_t)m * D) + F.lane; f32x4 v[4]; float s = 0.f;
#pragma unroll
        for (int j = 0; j < 4; ++j) { v[j] = xr[64 * j]; s += (v[j].x + v[j].y) + (v[j].z + v[j].w); }
        const float mean = wave_sum(s) * (1.f / D); float s2 = 0.f;
#pragma unroll
        for (int j = 0; j < 4; ++j) { v[j] = v[j] - mean; s2 += (v[j].x * v[j].x + v[j].y * v[j].y) + (v[j].z * v[j].z + v[j].w * v[j].w); }
        const float rstd = 1.f / sqrtf(wave_sum(s2) * (1.f / D) + LN_EPS);
        f32x4* o = (f32x4*)(xo + (size_t)m * D) + F.lane; u32x2* oh = (u32x2*)(xoh + (size_t)m * D) + F.lane;
#pragma unroll
        for (int j = 0; j < 4; ++j) { const f32x4 y = v[j] * rstd * gv[j] + bv[j]; o[64 * j] = y; u32x2 w; w.x = pkh(y.x, y.y); w.y = pkh(y.z, y.w); oh[64 * j] = w; }
    }
}

__device__ __forceinline__ void ld8(const h16* p, float (&o)[8]) { unpk8(*(const u32x4*)p, o); }
__device__ __forceinline__ void st8(LAS h16* p, const float (&v)[8]) { u32x4 w; w.x = pkh(v[0], v[1]); w.y = pkh(v[2], v[3]); w.z = pkh(v[4], v[5]); w.w = pkh(v[6], v[7]); *(LAS u32x4*)p = w; }
__device__ __forceinline__ void st8(h16* p, const float (&v)[8]) { u32x4 w; w.x = pkh(v[0], v[1]); w.y = pkh(v[2], v[3]); w.z = pkh(v[4], v[5]); w.w = pkh(v[6], v[7]); *(u32x4*)p = w; }
__device__ __forceinline__ void phase_prep(Frame& F, int l) {
    const int gw = F.bid * NWAVES + F.wave, NGW = F.G * NWAVES; unsigned char* ws = F.ws; const Args& A = *F.a; const int lane = F.lane;
    const h16* P = (const h16*)(ws + WS_PRWKV); const float* mu = A.in[I_MU] + l * RWKV_COLS;
    h16* R = (h16*)(ws + WS_R); h16* Kk = (h16*)(ws + WS_K); h16* V = (h16*)(ws + WS_V); h16* AL = (h16*)(ws + WS_ALORA);
    const h16* PM = (const h16*)(ws + WS_PMLA); h16* Kc = (h16*)(ws + WS_KC); float* rq = (float*)(ws + WS_RSTDQ); float* rkv = (float*)(ws + WS_RSTDKV);
    const float* cosT = (const float*)(ws + WS_COS); const float* sinT = (const float*)(ws + WS_SIN);
    for (int m = gw; m < M; m += NGW) {
        const int t = m & (T - 1);
#pragma unroll
        for (int j = 0; j < 4; ++j) { const int ch = lane + 64 * j;
            if (ch < 224) { const int c = 8 * ch; float p[8], q[8], o[8];
                ld8(P + (size_t)m * RWKV_COLS + c, p);
                if (t > 0) ld8(P + (size_t)(m - 1) * RWKV_COLS + c, q); else {
#pragma unroll
                    for (int e = 0; e < 8; ++e) q[e] = 0.f; }
                const f32x4 m0 = *(const f32x4*)(mu + c), m1 = *(const f32x4*)(mu + c + 4);
#pragma unroll
                for (int e = 0; e < 8; ++e) o[e] = p[e] + (q[e] - p[e]) * (e < 4 ? m0[e] : m1[e - 4]);
                if (c < 512) st8(R + (size_t)m * RD + c, o);
                else if (c < 1024) st8(Kk + (size_t)m * RD + (c - 512), o);
                else if (c < 1536) st8(V + (size_t)m * RD + (c - 1024), o);
                else { if (c < 1600) {
#pragma unroll
                        for (int e = 0; e < 8; ++e) o[e] = tanhf(o[e]); }
                    else if (c >= 1664) {
#pragma unroll
                        for (int e = 0; e < 8; ++e) o[e] = sigm(o[e]); }
                    st8(AL + (size_t)m * 256 + (c - 1536), o); } } }
        { float x[8]; float ss = 0.f;
            if (lane < 52) { ld8(PM + (size_t)m * 512 + 8 * lane, x);
#pragma unroll
                for (int e = 0; e < 8; ++e) ss += x[e] * x[e]; }
            else {
#pragma unroll
                for (int e = 0; e < 8; ++e) x[e] = 0.f; }
            const float sq = wave_sum(lane < 32 ? ss : 0.f), skv = wave_sum((lane >= 32 && lane < 48) ? ss : 0.f);
            if (lane == 0) { rq[m] = 1.0f / sqrtf(sq * (1.f / 256.f) + RMS_EPS); rkv[m] = 1.0f / sqrtf(skv * (1.f / 128.f) + RMS_EPS); }
            float y[8], o[8];
#pragma unroll
            for (int e = 0; e < 8; ++e) y[e] = __shfl_xor(x[e], 2);
            if (lane >= 48 && lane < 52) { const int i0 = 8 * (lane & 1); const bool second = lane >= 50;
#pragma unroll
                for (int e = 0; e < 8; ++e) { const float cs = cosT[t * 16 + i0 + e], sn = sinT[t * 16 + i0 + e];
                    o[e] = second ? (x[e] * cs + y[e] * sn) : (x[e] * cs - y[e] * sn); }
#pragma unroll
                for (int h = 0; h < 8; ++h) st8(Kc + (size_t)m * 768 + h * 96 + 64 + 8 * (lane - 48), o); } }
    }
}
__device__ __forceinline__ void phase_rwkv_post(Frame& F, int l, const float* xsrc) {
    const int gw = F.bid * NWAVES + F.wave, NGW = F.G * NWAVES; unsigned char* ws = F.ws; const Args& A = *F.a; const int lane = F.lane;
    const h16* R = (const h16*)(ws + WS_R); const h16* Kk = (const h16*)(ws + WS_K); const h16* V = (const h16*)(ws + WS_V);
    const h16* AS = (const h16*)(ws + WS_ASIG); const h16* G = (const h16*)(ws + WS_G); h16* YA = (h16*)(ws + WS_YAIN);
    const int c = 8 * lane;
    float ka[8], rk[8], gg[8], gb[8];
    { const f32x4 a0 = *(const f32x4*)(A.in[I_KA] + l * RD + c), a1 = *(const f32x4*)(A.in[I_KA] + l * RD + c + 4), r0 = *(const f32x4*)(A.in[I_RK] + l * RD + c), r1 = *(const f32x4*)(A.in[I_RK] + l * RD + c + 4);
      const f32x4 g0 = *(const f32x4*)(A.in[I_GNG] + l * RD + c), g1 = *(const f32x4*)(A.in[I_GNG] + l * RD + c + 4), b0 = *(const f32x4*)(A.in[I_GNB] + l * RD + c), b1 = *(const f32x4*)(A.in[I_GNB] + l * RD + c + 4);
#pragma unroll
      for (int e = 0; e < 4; ++e) { ka[e] = a0[e]; ka[4 + e] = a1[e]; rk[e] = r0[e]; rk[4 + e] = r1[e]; gg[e] = g0[e]; gg[4 + e] = g1[e]; gb[e] = b0[e]; gb[4 + e] = b1[e]; } }
    for (int m = gw; m < M; m += NGW) {
        const h16* Y = (const h16*)(ws + (m < T ? WS_YRW0 : WS_YRW1)) + (size_t)(m & (T - 1)) * RD;
        float y[8], v[8], g[8], o[8];
        ld8(Y + c, y); ld8(V + (size_t)m * RD + c, v); ld8(G + (size_t)m * RD + c, g);
        float s = 0.f; const float bs = ((const float*)(ws + WS_BS))[(size_t)m * 8 + (lane >> 3)];
#pragma unroll
        for (int e = 0; e < 8; ++e) s += y[e];
        s += __shfl_xor(s, 1); s += __shfl_xor(s, 2); s += __shfl_xor(s, 4);
        const float mean = s * (1.f / 64.f); float q = 0.f;
#pragma unroll
        for (int e = 0; e < 8; ++e) { y[e] -= mean; q += y[e] * y[e]; }
        q += __shfl_xor(q, 1); q += __shfl_xor(q, 2); q += __shfl_xor(q, 4);
        const float rstd = 1.0f / sqrtf(q * (1.f / 64.f) + GN_EPS);
#pragma unroll
        for (int e = 0; e < 8; ++e) o[e] = (y[e] * rstd * gg[e] + gb[e] + bs * v[e]) * g[e];
        st8(YA + (size_t)m * RD + c, o);
    }
    rows_to_h16(F, xsrc, (h16*)(ws + WS_XH2));
}

constexpr int S5_NC = 32, S5_CL = T / S5_NC;
__device__ __forceinline__ float rdlane(float v, int l) { return __builtin_bit_cast(float, __builtin_amdgcn_readlane(__builtin_bit_cast(int, v), l)); }
__device__ __forceinline__ float gelu_tanh(float x) { const float u = 0.7978845608028654f * (x + 0.044715f * x * x * x); return 0.5f * x * (1.0f + tanhf(u)); }
template <int PASS> __device__ __forceinline__ void phase_s5(Frame& F, int l) {
    const int gw = F.bid * NWAVES + F.wave, NGW = F.G * NWAVES; unsigned char* ws = F.ws; const Args& A = *F.a; const int lane = F.lane;
    const h16* U = (const h16*)(ws + WS_U); h16* Y = (h16*)(ws + WS_YS5); float* END = (float*)(ws + WS_S5END);
    LAS h16* sl = (LAS h16*)(F.lds + F.wave * 8704);
    for (int task = gw; task < BATCH * 32 * S5_NC; task += NGW) {
        const int ch = task % S5_NC, g = (task / S5_NC) % 32, b = task / (S5_NC * 32);
        const int gp = (l * 32 + g) * 64 + lane;
        const float lam_re = fminf(A.in[I_LRE][gp], -1e-4f), lam_im = A.in[I_LIM][gp], step = __expf(A.in[I_LSTEP][l * 32 + g]);
        float sn, cs; sincosf(lam_im * step, &sn, &cs); const float mag = __expf(lam_re * step);
        const float lb_re = mag * cs, lb_im = mag * sn, den = lam_re * lam_re + lam_im * lam_im, n_re = lb_re - 1.0f;
        const float f_re = (n_re * lam_re + lb_im * lam_im) / den, f_im = (lb_im * lam_re - n_re * lam_im) / den;
        float bbr[16], bbi[16];
#pragma unroll
        for (int q = 0; q < 4; ++q) { const f32x4 br = *(const f32x4*)(A.in[I_BRE] + (size_t)gp * 16 + 4 * q), bi = *(const f32x4*)(A.in[I_BIM] + (size_t)gp * 16 + 4 * q);
#pragma unroll
            for (int e = 0; e < 4; ++e) { bbr[4 * q + e] = f_re * br[e] - f_im * bi[e]; bbi[4 * q + e] = f_re * bi[e] + f_im * br[e]; } }
        float s_re = 0.f, s_im = 0.f;
        h16x8 cf[4]; float dsk = 0.f;
        if (PASS == 2) {
            float snL, csL; sincosf(lam_im * step * (float)S5_CL, &snL, &csL); const float magL = __expf(lam_re * step * (float)S5_CL); const float L_re = magL * csL, L_im = magL * snL;
            const float* e0 = END + ((size_t)(b * 32 + g) * S5_NC) * 128 + 2 * lane;
            for (int j = 0; j < ch; ++j) { const f32x2 e = *(const f32x2*)(e0 + j * 128); const float nr = s_re * L_re - s_im * L_im + e.x, ni = s_re * L_im + s_im * L_re + e.y; s_re = nr; s_im = ni; }
            const int c = lane & 15, kg = lane >> 4;
#pragma unroll
            for (int ks = 0; ks < 4; ++ks) { const int k = 32 * ks + 8 * kg; const float* src = (k < 64 ? A.in[I_CRE] : A.in[I_CIM]) + ((size_t)(l * 32 + g) * 16 + c) * 64 + (k & 63); const float sg = k < 64 ? 1.f : -1.f;
                const f32x4 a0 = *(const f32x4*)src, a1 = *(const f32x4*)(src + 4);
                cf[ks] = (h16x8){(h16)(sg * a0[0]), (h16)(sg * a0[1]), (h16)(sg * a0[2]), (h16)(sg * a0[3]), (h16)(sg * a1[0]), (h16)(sg * a1[1]), (h16)(sg * a1[2]), (h16)(sg * a1[3])}; }
            dsk = A.in[I_S5D][l * 512 + 16 * g + c];
        }
        const size_t m0 = (size_t)b * T + (size_t)ch * S5_CL;
        for (int tile = 0; tile < S5_CL / 64; ++tile) {
            float uv[16]; { const h16* up = U + (m0 + 64 * tile + lane) * 512 + 16 * g; float a[8], c2[8]; ld8(up, a); ld8(up + 8, c2);
#pragma unroll
                for (int e = 0; e < 8; ++e) { uv[e] = a[e]; uv[8 + e] = c2[e]; } }
#pragma unroll 1
            for (int half = 0; half < 2; ++half) {
#pragma unroll 2
                for (int tt = 0; tt < 32; ++tt) { const int tl = 32 * half + tt; float br = 0.f, bi = 0.f;
#pragma unroll
                    for (int c = 0; c < 16; ++c) { const float uc = rdlane(uv[c], tl); br += bbr[c] * uc; bi += bbi[c] * uc; }
                    const float nr = s_re * lb_re - s_im * lb_im + br, ni = s_re * lb_im + s_im * lb_re + bi; s_re = nr; s_im = ni;
                    if (PASS == 2) { sl[tt * 136 + lane] = (h16)s_re; sl[tt * 136 + 64 + lane] = (h16)s_im; } }
                if (PASS == 2) {
                    asm volatile("s_waitcnt lgkmcnt(0)" ::: "memory");
                    const int c = lane & 15, kg = lane >> 4;
#pragma unroll
                    for (int mb = 0; mb < 2; ++mb) { f32x4 acc = {0.f, 0.f, 0.f, 0.f};
#pragma unroll
                        for (int ks = 0; ks < 4; ++ks) { const h16x8 af = *(const LAS h16x8*)(sl + (mb * 16 + c) * 136 + 32 * ks + 8 * kg); acc = __builtin_amdgcn_mfma_f32_16x16x32_f16(af, cf[ks], acc, 0, 0, 0); }
#pragma unroll
                        for (int e = 0; e < 4; ++e) { const size_t m = m0 + 64 * tile + 32 * half + mb * 16 + 4 * kg + e; const float uu = (float)U[m * 512 + 16 * g + c];
                            Y[m * 512 + 16 * g + c] = (h16)gelu_tanh(acc[e] + dsk * uu); } }
                    asm volatile("s_waitcnt lgkmcnt(0)" ::: "memory");
                }
            }
        }
        if (PASS == 1) { *(f32x2*)(END + ((size_t)(b * 32 + g) * S5_NC + ch) * 128 + 2 * lane) = (f32x2){s_re, s_im}; }
    }
}

#ifdef DBG_CHUNK
#define CKO_G  WS_SLOT(21)
#define CKO_H  WS_SLOT(23)
#define CKO_RB WS_SLOT(1)
#define CKO_YB WS_SLOT(13)
#define YREF0  WS_SLOT(3)
#define YREF1  WS_SLOT(25)
#else
#define CKO_G  WS_R
#define CKO_H  WS_K
#define CKO_RB WS_LW
#define CKO_YB WS_ASIG
#endif
constexpr int RW_TS = 32, RW_BUF = 5 * 8192 + 2048 + 256;
template <int CTRL> __device__ __forceinline__ float dpp_add(float v) { return v + __builtin_bit_cast(float, __builtin_amdgcn_update_dpp(0, __builtin_bit_cast(int, v), CTRL, 0xf, 0xf, false)); }
__device__ __forceinline__ float red16(float v) { v = dpp_add<0xB1>(v); v = dpp_add<0x4E>(v); v = dpp_add<0x141>(v); v = dpp_add<0x140>(v); return v; }
__device__ __forceinline__ void rwkv_scan_unit(Frame& F, int l, int b, int h, int q) {
    unsigned char* ws = F.ws; const Args& A = *F.a; const int tid = F.tid, lane = F.lane, wave = F.wave;
    const h16* R = (const h16*)(ws + WS_R); const h16* Kk = (const h16*)(ws + WS_K); const h16* V = (const h16*)(ws + WS_V);
    const h16* LW = (const h16*)(ws + WS_LW); const h16* AS = (const h16*)(ws + WS_ASIG);
#ifdef DBG_CHUNK
    h16* Yg = (h16*)(ws + (b == 0 ? YREF0 : YREF1));
#else
    h16* Yg = (h16*)(ws + (b == 0 ? WS_YRW0 : WS_YRW1));
#endif
    LAS unsigned char* lds = F.lds;
    const size_t base = (size_t)b * T * RD + h * 64;
    if (wave >= 4) {
        const int c = lane; const float kkc = A.in[I_KK][l * RD + h * 64 + c], kac = A.in[I_KA][l * RD + h * 64 + c];
        for (int tile = 0; tile < T / RW_TS; ++tile) {
            LAS float* buf = (LAS float*)(lds + (tile & 1) * RW_BUF);
            float r[8], k[8], v[8], lw[8], as[8];
#pragma unroll
            for (int i = 0; i < 8; ++i) { const size_t idx = base + (size_t)(tile * RW_TS + (wave - 4) * 8 + i) * RD + c;
                r[i] = (float)R[idx]; k[i] = (float)Kk[idx]; v[i] = (float)V[idx]; lw[i] = (float)LW[idx]; as[i] = (float)AS[idx]; }
#pragma unroll
            for (int i = 0; i < 8; ++i) { const int tt = (wave - 4) * 8 + i;
                const float kkr = k[i] * kkc; const float n2 = wave_sum(kkr * kkr); const float kk = kkr * (1.0f / sqrtf(fmaxf(n2, 1e-12f)));
                const float bq = kk * as[i], kp = k[i] * (1.0f + (as[i] - 1.0f) * kac), w = __expf(lw[i]);
                const float brs = wave_sum(bq * r[i]), krs = wave_sum(kp * r[i]);
                buf[tt * 64 + c] = -kk; buf[2048 + tt * 64 + c] = w * r[i]; buf[4096 + tt * 64 + c] = w; buf[6144 + tt * 64 + c] = bq; buf[8192 + tt * 64 + c] = kp;
                if ((c >> 4) == q) buf[10240 + tt * 16 + (c & 15)] = v[i];
                if (c == 0) { buf[10752 + tt * 2] = brs; buf[10752 + tt * 2 + 1] = krs; } }
            __syncthreads();
        }
        __syncthreads();
    } else {
        const int row = tid >> 4, kq = tid & 15;
        float S0 = 0.f, S1 = 0.f, S2 = 0.f, S3 = 0.f;
        __syncthreads();
        for (int tile = 0; tile < T / RW_TS; ++tile) {
            const LAS float* buf = (const LAS float*)(lds + (tile & 1) * RW_BUF);
            float y0 = 0.f, y1 = 0.f;
#pragma unroll
            for (int tt = 0; tt < RW_TS; ++tt) {
                const f32x4 a4 = *(const LAS f32x4*)(buf + tt * 64 + 4 * kq), wr4 = *(const LAS f32x4*)(buf + 2048 + tt * 64 + 4 * kq), w4 = *(const LAS f32x4*)(buf + 4096 + tt * 64 + 4 * kq);
                const f32x4 b4 = *(const LAS f32x4*)(buf + 6144 + tt * 64 + 4 * kq), k4 = *(const LAS f32x4*)(buf + 8192 + tt * 64 + 4 * kq);
                const float vv = buf[10240 + tt * 16 + row]; const f32x2 sc = *(const LAS f32x2*)(buf + 10752 + tt * 2);
                float d1 = (S0 * a4[0] + S1 * a4[1]) + (S2 * a4[2] + S3 * a4[3]);
                float d2 = (S0 * wr4[0] + S1 * wr4[1]) + (S2 * wr4[2] + S3 * wr4[3]);
                d1 = red16(d1); d2 = red16(d2);
                S0 = S0 * w4[0] + d1 * b4[0] + vv * k4[0]; S1 = S1 * w4[1] + d1 * b4[1] + vv * k4[1];
                S2 = S2 * w4[2] + d1 * b4[2] + vv * k4[2]; S3 = S3 * w4[3] + d1 * b4[3] + vv * k4[3];
                const float y = d2 + d1 * sc.x + vv * sc.y;
                if (kq == (tt & 15)) { if (tt < 16) y0 = y; else y1 = y; }
            }
            { const size_t o = (size_t)(tile * RW_TS + kq) * RD + h * 64 + 16 * q + row; Yg[o] = (h16)y0; Yg[o + 16 * RD] = (h16)y1; }
            __syncthreads();
        }
    }
}


constexpr int CK_LDH = 72, CK_MAT = 64 * CK_LDH * 2;
constexpr int CK_RT = 0, CK_AT = CK_MAT, CK_BN = 2 * CK_MAT, CK_KN = 3 * CK_MAT, CK_BT = 4 * CK_MAT, CK_KT = 5 * CK_MAT, CK_VT = 6 * CK_MAT, CK_LAK = 7 * CK_MAT, CK_MRB = 8 * CK_MAT, CK_MRK = 9 * CK_MAT,
              CK_ABT = 10 * CK_MAT, CK_UBT = 11 * CK_MAT, CK_L32 = 12 * CK_MAT  , CK_X32 = CK_BN  , CK_SM = CK_L32 + 16384  ;
static_assert(CK_SM + 512 <= 131072 && 2 * CK_MAT >= 16384, "chunk LDS map");
template <int KS> __device__ __forceinline__ void ck_mm2(f32x4& acc0, f32x4& acc1, const LAS unsigned char* A, int mb0, const LAS unsigned char* Bt, int nb, int lane) {
    const int row = lane & 15, kg = lane >> 4;
#pragma unroll
    for (int ks = 0; ks < KS; ++ks) { const h16x8 b = *(const LAS h16x8*)(Bt + ((16 * nb + row) * CK_LDH + 32 * ks + 8 * kg) * 2);
        const h16x8 a0 = *(const LAS h16x8*)(A + ((16 * mb0 + row) * CK_LDH + 32 * ks + 8 * kg) * 2), a1 = *(const LAS h16x8*)(A + ((16 * mb0 + 16 + row) * CK_LDH + 32 * ks + 8 * kg) * 2);
        acc0 = __builtin_amdgcn_mfma_f32_16x16x32_f16(a0, b, acc0, 0, 0, 0); acc1 = __builtin_amdgcn_mfma_f32_16x16x32_f16(a1, b, acc1, 0, 0, 0); }
}
__device__ __forceinline__ void rwkv_chunk_item(Frame& F, int l, int b, int h, int c) {
    unsigned char* ws = F.ws; const Args& A = *F.a; int tid = F.tid; asm volatile("" : "+v"(tid)); const int lane = tid & 63, w = F.wave; LAS unsigned char* lds = F.lds;
    h16* R = (h16*)(ws + WS_R); h16* Kk = (h16*)(ws + WS_K); const h16* V = (const h16*)(ws + WS_V); h16* LW = (h16*)(ws + WS_LW); h16* AS = (h16*)(ws + WS_ASIG); float* BS = (float*)(ws + WS_BS);
    const size_t m0 = (size_t)b * T + (size_t)c * 64; const size_t tile = m0 * RD + h * 64;
    LAS float* cum = (LAS float*)(lds + CK_L32); LAS float* sm = (LAS float*)(lds + CK_SM);
    const int t = tid >> 3, c8 = tid & 7, k0 = 8 * c8;
    float lwv[8]; ld8(LW + tile + (size_t)t * RD + k0, lwv);
    *(LAS f32x4*)(cum + t * 64 + k0) = (f32x4){lwv[0], lwv[1], lwv[2], lwv[3]}; *(LAS f32x4*)(cum + t * 64 + k0 + 4) = (f32x4){lwv[4], lwv[5], lwv[6], lwv[7]};
    float rv[8], kv[8], vv[8], av[8];
    ld8(R + tile + (size_t)t * RD + k0, rv); ld8(Kk + tile + (size_t)t * RD + k0, kv); ld8(V + tile + (size_t)t * RD + k0, vv); ld8(AS + tile + (size_t)t * RD + k0, av);
    __syncthreads();
    if (w == 0) { float run = 0.f, rho = 0.f;
#pragma unroll 8
        for (int tt = 0; tt < 64; ++tt) { run += cum[tt * 64 + lane]; cum[tt * 64 + lane] = run; if (tt == 31) rho = run; }
        sm[lane] = __expf(rho); sm[64 + lane] = __expf(run - rho); sm[128 + lane] = rho; }
    __syncthreads();
    { float kkr[8], n2 = 0.f, bsum = 0.f; float kp[8];
      const f32x4 kk0 = *(const f32x4*)(A.in[I_KK] + l * RD + h * 64 + k0), kk1 = *(const f32x4*)(A.in[I_KK] + l * RD + h * 64 + k0 + 4), ka0 = *(const f32x4*)(A.in[I_KA] + l * RD + h * 64 + k0), ka1 = *(const f32x4*)(A.in[I_KA] + l * RD + h * 64 + k0 + 4);
      const f32x4 rk0 = *(const f32x4*)(A.in[I_RK] + l * RD + h * 64 + k0), rk1 = *(const f32x4*)(A.in[I_RK] + l * RD + h * 64 + k0 + 4);
#pragma unroll
      for (int e = 0; e < 8; ++e) { const float kkc = e < 4 ? kk0[e] : kk1[e - 4], kac = e < 4 ? ka0[e] : ka1[e - 4], rkc = e < 4 ? rk0[e] : rk1[e - 4];
          kkr[e] = kv[e] * kkc; n2 += kkr[e] * kkr[e]; kp[e] = kv[e] * (1.0f + (av[e] - 1.0f) * kac); bsum += rv[e] * kp[e] * rkc; }
      n2 += __shfl_xor(n2, 1); n2 += __shfl_xor(n2, 2); n2 += __shfl_xor(n2, 4); bsum += __shfl_xor(bsum, 1); bsum += __shfl_xor(bsum, 2); bsum += __shfl_xor(bsum, 4);
      if (c8 == 0) BS[(m0 + t) * 8 + h] = bsum;
      const float rn = 1.0f / sqrtf(fmaxf(n2, 1e-12f));
      float Rt[8], At[8], Kt[8], Bt[8];
#pragma unroll
      for (int e = 0; e < 8; ++e) { const float cu = cum[t * 64 + k0 + e], rho = sm[128 + k0 + e]; const float e1 = __expf(cu - rho), e2 = __expf(rho - cu), e0 = __expf(cu - lwv[e] - rho), kk = kkr[e] * rn;
          Rt[e] = rv[e] * e1; At[e] = -kk * e0; Kt[e] = kp[e] * e2; Bt[e] = kk * av[e] * e2; }
      st8((LAS h16*)(lds + CK_RT) + t * CK_LDH + k0, Rt); st8((LAS h16*)(lds + CK_AT) + t * CK_LDH + k0, At); st8((LAS h16*)(lds + CK_BN) + t * CK_LDH + k0, Bt); st8((LAS h16*)(lds + CK_KN) + t * CK_LDH + k0, Kt);
#pragma unroll
      for (int e = 0; e < 8; ++e) { ((LAS h16*)(lds + CK_BT))[(k0 + e) * CK_LDH + t] = (h16)Bt[e]; ((LAS h16*)(lds + CK_KT))[(k0 + e) * CK_LDH + t] = (h16)Kt[e]; ((LAS h16*)(lds + CK_VT))[(k0 + e) * CK_LDH + t] = (h16)vv[e]; } }
    __syncthreads();
    const int nb = w & 3, mb0 = 2 * (w >> 2), n_ = 16 * nb + (lane & 15), kg = lane >> 4;
    { f32x4 a0 = {}, a1 = {}, b0 = {}, b1 = {}, c0 = {}, c1 = {}, d0 = {}, d1 = {};
      ck_mm2<2>(a0, a1, lds + CK_BN, mb0, lds + CK_AT, nb, lane); ck_mm2<2>(b0, b1, lds + CK_KN, mb0, lds + CK_AT, nb, lane);
      ck_mm2<2>(c0, c1, lds + CK_BN, mb0, lds + CK_RT, nb, lane); ck_mm2<2>(d0, d1, lds + CK_KN, mb0, lds + CK_RT, nb, lane);
      __syncthreads();
#pragma unroll
      for (int mbi = 0; mbi < 2; ++mbi) { const int i0 = 16 * (mb0 + mbi) + 4 * kg; const f32x4 la = mbi ? a1 : a0, lk = mbi ? b1 : b0, mr = mbi ? c1 : c0, mk = mbi ? d1 : d0;
          f32x4 o; float x[4], y[4], z[4];
#pragma unroll
          for (int e = 0; e < 4; ++e) { const bool st = (i0 + e) < n_, inc = (i0 + e) <= n_; o[e] = st ? la[e] : 0.f; x[e] = st ? lk[e] : 0.f; y[e] = inc ? mr[e] : 0.f; z[e] = inc ? mk[e] : 0.f; }
          *(LAS f32x4*)((LAS float*)(lds + CK_L32) + n_ * 64 + i0) = o;
          *(LAS u32x2*)((LAS h16*)(lds + CK_LAK) + n_ * CK_LDH + i0) = (u32x2){pkh(x[0], x[1]), pkh(x[2], x[3])};
          *(LAS u32x2*)((LAS h16*)(lds + CK_MRB) + n_ * CK_LDH + i0) = (u32x2){pkh(y[0], y[1]), pkh(y[2], y[3])};
          *(LAS u32x2*)((LAS h16*)(lds + CK_MRK) + n_ * CK_LDH + i0) = (u32x2){pkh(z[0], z[1]), pkh(z[2], z[3])}; } }
    __syncthreads();
    { f32x4 a0 = {}, a1 = {}; ck_mm2<2>(a0, a1, lds + CK_VT, mb0, lds + CK_LAK, nb, lane);
      *(LAS f32x4*)((LAS float*)(lds + CK_X32) + n_ * 64 + 16 * mb0 + 4 * kg) = a0; *(LAS f32x4*)((LAS float*)(lds + CK_X32) + n_ * 64 + 16 * mb0 + 16 + 4 * kg) = a1; }
    __syncthreads();
    asm volatile("" ::: "memory");
    if (w < 2) { float W[64]; int zl = 0; asm volatile("" : "+v"(zl)); const LAS float* L = (const LAS float*)(lds + CK_L32) + zl;
#pragma unroll
        for (int tt = 0; tt < 64; ++tt) { float acc = (w == 0) ? (float)((const LAS h16*)(lds + CK_AT))[tt * CK_LDH + lane] : ((const LAS float*)(lds + CK_X32))[tt * 64 + lane];
#pragma unroll
            for (int i = 0; i < tt; ++i) acc += L[tt * 64 + i] * W[i];
            W[tt] = acc; asm volatile("" : "+v"(W[tt]) :: "memory"); }
        LAS h16* dst = (LAS h16*)(lds + (w == 0 ? CK_ABT : CK_UBT)) + lane * CK_LDH;
#pragma unroll
        for (int q = 0; q < 8; ++q) { const float o8[8] = {W[8 * q], W[8 * q + 1], W[8 * q + 2], W[8 * q + 3], W[8 * q + 4], W[8 * q + 5], W[8 * q + 6], W[8 * q + 7]}; st8(dst + 8 * q, o8); } }
    __syncthreads();
    { f32x4 r0 = {}, r1 = {}, y0 = {}, y1 = {}, g0 = {}, g1 = {}, h0 = {}, h1 = {};
      ck_mm2<2>(r0, r1, lds + CK_ABT, mb0, lds + CK_MRB, nb, lane);
      ck_mm2<2>(y0, y1, lds + CK_MRB, mb0, lds + CK_UBT, nb, lane); ck_mm2<2>(y0, y1, lds + CK_MRK, mb0, lds + CK_VT, nb, lane);
      ck_mm2<2>(g0, g1, lds + CK_ABT, mb0, lds + CK_BT, nb, lane);
      ck_mm2<2>(h0, h1, lds + CK_BT, mb0, lds + CK_UBT, nb, lane); ck_mm2<2>(h0, h1, lds + CK_KT, mb0, lds + CK_VT, nb, lane);
      const float dcn = sm[64 + n_];
#pragma unroll
      for (int mbi = 0; mbi < 2; ++mbi) { const int m_ = 16 * (mb0 + mbi) + 4 * kg; const f32x4 rr = mbi ? r1 : r0, yy = mbi ? y1 : y0, gg = mbi ? g1 : g0, hh = mbi ? h1 : h0;
          const f32x4 er = *(const LAS f32x4*)(sm + m_); const f32x4 rt = h4_to_f4(*(const LAS u32x2*)((const LAS h16*)(lds + CK_RT) + n_ * CK_LDH + m_));
          float o[4];
#pragma unroll
          for (int e = 0; e < 4; ++e) o[e] = (rt[e] + rr[e]) * er[e];
          *(u32x2*)((h16*)(ws + CKO_RB) + tile + (size_t)n_ * RD + m_) = (u32x2){pkh(o[0], o[1]), pkh(o[2], o[3])};
          *(u32x2*)((h16*)(ws + CKO_YB) + tile + (size_t)n_ * RD + m_) = (u32x2){pkh(yy[0], yy[1]), pkh(yy[2], yy[3])};
#pragma unroll
          for (int e = 0; e < 4; ++e) o[e] = dcn * (gg[e] + ((m_ + e) == n_ ? 1.0f : 0.0f)) * er[e];
          *(u32x2*)((h16*)(ws + CKO_G) + tile + (size_t)n_ * RD + m_) = (u32x2){pkh(o[0], o[1]), pkh(o[2], o[3])};
          { const f32x4 dm = *(const LAS f32x4*)(sm + 64 + m_); *(u32x2*)((h16*)(ws + CKO_H) + tile + (size_t)n_ * RD + m_) = (u32x2){pkh(dm[0] * hh[0], dm[1] * hh[1]), pkh(dm[2] * hh[2], dm[3] * hh[3])}; } } }
    __syncthreads();
}
__device__ __forceinline__ void phase_rwkv_chunks(Frame& F, int l) {
    for (int it = F.bid; it < BATCH * RH * (T / 64); it += F.G) rwkv_chunk_item(F, l, it >> 10, (it >> 7) & 7, it & 127);
}


struct SeqOps { u32x2 g[4][2][2], rb[4][2][2], hi[4], yi[4]; };
__device__ __forceinline__ void seq_load(SeqOps& o, const h16* Gm, const h16* Hm, const h16* RBm, const h16* YBm, size_t tile, int w, int lane) {
    const int row = lane & 15, kg = lane >> 4;
#pragma unroll
    for (int blk = 0; blk < 4; ++blk) {
#pragma unroll
        for (int s2 = 0; s2 < 2; ++s2) { const size_t off = tile + (size_t)(16 * blk + row) * RD + 32 * s2 + 4 * kg;
            o.g[blk][s2][0] = *(const u32x2*)(Gm + off); o.g[blk][s2][1] = *(const u32x2*)(Gm + off + 16); o.rb[blk][s2][0] = *(const u32x2*)(RBm + off); o.rb[blk][s2][1] = *(const u32x2*)(RBm + off + 16); }
        const size_t io = tile + (size_t)(16 * w + row) * RD + 16 * blk + 4 * kg; o.hi[blk] = *(const u32x2*)(Hm + io); o.yi[blk] = *(const u32x2*)(YBm + io); }
}
__device__ __forceinline__ h16x8 mk_frag(u32x2 lo, u32x2 hi) { const u32x4 v = {lo.x, lo.y, hi.x, hi.y}; return __builtin_bit_cast(h16x8, v); }
__device__ __forceinline__ void seq_step(f32x4 (&ST)[4], const SeqOps& o, h16* Yg, size_t yoff, int lane) {
    const int kg = lane >> 4;
    h16x8 sb[2];
#pragma unroll
    for (int s2 = 0; s2 < 2; ++s2) sb[s2] = mk_frag((u32x2){pkh(ST[2 * s2][0], ST[2 * s2][1]), pkh(ST[2 * s2][2], ST[2 * s2][3])}, (u32x2){pkh(ST[2 * s2 + 1][0], ST[2 * s2 + 1][1]), pkh(ST[2 * s2 + 1][2], ST[2 * s2 + 1][3])});
#pragma unroll
    for (int blk = 0; blk < 4; ++blk) { f32x4 acc = h4_to_f4(o.yi[blk]);
#pragma unroll
        for (int s2 = 0; s2 < 2; ++s2) acc = __builtin_amdgcn_mfma_f32_16x16x32_f16(mk_frag(o.rb[blk][s2][0], o.rb[blk][s2][1]), sb[s2], acc, 0, 0, 0);
#pragma unroll
        for (int e = 0; e < 4; ++e) Yg[yoff + (size_t)(16 * blk + 4 * kg + e) * RD] = (h16)acc[e]; }
    f32x4 Sn[4];
#pragma unroll
    for (int blk = 0; blk < 4; ++blk) { f32x4 acc = h4_to_f4(o.hi[blk]);
#pragma unroll
        for (int s2 = 0; s2 < 2; ++s2) acc = __builtin_amdgcn_mfma_f32_16x16x32_f16(mk_frag(o.g[blk][s2][0], o.g[blk][s2][1]), sb[s2], acc, 0, 0, 0);
        Sn[blk] = acc; }
#pragma unroll
    for (int blk = 0; blk < 4; ++blk) ST[blk] = Sn[blk];
}
__device__ __forceinline__ void rwkv_seq_unit(Frame& F, int b, int h) {
    if (F.wave >= 4) return;
    unsigned char* ws = F.ws; int lane = F.lane; asm volatile("" : "+v"(lane)); const int w = F.wave;
    const h16* Gm = (const h16*)(ws + CKO_G); const h16* Hm = (const h16*)(ws + CKO_H); const h16* RBm = (const h16*)(ws + CKO_RB); const h16* YBm = (const h16*)(ws + CKO_YB);
    h16* Yg = (h16*)(ws + (b == 0 ? WS_YRW0 : WS_YRW1));
    const size_t tile0 = (size_t)b * T * RD + h * 64; const size_t ycol = (size_t)h * 64 + 16 * w + (lane & 15);
    f32x4 ST[4] = {};
    SeqOps oa, ob; seq_load(oa, Gm, Hm, RBm, YBm, tile0, w, lane);
    for (int c = 0; c < T / 64; c += 2) {
        seq_load(ob, Gm, Hm, RBm, YBm, tile0 + (size_t)(c + 1) * 64 * RD, w, lane);
        seq_step(ST, oa, Yg, (size_t)c * 64 * RD + ycol, lane);
        if (c + 2 < T / 64) seq_load(oa, Gm, Hm, RBm, YBm, tile0 + (size_t)(c + 2) * 64 * RD, w, lane);
        seq_step(ST, ob, Yg, (size_t)(c + 1) * 64 * RD + ycol, lane);
    }
}

constexpr int AT_KB = 64 * 208, AT_VB = 8192, AT_K0 = 0, AT_V0 = 2 * AT_KB, AT_WS = AT_V0 + 2 * AT_VB, AT_TICKET = AT_WS + 8 * 256;
__device__ __forceinline__ int crow(int r, int hi) { return (r & 3) + 8 * (r >> 2) + 4 * hi; }
typedef short v4i16_t __attribute__((ext_vector_type(4)));
__device__ __forceinline__ h16x4 vtr(const LAS unsigned char* p) { return __builtin_bit_cast(h16x4, __builtin_amdgcn_ds_read_tr16_b64_v4i16((LAS v4i16_t*)p)); }
__device__ __forceinline__ void attn_unit(Frame& F, int b, int h, int qb) {
    unsigned char* ws = F.ws; const int tid = F.tid, lane = F.lane, wid = F.wave, r32 = lane & 31, hi = lane >> 5;
    const h16* Qc = (const h16*)(ws + WS_QC); const h16* Kc = (const h16*)(ws + WS_KC); const h16* Va = (const h16*)(ws + WS_VA); h16* O = (h16*)(ws + WS_OATT);
    LAS unsigned char* lds = F.lds; LAS float* wsf = (LAS float*)(lds + AT_WS + wid * 256);
    const size_t rowbase = (size_t)b * T; const int q0 = qb * 256;
    h16x8 qr[6];
    { const h16* Qw = Qc + (rowbase + q0 + wid * 32 + r32) * 768 + h * 96 + hi * 8;
#pragma unroll
        for (int d0 = 0; d0 < 6; ++d0) qr[d0] = *(const h16x8*)(Qw + d0 * 16); }
    const int kp0 = tid, kp1 = tid + 512; const int kk0 = kp0 / 12, kc0 = kp0 % 12, kk1 = kp1 / 12, kc1 = kp1 % 12; const bool has1 = kp1 < 768;
    const h16* ksrc0 = Kc + (rowbase + kk0) * 768 + h * 96 + 8 * kc0; const h16* ksrc1 = Kc + (rowbase + (has1 ? kk1 : 0)) * 768 + h * 96 + 8 * (has1 ? kc1 : 0);
    const int kdst0 = kk0 * 208 + kc0 * 16, kdst1 = kk1 * 208 + kc1 * 16;
    const int vk = tid >> 3, vc = tid & 7; const h16* vsrc = Va + (rowbase + vk) * 512 + h * 64 + 8 * vc;
    const int vdst = (vc >> 2) * 4096 + (vk >> 4) * 1024 + (vk & 15) * 64 + (vc & 3) * 16;
    const int NT = 4 * (qb + 1), my_last = 4 * qb + (wid >> 1);
    float m_run = -1e30f, l_run = 0.f; f32x16 o0 = {}, o1 = {};
    u32x4 kr0, kr1 = {0u, 0u, 0u, 0u}, vr;
    kr0 = *(const u32x4*)ksrc0; if (has1) kr1 = *(const u32x4*)ksrc1; vr = *(const u32x4*)vsrc;
    *(LAS u32x4*)(lds + AT_K0 + kdst0) = kr0; if (has1) *(LAS u32x4*)(lds + AT_K0 + kdst1) = kr1; *(LAS u32x4*)(lds + AT_V0 + vdst) = vr;
    __syncthreads();
    const int vfo = ((lane >> 4) & 1) * 32 + (lane & 3) * 8 + (4 * hi + ((lane & 15) >> 2)) * 64;
    for (int jt = 0; jt < NT; ++jt) {
        const bool more = jt + 1 < NT;
        if (more) { const size_t adv = (size_t)(jt + 1) * 64; kr0 = *(const u32x4*)(ksrc0 + adv * 768); if (has1) kr1 = *(const u32x4*)(ksrc1 + adv * 768); vr = *(const u32x4*)(vsrc + adv * 512); }
        if (jt <= my_last) {
            const LAS unsigned char* Kb = lds + AT_K0 + (jt & 1) * AT_KB; const LAS unsigned char* Vb = lds + AT_V0 + (jt & 1) * AT_VB;
            f32x16 p0 = {}, p1 = {};
#pragma unroll
            for (int d0 = 0; d0 < 6; ++d0) { const h16x8 k0 = *(const LAS h16x8*)(Kb + r32 * 208 + (2 * d0 + hi) * 16), k1 = *(const LAS h16x8*)(Kb + (32 + r32) * 208 + (2 * d0 + hi) * 16);
                p0 = __builtin_amdgcn_mfma_f32_32x32x16_f16(k0, qr[d0], p0, 0, 0, 0); p1 = __builtin_amdgcn_mfma_f32_32x32x16_f16(k1, qr[d0], p1, 0, 0, 0); }
            if (64 * jt + 63 > q0 + 32 * wid) { const int qpos = q0 + 32 * wid + r32, kb = 64 * jt + 4 * hi;
#pragma unroll
                for (int r = 0; r < 16; ++r) { const int kv = kb + (r & 3) + 8 * (r >> 2); if (kv > qpos) p0[r] = -INFINITY; if (kv + 32 > qpos) p1[r] = -INFINITY; } }
            float rm = fmaxf(p0[0], p1[0]);
#pragma unroll
            for (int r = 1; r < 16; ++r) rm = fmaxf(rm, fmaxf(p0[r], p1[r]));
            rm = fmaxf(rm, __shfl_xor(rm, 32));
            const float m_new = fmaxf(m_run, rm), alpha = __builtin_amdgcn_exp2f(m_run - m_new);
            const bool grow = __any(m_new > m_run);
            m_run = m_new;
            float sum = 0.f;
#pragma unroll
            for (int r = 0; r < 16; ++r) { p0[r] = __builtin_amdgcn_exp2f(p0[r] - m_new); p1[r] = __builtin_amdgcn_exp2f(p1[r] - m_new); sum += p0[r] + p1[r]; }
            l_run = l_run * alpha + sum;
            if (grow) { if (hi == 0) wsf[r32] = alpha; asm volatile("s_waitcnt lgkmcnt(0)" ::: "memory");
#pragma unroll
                for (int r = 0; r < 16; ++r) { const float f = wsf[crow(r, hi)]; o0[r] *= f; o1[r] *= f; } }
            h16x8 pa[4];
#pragma unroll
            for (int j = 0; j < 8; ++j) { pa[0][j] = (h16)p0[j]; pa[1][j] = (h16)p0[8 + j]; pa[2][j] = (h16)p1[j]; pa[3][j] = (h16)p1[8 + j]; }
#pragma unroll
            for (int ks = 0; ks < 4; ++ks) {
                const h16x4 a0 = vtr(Vb + vfo + ks * 1024), a1 = vtr(Vb + vfo + ks * 1024 + 512), c0 = vtr(Vb + vfo + 4096 + ks * 1024), c1 = vtr(Vb + vfo + 4096 + ks * 1024 + 512);
                const h16x8 v0 = {a0[0], a0[1], a0[2], a0[3], a1[0], a1[1], a1[2], a1[3]}, v1 = {c0[0], c0[1], c0[2], c0[3], c1[0], c1[1], c1[2], c1[3]};
                o0 = __builtin_amdgcn_mfma_f32_32x32x16_f16(pa[ks], v0, o0, 0, 0, 0); o1 = __builtin_amdgcn_mfma_f32_32x32x16_f16(pa[ks], v1, o1, 0, 0, 0); }
        }
        if (more) { LAS unsigned char* Kn = lds + AT_K0 + ((jt + 1) & 1) * AT_KB; LAS unsigned char* Vn = lds + AT_V0 + ((jt + 1) & 1) * AT_VB;
            *(LAS u32x4*)(Kn + kdst0) = kr0; if (has1) *(LAS u32x4*)(Kn + kdst1) = kr1; *(LAS u32x4*)(Vn + vdst) = vr; }
        __syncthreads();
    }
    l_run += __shfl_xor(l_run, 32);
    if (hi == 0) wsf[r32] = 1.0f / l_run;
    asm volatile("s_waitcnt lgkmcnt(0)" ::: "memory");
    h16* Ow = O + (rowbase + q0 + wid * 32) * 512 + h * 64 + r32;
#pragma unroll
    for (int r = 0; r < 16; ++r) { const int qr_ = crow(r, hi); const float f = wsf[qr_]; Ow[(size_t)qr_ * 512] = (h16)(o0[r] * f); Ow[(size_t)qr_ * 512 + 32] = (h16)(o1[r] * f); }
    __syncthreads();
}


#ifdef DBG_CHUNK
constexpr int CW_DBG = 2048;
__device__ __forceinline__ void dbg_max(Frame& F, float v) {
    v = fmaxf(v, 0.f);
#pragma unroll
    for (int o = 1; o < 64; o <<= 1) v = fmaxf(v, __shfl_xor(v, o));
    if (F.lane == 0) atomicMax((unsigned*)(F.ws + WS_CTL) + CW_DBG, __float_as_uint(v));
}
__device__ __forceinline__ void dbg_emit(Frame& F) {
    if (F.bid == 0 && F.tid == 0) { const float v = __uint_as_float(((unsigned*)(F.ws + WS_CTL))[CW_DBG]);
        int code = v > 1e-6f ? (int)(4.0f * log2f(v * 1e6f) + 0.5f) : 0; code = code > 89 ? 89 : code; F.a->out[0] = (float)((10 + code) * 1000); }
}
__device__ __forceinline__ void dbg_cmp_y(Frame& F) {
    float md = 0.f;
    for (size_t i = (size_t)F.bid * NTHREADS + F.tid; i < (size_t)M * RD; i += (size_t)F.G * NTHREADS) { const int m = (int)(i >> 9), t = m & (T - 1), c = (int)(i & 511);
        if (t >= DBG_TLO && t < DBG_THI) { const float a = (float)((const h16*)(F.ws + (m < T ? WS_YRW0 : WS_YRW1)))[(size_t)t * RD + c], b = (float)((const h16*)(F.ws + (m < T ? YREF0 : YREF1)))[(size_t)t * RD + c];
            md = fmaxf(md, fabsf(a - b) / (1.0f + fabsf(b))); } }
    dbg_max(F, md);
}
#endif

typedef GAS unsigned gu32;
#define XB_TMO      128
#define XB_XCNT(j)  (256  + 64 * (j))
#define XB_XSUB(j)  (1280 + 64 * (j))
#define XB_XGEN(j)  (2304 + 64 * (j))
#define XB_TOP      3328
#define XB_TOPGEN   3392
#define XCD_BAR_WORDS 3456
#define XB_SPIN_CAP (1u << 22)
__device__ __forceinline__ unsigned xb_ld(unsigned* p)              { return __hip_atomic_load(p, __ATOMIC_RELAXED, __HIP_MEMORY_SCOPE_AGENT); }
__device__ __forceinline__ unsigned xb_add(unsigned* p, unsigned v) { return __hip_atomic_fetch_add(p, v, __ATOMIC_RELAXED, __HIP_MEMORY_SCOPE_AGENT); }
__device__ __forceinline__ unsigned xb_xcc_id() { return (unsigned)__builtin_amdgcn_s_getreg((3 << 11) | 20) & 0xFu; }
#define XB_SPIN(cond, bar) do { unsigned _sp = 0; while (cond) { __builtin_amdgcn_s_sleep(1); \
    if ((++_sp & 255u) == 0u) { if (xb_ld(&(bar)[XB_TMO])) break; if (_sp > XB_SPIN_CAP) { atomicAdd(&(bar)[XB_TMO], 1u); break; } } } } while (0)
struct XcdBarrier { unsigned* bar; unsigned x; volatile LAS unsigned* st; };
__device__ __forceinline__ XcdBarrier xcd_barrier_post(unsigned* bar, volatile LAS unsigned* st) {
    XcdBarrier b; b.bar = bar; b.x = xb_xcc_id(); b.st = st;
    if (threadIdx.x == 0) (void)xb_add(&bar[XB_XCNT(b.x)], 1u);
    return b;
}
__device__ __forceinline__ void xcd_barrier_complete(unsigned* bar, unsigned x, unsigned& nloc, unsigned& nx) {
    const unsigned G = gridDim.x * gridDim.y * gridDim.z;
    unsigned sum, cnt, mine, sp = 0u;
    for (;;) {
        sum = 0u; cnt = 0u; mine = 0u;
#pragma unroll
        for (unsigned j = 0; j < 16; ++j) { const unsigned c = xb_ld(&bar[XB_XCNT(j)]); sum += c; cnt += (c > 0u) ? 1u : 0u; mine = (j == x) ? c : mine; }
        if (sum == G) break;
        __builtin_amdgcn_s_sleep(1);
        if ((++sp & 255u) == 0u) { if (xb_ld(&bar[XB_TMO])) break; if (sp > XB_SPIN_CAP) { atomicAdd(&bar[XB_TMO], 1u); break; } }
    }
    nloc = mine > 0u ? mine : 1u; nx = cnt > 0u ? cnt : 1u;
}
__device__ __forceinline__ void xcd_barrier(const XcdBarrier& b) {
    asm volatile("s_waitcnt vmcnt(0)" ::: "memory");
    __syncthreads();
    if (threadIdx.x == 0) {
        unsigned* bar = b.bar;
        __builtin_amdgcn_s_waitcnt(0);
        unsigned nloc = b.st[0], nx = b.st[1];
        if (nloc == 0u) { xcd_barrier_complete(bar, b.x, nloc, nx); b.st[0] = nloc; b.st[1] = nx; }
        const unsigned old = xb_add(&bar[XB_XSUB(b.x)], 1u);
        const unsigned gen = old / nloc;
        if (old + 1u == (gen + 1u) * nloc) {
            __builtin_amdgcn_fence(__ATOMIC_RELEASE, "agent");
            asm volatile("s_waitcnt vmcnt(0)" ::: "memory");
            const unsigned og = xb_add(&bar[XB_TOP], 1u);
            const unsigned tg = og / nx;
            if (og + 1u == (tg + 1u) * nx) xb_add(&bar[XB_TOPGEN], 1u);
            else XB_SPIN(xb_ld(&bar[XB_TOPGEN]) == tg, bar);
            __builtin_amdgcn_fence(__ATOMIC_ACQUIRE, "agent");
            xb_add(&bar[XB_XGEN(b.x)], 1u);
            asm volatile("s_waitcnt vmcnt(0)" ::: "memory");
        } else {
            XB_SPIN(xb_ld(&bar[XB_XGEN(b.x)]) == gen, bar);
            __builtin_amdgcn_fence(__ATOMIC_ACQUIRE, "agent");
            asm volatile("s_waitcnt vmcnt(0)" ::: "memory");
        }
    }
    __syncthreads();
}

constexpr int NPH = 1 + 13 * DEPTH;
__device__ __forceinline__ void run_phase(Frame& F, int ph) {
    { int w_ = F.wave, b_ = F.bid; asm volatile("" : "+v"(F.tid), "+v"(F.lane), "+v"(w_), "+v"(b_)); F.wave = __builtin_amdgcn_readfirstlane(w_); F.bid = __builtin_amdgcn_readfirstlane(b_); }
    unsigned char* ws = F.ws; const Args& A = *F.a; LAS unsigned char* lds = F.lds;
    if (ph == 0) { phase_convert(F, 0); rows_to_h16(F, A.in[I_X], (h16*)(ws + WS_XH)); rope_table(F); return; }
    const int l = (ph - 1) / 13, k = (ph - 1) % 13 + 1;
    const float* xres = (l == 0) ? A.in[I_X] : A.out;
    switch (k) {
    case 1: { pg8::Gemm g{(const h16*)(ws + WS_XH), (const h16*)(ws + WS_WIN), 1024, 1024, 1024}; pg8::StaticOrder S; S.init(M, 2816, F.G, F.bid);
        EpiStoreSplit E{(h16*)(ws + WS_PRWKV), (h16*)(ws + WS_PMLA), (h16*)(ws + WS_U)}; pg8::gemm_phase(lds, g, S, E);
        } break;
    case 2: phase_prep(F, l); phase_s5<1>(F, l); break;
    case 3: {
        { pg8::Gemm g{(const h16*)(ws + WS_ALORA), (const h16*)(ws + WS_WLORA), 256, 256, 256}; pg8::StaticOrder S; S.init(M, 1536, F.G, F.bid);
          EpiLora E{(h16*)(ws + WS_LW), A.in[I_W0] + l * RD, A.in[I_A0] + l * RD}; pg8::gemm_phase(lds, g, S, E); }
        { pg8::Gemm g{(const h16*)(ws + WS_PMLA), (const h16*)(ws + WS_WQ), 512, 256, 256}; pg8::StaticOrder S; S.init(M, 768, F.G, F.bid);
          EpiQ E{(h16*)(ws + WS_QC), (const float*)(ws + WS_RSTDQ), (const float*)(ws + WS_COS), (const float*)(ws + WS_SIN)}; pg8::gemm_phase(lds, g, S, E); }
        { pg8::Gemm g{(const h16*)(ws + WS_PMLA) + 256, (const h16*)(ws + WS_WKV), 512, 128, 128}; pg8::StaticOrder S; S.init(M, 1024, F.G, F.bid);
          EpiKV E{(h16*)(ws + WS_KC), (h16*)(ws + WS_VA), (const float*)(ws + WS_RSTDKV)}; pg8::gemm_phase(lds, g, S, E); }
    } break;
    case 4: phase_s5<2>(F, l); phase_rwkv_chunks(F, l); break;
    case 5: {
        for (int rw = F.bid; rw < 16; rw += F.G) rwkv_seq_unit(F, rw >> 3, rw & 7);
#ifdef DBG_CHUNK
        __syncthreads();
        if (F.bid >= 16) for (int rw = F.bid - 16; rw < 64; rw += F.G) rwkv_scan_unit(F, l, rw >> 5, (rw >> 2) & 7, rw & 3);
        break;
#endif
        unsigned* qh = (unsigned*)(ws + WS_CTL) + CW_QUEUE * (1 + l); LAS unsigned* tk = (LAS unsigned*)(lds + AT_TICKET);
        for (;;) {
            if (F.tid == 0) tk[0] = __hip_atomic_fetch_add(qh, 1u, __ATOMIC_RELAXED, __HIP_MEMORY_SCOPE_AGENT);
            __syncthreads(); const unsigned u = tk[0]; __syncthreads();
            if (u >= 512u) break;
            attn_unit(F, (int)(u & 15u) >> 3, (int)(u & 7u), 31 - (int)(u >> 4));
        }
    } break;
#ifdef DBG_CHUNK
    case 6: if (l == 0) dbg_cmp_y(F); phase_rwkv_post(F, l, xres); break;
#else
    case 6: phase_rwkv_post(F, l, xres); break;
#endif
    case 7: { pg8::Gemm g{(const h16*)(ws + WS_XH2), (const h16*)(ws + WS_WG), 1024, 1024, 1024}; pg8::StaticOrder S; S.init(M, 3072, F.G, F.bid);
        EpiGate E{(h16*)(ws + WS_GATES), A.in[I_GATEB] + l * 3072}; pg8::gemm_phase(lds, g, S, E);
        } break;
    case 8: { pg8::StaticOrder S; S.init(M, 1024, F.G, F.bid); h16* mg = (h16*)(ws + WS_MERGED); const h16* gt = (const h16*)(ws + WS_GATES);
        for (int i = 0;; ++i) { Unit u; if (!S.next(i, u)) break;
            pg8::ListOrder L1{u, u, 1}; pg8::ListOrder L2{Unit{u.pm, 2 * u.pn}, Unit{u.pm, 2 * u.pn + 1}, 2};
            { pg8::Gemm g{(const h16*)(ws + WS_YAIN), (const h16*)(ws + WS_WRO), 512, 512, 512}; EpiBranch<0> E{mg, gt}; pg8::gemm_phase(lds, g, L1, E); }
            { pg8::Gemm g{(const h16*)(ws + WS_OATT), (const h16*)(ws + WS_WMO), 512, 512, 512}; EpiBranch<1> E{mg, gt}; pg8::gemm_phase(lds, g, L1, E); }
            { pg8::Gemm g{(const h16*)(ws + WS_YS5), (const h16*)(ws + WS_WGLU), 512, 512, 512}; EpiBranch<2> E{mg, gt}; pg8::gemm_phase(lds, g, L2, E); } }
    } break;
    case 9: { pg8::Gemm g{(const h16*)(ws + WS_MERGED), (const h16*)(ws + WS_WO), 1024, 1024, 1024}; pg8::StaticOrder S; S.init(M, 1024, F.G, F.bid);
        EpiPre E{xres, (float*)(ws + WS_PRE)}; pg8::gemm_phase(lds, g, S, E); } break;
    case 10: phase_ln(F, (const float*)(ws + WS_PRE), A.in[I_LN1G] + l * D, A.in[I_LN1B] + l * D, A.out, (h16*)(ws + WS_X1H)); break;
    case 11: { pg8::Gemm g{(const h16*)(ws + WS_X1H), (const h16*)(ws + WS_W13), 1024, 1024, 1024}; pg8::StaticOrder S; S.init(M, 5632, F.G, F.bid);
        EpiSwiGLU E{(h16*)(ws + WS_HB)}; pg8::gemm_phase(lds, g, S, E); } break;
    case 12: { pg8::Gemm g{(const h16*)(ws + WS_HB), (const h16*)(ws + WS_W2), DFF, DFF, DFF}; pg8::StaticOrder S; S.init(M, 1024, F.G, F.bid);
        EpiPre E{A.out, (float*)(ws + WS_PRE2)}; pg8::gemm_phase(lds, g, S, E); } break;
    case 13: phase_ln(F, (const float*)(ws + WS_PRE2), A.in[I_LN2G] + l * D, A.in[I_LN2B] + l * D, A.out, (h16*)(ws + WS_XH)); if (l + 1 < DEPTH) phase_convert(F, l + 1); break;
#ifdef DBG_CHUNK
    case 14: break;
#endif
    }
}
__global__ void __launch_bounds__(NTHREADS, 2) fwd(Args args) {
    extern __shared__ __attribute__((aligned(16))) unsigned char lds_raw[];
    Frame F; F.lds = (LAS unsigned char*)lds_raw; F.tid = threadIdx.x; F.lane = F.tid & 63; F.wave = __builtin_amdgcn_readfirstlane(F.tid >> 6);
    F.G = gridDim.x; F.bid = blockIdx.x; F.ws = args.ws; F.a = &args;
    volatile LAS unsigned* MISC = (volatile LAS unsigned*)(F.lds + MISC_OFF);
    if (F.tid < 32) MISC[F.tid] = 0u;
    __syncthreads();
    XcdBarrier bar; bar.bar = (unsigned*)(args.ws + WS_CTL) + CW_BAR; bar.x = 0; bar.st = nullptr;
    if (args.one_launch) bar = xcd_barrier_post((unsigned*)(args.ws + WS_CTL) + CW_BAR, MISC + 8);
    for (int ph = args.ph_lo; ph < args.ph_hi; ++ph) {
        run_phase(F, ph);
        if (ph + 1 < args.ph_hi) xcd_barrier(bar);
    }
#ifdef DBG_CHUNK
    xcd_barrier(bar); dbg_emit(F);
#endif
}

#ifndef MK_ONE_LAUNCH
#define MK_ONE_LAUNCH 1
#endif
extern "C" void kernel_launch(void* const* d_in, const int* in_sizes, int n_in, void* d_out, int out_size, void* d_ws, size_t ws_size, hipStream_t stream) {
    static int grid = 0;
    if (grid == 0) {
        if (n_in != 37 || out_size != M * D || ws_size < WS_END) { fprintf(stderr, "kernel_launch: unexpected shapes n_in %d out %d ws %zu\n", n_in, out_size, ws_size); grid = -1; return; }
        int dev = 0, cus = 0, per_cu = 0;
        if (hipGetDevice(&dev) != hipSuccess || hipDeviceGetAttribute(&cus, hipDeviceAttributeMultiprocessorCount, dev) != hipSuccess) { grid = -1; return; }
        if (hipFuncSetAttribute((const void*)fwd, hipFuncAttributeMaxDynamicSharedMemorySize, LDS_BYTES) != hipSuccess) { fprintf(stderr, "kernel_launch: hipFuncSetAttribute failed\n"); grid = -1; return; }
        if (hipOccupancyMaxActiveBlocksPerMultiprocessor(&per_cu, (const void*)fwd, NTHREADS, LDS_BYTES) != hipSuccess || per_cu < 1) { fprintf(stderr, "kernel_launch: occupancy query says %d\n", per_cu); (void)hipGetLastError(); grid = -1; return; }
        grid = cus;
    }
    if (grid < 0) return;
    (void)hipMemsetAsync((char*)d_ws + WS_CTL, 0, CTL_ZERO_BYTES, stream);
    Args a{};
    for (int i = 0; i < 37; ++i) a.in[i] = (const float*)d_in[i];
    a.out = (float*)d_out; a.ws = (unsigned char*)d_ws;
    for (int i = 0; i < 16; ++i) a.invfreq[i] = (float)pow(10000.0, -(double)i / 16.0);
    a.one_launch = MK_ONE_LAUNCH;
    if (MK_ONE_LAUNCH) { a.ph_lo = 0; a.ph_hi = NPH; hipLaunchKernelGGL(fwd, dim3(grid), dim3(NTHREADS), LDS_BYTES, stream, a); }
    else for (int ph = 0; ph < NPH; ++ph) { a.ph_lo = ph; a.ph_hi = ph + 1; hipLaunchKernelGGL(fwd, dim3(grid), dim3(NTHREADS), LDS_BYTES, stream, a);
    }
}
```

```cpp
#include <hip/hip_runtime.h>
#include <cstdio>
#include <cstdint>


#define LAS __attribute__((address_space(3)))
#define GAS __attribute__((address_space(1)))
typedef _Float16 h16;
typedef _Float16 h16x2 __attribute__((ext_vector_type(2)));
typedef _Float16 h16x4 __attribute__((ext_vector_type(4)));
typedef _Float16 h16x8 __attribute__((ext_vector_type(8)));
typedef float f32x2 __attribute__((ext_vector_type(2)));
typedef float f32x4 __attribute__((ext_vector_type(4)));
typedef float f32x16 __attribute__((ext_vector_type(16)));
typedef unsigned u32x2 __attribute__((ext_vector_type(2)));
typedef unsigned u32x4 __attribute__((ext_vector_type(4)));
typedef short s16x4 __attribute__((ext_vector_type(4)));

constexpr int BATCH = 2, T = 8192, D = 1024, M = BATCH * T, DEPTH = 2;
constexpr int RH = 8, RN = 64, RD = 512;
constexpr int RWKV_COLS = 1792, MLA_COLS = 416, IN_COLS = 5792, DFF = 2816;
constexpr int O_MLA = 1792, O_S5 = 2208, O_GATE = 2720;
constexpr float ALPHA = 1.4142135623730951f;
constexpr float LN_EPS = 1e-5f, RMS_EPS = 1e-6f, GN_EPS = 64e-5f;
constexpr float QSCALE = 0.10206207261596577f * 1.4426950408889634f;

__device__ __forceinline__ unsigned pkh(float lo, float hi) { h16x2 v = {(h16)lo, (h16)hi}; return __builtin_bit_cast(unsigned, v); }
__device__ __forceinline__ float sigm(float x) { return __builtin_amdgcn_rcpf(1.0f + __expf(-x)); }

namespace pg8 {
constexpr int BM = 256, BK = 64, HALF = 128, HTB = HALF * BK * 2, STAGE_BYTES = 8 * HTB, NXCD = 8, WGM = 8;
__host__ __device__ __forceinline__ int lds_byte(int r, int c) { const int st = (r >> 4) * 2 + (c >> 5), rr = r & 15, cc = c & 31, ob = rr * 64 + cc * 2; return st * 1024 + (ob ^ (((ob >> 9) & 1) << 5)); }
__host__ __device__ __forceinline__ void stage_rc(int b, int& R, int& C) { const int st = b / 1024, sb = b % 1024, swz = sb ^ (((sb >> 9) & 1) << 5); R = (st >> 1) * 16 + swz / 64; C = (st & 1) * 32 + (swz % 64) / 2; }
__host__ __device__ __forceinline__ int perm32(int rho) { const int n = rho >> 4, i = rho & 15; return 8 * (i >> 2) + 4 * n + (i & 3); }

struct Unit { int pm, pn; };
struct Gemm { const h16* A; const h16* Bt; int lda, ldb, K; };

struct StaticOrder {
    int nM, nN, nwg, G, c;
    __device__ __forceinline__ void init(int Mr, int N, int G_, int c_) { nM = Mr / BM; nN = N / BM; nwg = nM * nN; G = G_; c = c_; }
    __device__ __forceinline__ bool next(int i, Unit& u) const {
        const long L = (long)i * G + c; if (L >= nwg) return false;
        int wgid = (int)L; { const int q = nwg / NXCD, r = nwg % NXCD, xcd = wgid % NXCD, off = wgid / NXCD; wgid = (xcd < r ? xcd * (q + 1) : r * (q + 1) + (xcd - r) * q) + off; }
        const int nig = WGM * nN, gid = wgid / nig, fm = gid * WGM, gsz = (nM - fm) < WGM ? (nM - fm) : WGM;
        u.pm = fm + ((wgid % nig) % gsz); u.pn = (wgid % nig) / gsz; return true;
    }
};
struct ListOrder {
    Unit u0, u1; int n;
    __device__ __forceinline__ bool next(int i, Unit& u) const { if (i >= n) return false; u = (i == 0) ? u0 : u1; return true; }
};

template <class Epi, class Sched>
__device__ __forceinline__ void gemm_phase(LAS unsigned char* lds, const Gemm g, const Sched& S, const Epi& E) {
    int tid = threadIdx.x; asm volatile("" : "+v"(tid));
    const int wid = __builtin_amdgcn_readfirstlane(tid >> 6), lane = tid & 63, wr = wid >> 2, wc = wid & 3, fr = lane & 15, fq = lane >> 4;
    int K = g.K; asm volatile("" : "+s"(K)); const int nt = K / BK;
    unsigned voffA[2], voffB[2];
#pragma unroll
    for (int i = 0; i < 2; ++i) { int R, C; stage_rc(tid * 16 + i * 8192, R, C); const int Rb = Epi::PERM ? ((R & ~31) + perm32(R & 31)) : R;
        voffA[i] = (unsigned)(R * g.lda + C) * 2u; voffB[i] = (unsigned)(Rb * g.ldb + C) * 2u; }
    const size_t kstep = (size_t)(BK * 2);
    const size_t hstepA = (size_t)HALF * g.lda * 2, hstepB = (size_t)HALF * g.ldb * 2;
    const size_t tstepA = 2 * hstepA, tstepB = 2 * hstepB;
    const unsigned ldsw = (unsigned)wid * 1024u;
    const int aoff = lds_byte(wr * 64 + fr, fq * 8), boff = lds_byte(wc * 32 + fr, fq * 8);
#define PG8_SA(b, h) (((b) * 2 + (h)) * HTB)
#define PG8_SB(b, h) ((4 + (b) * 2 + (h)) * HTB)
#define PG8_STAGE(bufoff, gbase, voff) do { _Pragma("unroll") for (int _i = 0; _i < 2; ++_i) \
        __builtin_amdgcn_global_load_lds((const unsigned*)((const char*)(gbase) + (voff)[_i]), (LAS unsigned*)(lds + (bufoff) + ldsw + _i * 8192), 16, 0, 0); } while (0)
#define PG8_LDA(dst, b, h) do { _Pragma("unroll") for (int m = 0; m < 4; ++m) _Pragma("unroll") for (int k = 0; k < 2; ++k) dst[m][k] = *(const LAS h16x8*)(lds + PG8_SA(b, h) + aoff + m * 2048 + k * 1024); } while (0)
#define PG8_LDB(dst, b, h) do { _Pragma("unroll") for (int n = 0; n < 2; ++n) _Pragma("unroll") for (int k = 0; k < 2; ++k) dst[n][k] = *(const LAS h16x8*)(lds + PG8_SB(b, h) + boff + n * 2048 + k * 1024); } while (0)
#define PG8_MMA(ai, bj, At, Bt) do { __builtin_amdgcn_s_setprio(1); _Pragma("unroll") for (int m = 0; m < 4; ++m) _Pragma("unroll") for (int n = 0; n < 2; ++n) _Pragma("unroll") for (int k = 0; k < 2; ++k) \
        acc[ai][bj][m][n] = __builtin_amdgcn_mfma_f32_16x16x32_f16(Bt[n][k], At[m][k], acc[ai][bj][m][n], 0, 0, 0); __builtin_amdgcn_s_setprio(0); } while (0)
#define PG8_WAIT_V(n) asm volatile("s_waitcnt vmcnt(" #n ")" ::: "memory")
#define PG8_WAIT_L(n) asm volatile("s_waitcnt lgkmcnt(" #n ")" ::: "memory")
#define PG8_BAR __builtin_amdgcn_s_barrier()
#define PG8_SCHED __builtin_amdgcn_sched_barrier(0)
    Unit cur, nxt; int ui = 0;
    if (!S.next(0, cur)) return;
    f32x4 acc[2][2][4][2];
#pragma unroll
    for (int a = 0; a < 2; ++a)
#pragma unroll
        for (int b = 0; b < 2; ++b)
#pragma unroll
            for (int m = 0; m < 4; ++m)
#pragma unroll
                for (int n = 0; n < 2; ++n) acc[a][b][m][n] = (f32x4){0.f, 0.f, 0.f, 0.f};
    h16x8 At[4][2], B0[2][2], B1[2][2];
    const char* cA = (const char*)g.A + (size_t)cur.pm * tstepA; const char* cB = (const char*)g.Bt + (size_t)cur.pn * tstepB;
    {
        PG8_STAGE(PG8_SB(0, 0), cB, voffB); PG8_STAGE(PG8_SB(0, 1), cB + hstepB, voffB); PG8_STAGE(PG8_SA(0, 0), cA, voffA); PG8_STAGE(PG8_SA(0, 1), cA + hstepA, voffA);
        if (wr == 1) PG8_BAR;
        PG8_WAIT_V(2); PG8_BAR;
        PG8_STAGE(PG8_SB(1, 0), cB + kstep, voffB); PG8_STAGE(PG8_SA(1, 0), cA + kstep, voffA); PG8_STAGE(PG8_SB(1, 1), cB + hstepB + kstep, voffB);
        PG8_WAIT_V(6); PG8_BAR;
    }
    for (;;) {
        const bool has_next = S.next(ui + 1, nxt);
        const char* nA = has_next ? (const char*)g.A + (size_t)nxt.pm * tstepA : cA; const char* nB = has_next ? (const char*)g.Bt + (size_t)nxt.pn * tstepB : cB;
        for (int t = 0; t < nt; t += 2) {
            const bool last = (t == nt - 2);
            const char* a1 = cA + (size_t)(t + 1) * kstep;
            const char* a2 = last ? nA : cA + (size_t)(t + 2) * kstep; const char* b2 = last ? nB : cB + (size_t)(t + 2) * kstep;
            const char* a3 = a2 + kstep; const char* b3 = b2 + kstep;
            PG8_LDB(B0, 0, 0); PG8_LDB(B1, 0, 1); PG8_SCHED; PG8_LDA(At, 0, 0); PG8_STAGE(PG8_SA(1, 1), a1 + hstepA, voffA);
            PG8_WAIT_V(8); PG8_WAIT_L(0); PG8_BAR; PG8_MMA(0, 0, At, B0); PG8_MMA(0, 1, At, B1); PG8_BAR; PG8_SCHED;
            PG8_LDA(At, 0, 1); PG8_STAGE(PG8_SB(0, 0), b2, voffB); PG8_STAGE(PG8_SB(0, 1), b2 + hstepB, voffB); PG8_STAGE(PG8_SA(0, 0), a2, voffA);
            PG8_WAIT_V(8); PG8_WAIT_L(0); PG8_BAR; PG8_MMA(1, 0, At, B0); PG8_MMA(1, 1, At, B1); PG8_BAR; PG8_SCHED;
            PG8_LDB(B0, 1, 0); PG8_LDB(B1, 1, 1); PG8_SCHED; PG8_LDA(At, 1, 0); PG8_STAGE(PG8_SA(0, 1), a2 + hstepA, voffA);
            PG8_WAIT_V(8); PG8_WAIT_L(0); PG8_BAR; PG8_MMA(0, 0, At, B0); PG8_MMA(0, 1, At, B1); PG8_BAR; PG8_SCHED;
            PG8_LDA(At, 1, 1); PG8_STAGE(PG8_SB(1, 0), b3, voffB); PG8_STAGE(PG8_SB(1, 1), b3 + hstepB, voffB); PG8_STAGE(PG8_SA(1, 0), a3, voffA);
            PG8_WAIT_V(8); PG8_WAIT_L(0); PG8_BAR; PG8_MMA(1, 0, At, B0); PG8_MMA(1, 1, At, B1); PG8_BAR; PG8_SCHED;
        }
        if (wr == 0) PG8_BAR;
        { int fr_ = fr, fq_ = fq; asm volatile("" : "+v"(fr_), "+v"(fq_)); E(acc, cur, wr, wc, fr_, fq_); }
        if (!has_next) break;
#pragma unroll
        for (int a = 0; a < 2; ++a)
#pragma unroll
            for (int b = 0; b < 2; ++b)
#pragma unroll
                for (int m = 0; m < 4; ++m)
#pragma unroll
                    for (int n = 0; n < 2; ++n) acc[a][b][m][n] = (f32x4){0.f, 0.f, 0.f, 0.f};
        cur = nxt; cA = nA; cB = nB; ++ui;
        if (wr == 1) PG8_BAR;
    }
    PG8_WAIT_V(0);
    PG8_BAR;
#undef PG8_SA
#undef PG8_SB
#undef PG8_STAGE
#undef PG8_LDA
#undef PG8_LDB
#undef PG8_MMA
#undef PG8_WAIT_V
#undef PG8_WAIT_L
#undef PG8_BAR
#undef PG8_SCHED
}
}

using pg8::Unit; using pg8::HALF; using pg8::BM;
struct EpiStoreSplit {
    static constexpr bool PERM = true;
    h16* p_rwkv; h16* p_mla; h16* u;
    __device__ __forceinline__ void operator()(const f32x4 (&acc)[2][2][4][2], const Unit& un, int wr, int wc, int fr, int fq) const {
        h16* base; int ldc, colt;
        if (un.pn < 7) { base = p_rwkv; ldc = RWKV_COLS; colt = un.pn * BM; } else if (un.pn < 9) { base = p_mla; ldc = 512; colt = (un.pn - 7) * BM; } else { base = u; ldc = 512; colt = (un.pn - 9) * BM; }
        const int row0 = un.pm * BM + wr * 64 + fr, col0 = colt + wc * 32 + 8 * fq;
#pragma unroll
        for (int ai = 0; ai < 2; ++ai)
#pragma unroll
            for (int m = 0; m < 4; ++m) { h16* rowp = base + (size_t)(row0 + ai * HALF + m * 16) * ldc + col0;
#pragma unroll
                for (int bj = 0; bj < 2; ++bj) { const f32x4 v0 = acc[ai][bj][m][0], v1 = acc[ai][bj][m][1];
                    u32x4 w; w.x = pkh(v0[0], v0[1]); w.y = pkh(v0[2], v0[3]); w.z = pkh(v1[0], v1[1]); w.w = pkh(v1[2], v1[3]);
                    *(u32x4*)(rowp + bj * HALF) = w; } }
    }
};
struct EpiLora {
    static constexpr bool PERM = true;
    h16* lw; const float* w0; const float* a0;
    __device__ __forceinline__ void operator()(const f32x4 (&acc)[2][2][4][2], const Unit& un, int wr, int wc, int fr, int fq) const {
        const int kind = un.pn >> 1; h16* base = lw + (size_t)kind * (size_t)(8u << 20); const float* bias = kind == 0 ? w0 : a0;
        const int colt = (un.pn & 1) * BM; const int row0 = un.pm * BM + wr * 64 + fr, col0 = colt + wc * 32 + 8 * fq;
        f32x4 bv[2][2];
#pragma unroll
        for (int bj = 0; bj < 2; ++bj)
#pragma unroll
            for (int n = 0; n < 2; ++n) bv[bj][n] = kind < 2 ? *(const f32x4*)(bias + col0 + bj * HALF + 4 * n) : (f32x4){0.f, 0.f, 0.f, 0.f};
#pragma unroll
        for (int ai = 0; ai < 2; ++ai)
#pragma unroll
            for (int m = 0; m < 4; ++m) { h16* rowp = base + (size_t)(row0 + ai * HALF + m * 16) * RD + col0;
#pragma unroll
                for (int bj = 0; bj < 2; ++bj) { f32x4 v0 = acc[ai][bj][m][0] + bv[bj][0], v1 = acc[ai][bj][m][1] + bv[bj][1];
                    if (kind < 2) { const float sc = kind == 0 ? -0.6065306597126334f : 1.0f;
#pragma unroll
                        for (int e = 0; e < 4; ++e) { v0[e] = sc * sigm(v0[e]); v1[e] = sc * sigm(v1[e]); } }
                    u32x4 w; w.x = pkh(v0[0], v0[1]); w.y = pkh(v0[2], v0[3]); w.z = pkh(v1[0], v1[1]); w.w = pkh(v1[2], v1[3]);
                    *(u32x4*)(rowp + bj * HALF) = w; } }
    }
};
struct EpiQ {
    static constexpr bool PERM = false;
    h16* Qc; const float* rstd; const float* cosT; const float* sinT;
    __device__ __forceinline__ void operator()(const f32x4 (&acc)[2][2][4][2], const Unit& un, int wr, int wc, int fr, int fq) const {
        const int row0 = un.pm * BM + wr * 64 + fr;
#pragma unroll
        for (int ai = 0; ai < 2; ++ai)
#pragma unroll
            for (int m = 0; m < 4; ++m) { const int row = row0 + ai * HALF + m * 16; const float rs = rstd[row] * QSCALE; const int pos = row & (T - 1);
                const f32x4 cs = *(const f32x4*)(cosT + pos * 16 + 4 * fq), sn = *(const f32x4*)(sinT + pos * 16 + 4 * fq);
#pragma unroll
                for (int bj = 0; bj < 2; ++bj) { const int cb = un.pn * 8 + bj * 4 + wc;
                    f32x4 v0 = acc[ai][bj][m][0] * rs, v1 = acc[ai][bj][m][1] * rs;
                    if (cb % 3 == 2) { const f32x4 a = v0, b = v1; v0 = a * cs - b * sn; v1 = b * cs + a * sn; }
                    h16* p = Qc + (size_t)row * 768 + cb * 32 + 4 * fq;
                    u32x2 w0; w0.x = pkh(v0[0], v0[1]); w0.y = pkh(v0[2], v0[3]); *(u32x2*)p = w0;
                    u32x2 w1; w1.x = pkh(v1[0], v1[1]); w1.y = pkh(v1[2], v1[3]); *(u32x2*)(p + 16) = w1; } }
    }
};
struct EpiKV {
    static constexpr bool PERM = true;
    h16* Kc; h16* Va; const float* rstd;
    __device__ __forceinline__ void operator()(const f32x4 (&acc)[2][2][4][2], const Unit& un, int wr, int wc, int fr, int fq) const {
        const int row0 = un.pm * BM + wr * 64 + fr;
#pragma unroll
        for (int ai = 0; ai < 2; ++ai)
#pragma unroll
            for (int m = 0; m < 4; ++m) { const int row = row0 + ai * HALF + m * 16; const float rs = rstd[row];
#pragma unroll
                for (int bj = 0; bj < 2; ++bj) { const int c = un.pn * BM + bj * HALF + wc * 32 + 8 * fq, h = c >> 7, w = c & 127;
                    const f32x4 v0 = acc[ai][bj][m][0] * rs, v1 = acc[ai][bj][m][1] * rs;
                    u32x4 o; o.x = pkh(v0[0], v0[1]); o.y = pkh(v0[2], v0[3]); o.z = pkh(v1[0], v1[1]); o.w = pkh(v1[2], v1[3]);
                    h16* p = (w < 64) ? Kc + (size_t)row * 768 + h * 96 + w : Va + (size_t)row * 512 + h * 64 + (w - 64);
                    *(u32x4*)p = o; } }
    }
};
struct EpiGate {
    static constexpr bool PERM = true;
    h16* gates; const float* gb;
    __device__ __forceinline__ void operator()(const f32x4 (&acc)[2][2][4][2], const Unit& un, int wr, int wc, int fr, int fq) const {
        const int row0 = un.pm * BM + wr * 64 + fr, col0 = un.pn * BM + wc * 32 + 8 * fq;
        f32x4 bv[2][2];
#pragma unroll
        for (int bj = 0; bj < 2; ++bj)
#pragma unroll
            for (int n = 0; n < 2; ++n) bv[bj][n] = *(const f32x4*)(gb + col0 + bj * HALF + 4 * n);
#pragma unroll
        for (int ai = 0; ai < 2; ++ai)
#pragma unroll
            for (int m = 0; m < 4; ++m) { h16* rowp = gates + (size_t)(row0 + ai * HALF + m * 16) * 3072 + col0;
#pragma unroll
                for (int bj = 0; bj < 2; ++bj) { f32x4 v0 = acc[ai][bj][m][0] + bv[bj][0], v1 = acc[ai][bj][m][1] + bv[bj][1];
#pragma unroll
                    for (int e = 0; e < 4; ++e) { v0[e] = sigm(v0[e]); v1[e] = sigm(v1[e]); }
                    u32x4 w; w.x = pkh(v0[0], v0[1]); w.y = pkh(v0[2], v0[3]); w.z = pkh(v1[0], v1[1]); w.w = pkh(v1[2], v1[3]);
                    *(u32x4*)(rowp + bj * HALF) = w; } }
    }
};
__device__ __forceinline__ void unpk8(const u32x4 w, float (&o)[8]) {
    const unsigned a0 = w.x, a1 = w.y, a2 = w.z, a3 = w.w;
    const h16x2 h0 = __builtin_bit_cast(h16x2, a0), h1 = __builtin_bit_cast(h16x2, a1), h2 = __builtin_bit_cast(h16x2, a2), h3 = __builtin_bit_cast(h16x2, a3);
    o[0] = (float)h0[0]; o[1] = (float)h0[1]; o[2] = (float)h1[0]; o[3] = (float)h1[1]; o[4] = (float)h2[0]; o[5] = (float)h2[1]; o[6] = (float)h3[0]; o[7] = (float)h3[1];
}
__device__ __forceinline__ f32x4 h4_to_f4(u32x2 q) { const unsigned q0 = q.x, q1 = q.y; const h16x2 a = __builtin_bit_cast(h16x2, q0), b = __builtin_bit_cast(h16x2, q1); return (f32x4){(float)a[0], (float)a[1], (float)b[0], (float)b[1]}; }
template <int KIND> struct EpiBranch {
    static constexpr bool PERM = true;
    h16* merged; const h16* gates;
    __device__ __forceinline__ void operator()(const f32x4 (&acc)[2][2][4][2], const Unit& un, int wr, int wc, int fr, int fq) const {
        const int row0 = un.pm * BM + wr * 64 + fr;
#pragma unroll
        for (int ai = 0; ai < 2; ++ai)
#pragma unroll
            for (int m = 0; m < 4; ++m) { const int row = row0 + ai * HALF + m * 16;
#pragma unroll
                for (int bj = 0; bj < (KIND == 2 ? 1 : 2); ++bj) {
                    const int col = (KIND == 2 ? un.pn * HALF : un.pn * BM + bj * HALF) + wc * 32 + 8 * fq;
                    float v[8];
                    if (KIND == 2) { const f32x4 a0 = acc[ai][0][m][0], a1 = acc[ai][0][m][1], b0 = acc[ai][1][m][0], b1 = acc[ai][1][m][1];
#pragma unroll
                        for (int e = 0; e < 4; ++e) { v[e] = a0[e] * sigm(b0[e]); v[4 + e] = a1[e] * sigm(b1[e]); } }
                    else { const f32x4 a0 = acc[ai][bj][m][0], a1 = acc[ai][bj][m][1];
#pragma unroll
                        for (int e = 0; e < 4; ++e) { v[e] = a0[e]; v[4 + e] = a1[e]; } }
                    float gt[8]; unpk8(*(const u32x4*)(gates + (size_t)row * 3072 + KIND * 1024 + col), gt);
                    h16* mp = merged + (size_t)row * 1024 + col;
                    if (KIND != 0) { float old[8]; unpk8(*(const u32x4*)mp, old);
#pragma unroll
                        for (int e = 0; e < 8; ++e) v[e] = old[e] + gt[e] * v[e]; }
                    else {
#pragma unroll
                        for (int e = 0; e < 8; ++e) v[e] = gt[e] * v[e]; }
                    u32x4 w; w.x = pkh(v[0], v[1]); w.y = pkh(v[2], v[3]); w.z = pkh(v[4], v[5]); w.w = pkh(v[6], v[7]);
                    *(u32x4*)mp = w; } }
    }
};
struct EpiPre {
    static constexpr bool PERM = false;
    const float* xres; float* pre;
    __device__ __forceinline__ void operator()(const f32x4 (&acc)[2][2][4][2], const Unit& un, int wr, int wc, int fr, int fq) const {
        const int row0 = un.pm * BM + wr * 64 + fr, col0 = un.pn * BM + wc * 32 + 4 * fq;
#pragma unroll
        for (int ai = 0; ai < 2; ++ai)
#pragma unroll
            for (int m = 0; m < 4; ++m) { const size_t off = (size_t)(row0 + ai * HALF + m * 16) * D + col0;
#pragma unroll
                for (int bj = 0; bj < 2; ++bj)
#pragma unroll
                    for (int n = 0; n < 2; ++n) { const f32x4 xr = *(const f32x4*)(xres + off + bj * HALF + n * 16);
                        *(f32x4*)(pre + off + bj * HALF + n * 16) = xr * ALPHA + acc[ai][bj][m][n]; } }
    }
};
struct EpiSwiGLU {
    static constexpr bool PERM = true;
    h16* hb;
    __device__ __forceinline__ void operator()(const f32x4 (&acc)[2][2][4][2], const Unit& un, int wr, int wc, int fr, int fq) const {
        const int row0 = un.pm * BM + wr * 64 + fr, col0 = un.pn * HALF + wc * 32 + 8 * fq;
#pragma unroll
        for (int ai = 0; ai < 2; ++ai)
#pragma unroll
            for (int m = 0; m < 4; ++m) { const f32x4 a0 = acc[ai][0][m][0], a1 = acc[ai][0][m][1], b0 = acc[ai][1][m][0], b1 = acc[ai][1][m][1]; float v[8];
#pragma unroll
                for (int e = 0; e < 4; ++e) { v[e] = a0[e] * sigm(a0[e]) * b0[e]; v[4 + e] = a1[e] * sigm(a1[e]) * b1[e]; }
                u32x4 w; w.x = pkh(v[0], v[1]); w.y = pkh(v[2], v[3]); w.z = pkh(v[4], v[5]); w.w = pkh(v[6], v[7]);
                *(u32x4*)(hb + (size_t)(row0 + ai * HALF + m * 16) * DFF + col0) = w; }
    }
};

constexpr size_t MiB = 1u << 20;
constexpr size_t WS_CTL = 0, CTL_ZERO_BYTES = 1 * MiB;
constexpr size_t WS_COS = 1 * MiB, WS_SIN = 1 * MiB + 512 * 1024;
constexpr size_t WS_RSTDQ = 2 * MiB, WS_RSTDKV = 2 * MiB + 64 * 1024;
constexpr size_t WS_BS = 3 * MiB + 512 * 1024;
constexpr size_t WS_S5END = 2 * MiB + 512 * 1024;
constexpr size_t WS_WIN = 4 * MiB;
constexpr size_t WS_WG = WS_WIN + 5632 * 1024;
constexpr size_t WS_WLORA = WS_WG + 6 * MiB;
constexpr size_t WS_WQ = WS_WLORA + 768 * 1024;
constexpr size_t WS_WKV = WS_WQ + 384 * 1024;
constexpr size_t WS_WRO = WS_WKV + 256 * 1024;
constexpr size_t WS_WMO = WS_WRO + 1 * MiB;
constexpr size_t WS_WGLU = WS_WMO + 1 * MiB;
constexpr size_t WS_WO = WS_WGLU + 2 * MiB;
constexpr size_t WS_W13 = WS_WO + 2 * MiB;
constexpr size_t WS_W2 = WS_W13 + 11 * MiB;
static_assert(WS_W2 + 5632 * 1024 <= 40 * MiB, "weights region");
constexpr size_t SLOT0 = 40 * MiB, SLOT = 8 * MiB;
#define WS_SLOT(s) (SLOT0 + (size_t)(s) * SLOT)
constexpr size_t WS_XH = WS_SLOT(0), WS_PRWKV = WS_SLOT(4), WS_PMLA = WS_SLOT(11), WS_U = WS_SLOT(13);
constexpr size_t WS_KC = WS_SLOT(1), WS_ALORA = WS_SLOT(0), WS_R = WS_SLOT(15), WS_K = WS_SLOT(17), WS_V = WS_SLOT(19);
constexpr size_t WS_LW = WS_SLOT(5), WS_ASIG = WS_SLOT(7), WS_G = WS_SLOT(9), WS_QC = WS_SLOT(21), WS_VA = WS_SLOT(24);
constexpr size_t WS_YS5 = WS_SLOT(11), WS_OATT = WS_SLOT(13), WS_YRW0 = WS_SLOT(0), WS_YRW1 = WS_SLOT(26);
constexpr size_t WS_XH2 = WS_SLOT(3), WS_YAIN = WS_SLOT(1), WS_GATES = WS_SLOT(15), WS_MERGED = WS_SLOT(7);
constexpr size_t WS_PRE = WS_SLOT(11), WS_X1H = WS_SLOT(0), WS_HB = WS_SLOT(4), WS_PRE2 = WS_SLOT(15);
constexpr size_t WS_END = WS_SLOT(27);
static_assert(WS_ASIG == WS_LW + 16 * MiB && WS_G == WS_LW + 32 * MiB, "EpiLora strides");
static_assert(WS_END == 256 * MiB, "ws map");
constexpr int CW_BAR = 4096;
constexpr int CW_QUEUE = 64;

constexpr int LDS_BYTES = 147456;
constexpr int MISC_OFF = 131072 + 320;
constexpr int NWAVES = 8, NTHREADS = 512;

struct Args {
    const float* in[37]; float* out; unsigned char* ws; float invfreq[16]; int ph_lo, ph_hi; int one_launch, pad;
};
enum { I_X = 0, I_WIN, I_MU, I_W0, I_W2, I_A0, I_A2, I_G2, I_KK, I_KA, I_RK, I_GNG, I_GNB, I_ROUT, I_QNORM, I_QUP, I_KVNORM, I_KVUP, I_MOUT,
       I_LRE, I_LIM, I_LSTEP, I_BRE, I_BIM, I_CRE, I_CIM, I_S5D, I_GLU, I_GATEB, I_WOUT, I_LN1G, I_LN1B, I_W1, I_W3, I_FW2, I_LN2G, I_LN2B };

struct Frame {
    LAS unsigned char* lds; int tid, lane, wave, G, bid; unsigned char* ws; const Args* a;
};
__device__ __forceinline__ float wave_sum(float v) {
#pragma unroll
    for (int o = 1; o < 64; o <<= 1) v += __shfl_xor(v, o);
    return v;
}

__device__ __forceinline__ void cvt_item(const float* src, int ldsrc, int k0, int n0, h16* dst, int lddst, int drow0, int dk0, const float* kscale, LAS float* scr, int lane) {
    if (src) {
#pragma unroll 8
        for (int i = 0; i < 32; ++i) { const int kk = 2 * i + (lane >> 5); float v = src[(size_t)(k0 + kk) * ldsrc + n0 + (lane & 31)]; if (kscale) v *= kscale[k0 + kk]; scr[kk * 33 + (lane & 31)] = v; }
    }
    asm volatile("s_waitcnt lgkmcnt(0)" ::: "memory");
    const int c = lane & 7;
#pragma unroll
    for (int j = 0; j < 4; ++j) { const int n = (lane >> 3) + 8 * j; const LAS float* s = scr + (8 * c) * 33 + n;
        u32x4 o = {0u, 0u, 0u, 0u};
        if (src) { o.x = pkh(s[0 * 33], s[1 * 33]); o.y = pkh(s[2 * 33], s[3 * 33]); o.z = pkh(s[4 * 33], s[5 * 33]); o.w = pkh(s[6 * 33], s[7 * 33]); }
        *(u32x4*)(dst + (size_t)(drow0 + n) * lddst + dk0 + 8 * c) = o; }
    asm volatile("s_waitcnt lgkmcnt(0)" ::: "memory");
}
__device__ __forceinline__ void phase_convert(Frame& F, int l) {
    LAS float* scr = (LAS float*)(F.lds + F.wave * 16384);
    const int gw = F.bid * NWAVES + F.wave, NGW = F.G * NWAVES; unsigned char* ws = F.ws; const Args& A = *F.a;
    const float* win = A.in[I_WIN] + (size_t)l * D * IN_COLS;
    constexpr int N_WIN = 16 * 88, N_WG = 16 * 96, N_LORA = 4 * 48, N_Q = 4 * 24, N_KV = 2 * 32, N_RO = 8 * 32, N_MO = 8 * 32, N_GLU = 8 * 64, N_O = 16 * 32, N_13 = 16 * 176, N_2 = 44 * 32;
    constexpr int NITEMS = N_WIN + N_WG + N_LORA + N_Q + N_KV + N_RO + N_MO + N_GLU + N_O + N_13 + N_2;
    for (int it = gw; it < NITEMS; it += NGW) {
        int r = it;
        if (r < N_WIN) { const int kb = r / 88, db = r % 88;
            int sc; if (db < 56) sc = 32 * db; else if (db < 69) sc = O_MLA + 32 * (db - 56); else if (db < 72) sc = -1; else sc = O_S5 + 32 * (db - 72);
            cvt_item(sc >= 0 ? win : nullptr, IN_COLS, 64 * kb, sc, (h16*)(ws + WS_WIN), 1024, 32 * db, 64 * kb, nullptr, scr, F.lane); continue; } r -= N_WIN;
        if (r < N_WG) { const int kb = r / 96, db = r % 96;
            cvt_item(win, IN_COLS, 64 * kb, O_GATE + 32 * db, (h16*)(ws + WS_WG), 1024, 32 * db, 64 * kb, nullptr, scr, F.lane); continue; } r -= N_WG;
        if (r < N_LORA) { const int kb = r / 48, db = r % 48; const float* s = nullptr; int k0 = 0, n0 = 0;
            if (db < 16) { if (kb == 0) { s = A.in[I_W2] + (size_t)l * 64 * 512; k0 = 0; n0 = 32 * db; } }
            else if (db < 32) { if (kb == 1) { s = A.in[I_A2] + (size_t)l * 64 * 512; k0 = 0; n0 = 32 * (db - 16); } }
            else { if (kb >= 2) { s = A.in[I_G2] + (size_t)l * 128 * 512; k0 = 64 * (kb - 2); n0 = 32 * (db - 32); } }
            cvt_item(s, 512, k0, n0, (h16*)(ws + WS_WLORA), 256, 32 * db, 64 * kb, nullptr, scr, F.lane); continue; } r -= N_LORA;
        if (r < N_Q) { const int kb = r / 24, db = r % 24;
            cvt_item(A.in[I_QUP] + (size_t)l * 256 * 768, 768, 64 * kb, 32 * db, (h16*)(ws + WS_WQ), 256, 32 * db, 64 * kb, A.in[I_QNORM] + l * 256, scr, F.lane); continue; } r -= N_Q;
        if (r < N_KV) { const int kb = r / 32, db = r % 32;
            cvt_item(A.in[I_KVUP] + (size_t)l * 128 * 1024, 1024, 64 * kb, 32 * db, (h16*)(ws + WS_WKV), 128, 32 * db, 64 * kb, A.in[I_KVNORM] + l * 128, scr, F.lane); continue; } r -= N_KV;
        if (r < N_RO) { const int kb = r / 32, db = r % 32;
            cvt_item(A.in[I_ROUT] + (size_t)l * 512 * 1024, 1024, 64 * kb, 32 * db, (h16*)(ws + WS_WRO), 512, 32 * db, 64 * kb, nullptr, scr, F.lane); continue; } r -= N_RO;
        if (r < N_MO) { const int kb = r / 32, db = r % 32;
            cvt_item(A.in[I_MOUT] + (size_t)l * 512 * 1024, 1024, 64 * kb, 32 * db, (h16*)(ws + WS_WMO), 512, 32 * db, 64 * kb, nullptr, scr, F.lane); continue; } r -= N_MO;
        if (r < N_GLU) { const int kb = r / 64, db = r % 64, t = db >> 3, w = db & 7; const int sc = (w < 4) ? 128 * t + 32 * w : 1024 + 128 * t + 32 * (w - 4);
            cvt_item(A.in[I_GLU] + (size_t)l * 512 * 2048, 2048, 64 * kb, sc, (h16*)(ws + WS_WGLU), 512, 32 * db, 64 * kb, nullptr, scr, F.lane); continue; } r -= N_GLU;
        if (r < N_O) { const int kb = r / 32, db = r % 32;
            cvt_item(A.in[I_WOUT] + (size_t)l * 1024 * 1024, 1024, 64 * kb, 32 * db, (h16*)(ws + WS_WO), 1024, 32 * db, 64 * kb, nullptr, scr, F.lane); continue; } r -= N_O;
        if (r < N_13) { const int kb = r / 176, db = r % 176, t = db >> 3, w = db & 7; const float* s = (w < 4 ? A.in[I_W1] : A.in[I_W3]) + (size_t)l * 1024 * DFF;
            cvt_item(s, DFF, 64 * kb, 128 * t + 32 * (w & 3), (h16*)(ws + WS_W13), 1024, 32 * db, 64 * kb, nullptr, scr, F.lane); continue; } r -= N_13;
        { const int kb = r / 32, db = r % 32;
            cvt_item(A.in[I_FW2] + (size_t)l * DFF * 1024, 1024, 64 * kb, 32 * db, (h16*)(ws + WS_W2), DFF, 32 * db, 64 * kb, nullptr, scr, F.lane); }
    }
}
__device__ __forceinline__ void rows_to_h16(Frame& F, const float* x, h16* xh) {
    const int gw = F.bid * NWAVES + F.wave, NGW = F.G * NWAVES;
    for (int m = gw; m < M; m += NGW) { const f32x4* xr = (const f32x4*)(x + (size_t)m * D) + F.lane; u32x2* o = (u32x2*)(xh + (size_t)m * D) + F.lane;
#pragma unroll
        for (int j = 0; j < 4; ++j) { const f32x4 v = xr[64 * j]; u32x2 w; w.x = pkh(v.x, v.y); w.y = pkh(v.z, v.w); o[64 * j] = w; } }
}
__device__ __forceinline__ void rope_table(Frame& F) {
    float* cosT = (float*)(F.ws + WS_COS); float* sinT = (float*)(F.ws + WS_SIN);
    for (int i = F.bid * NTHREADS + F.tid; i < T * 16; i += F.G * NTHREADS) { const int pos = i >> 4, f = i & 15; const float ang = (float)pos * exp2f(-(float)f * 0.8304820237218406f); float s, c; sincosf(ang, &s, &c); cosT[i] = c; sinT[i] = s; }
}
__device__ __forceinline__ void phase_ln(Frame& F, const float* pre, const float* g, const float* b, float* xo, h16* xoh) {
    const int gw = F.bid * NWAVES + F.wave, NGW = F.G * NWAVES;
    f32x4 gv[4], bv[4];
#pragma unroll
    for (int j = 0; j < 4; ++j) { gv[j] = ((const f32x4*)g)[F.lane + 64 * j]; bv[j] = ((const f32x4*)b)[F.lane + 64 * j]; }
    for (int m = gw; m < M; m += NGW) {
        const f32x4* xr = (const f32x4*)(pre + (size_t)m * D) + F.lane; f32x4 v[4]; float s = 0.f;
#pragma unroll
        for (int j = 0; j < 4; ++j) { v[j] = xr[64 * j]; s += (v[j].x + v[j].y) + (v[j].z + v[j].w); }
        const float mean = wave_sum(s) * (1.f / D); float s2 = 0.f;
#pragma unroll
        for (int j = 0; j < 4; ++j) { v[j] = v[j] - mean; s2 += (v[j].x * v[j].x + v[j].y * v[j].y) + (v[j].z * v[j].z + v[j].w * v[j].w); }
        const float rstd = 1.f / sqrtf(wave_sum(s2) * (1.f / D) + LN_EPS);
        f32x4* o = (f32x4*)(xo + (size_t)m * D) + F.lane; u32x2* oh = (u32x2*)(xoh + (size_t)m * D) + F.lane;
#pragma unroll
        for (int j = 0; j < 4; ++j) { const f32x4 y = v[j] * rstd * gv[j] + bv[j]; o[64 * j] = y; u32x2 w; w.x = pkh(y.x, y.y); w.y = pkh(y.z, y.w); oh[64 * j] = w; }
    }
}

__device__ __forceinline__ void ld8(const h16* p, float (&o)[8]) { unpk8(*(const u32x4*)p, o); }
__device__ __forceinline__ void st8(LAS h16* p, const float (&v)[8]) { u32x4 w; w.x = pkh(v[0], v[1]); w.y = pkh(v[2], v[3]); w.z = pkh(v[4], v[5]); w.w = pkh(v[6], v[7]); *(LAS u32x4*)p = w; }
__device__ __forceinline__ void st8(h16* p, const float (&v)[8]) { u32x4 w; w.x = pkh(v[0], v[1]); w.y = pkh(v[2], v[3]); w.z = pkh(v[4], v[5]); w.w = pkh(v[6], v[7]); *(u32x4*)p = w; }
__device__ __forceinline__ void phase_prep(Frame& F, int l) {
    const int gw = F.bid * NWAVES + F.wave, NGW = F.G * NWAVES; unsigned char* ws = F.ws; const Args& A = *F.a; const int lane = F.lane;
    const h16* P = (const h16*)(ws + WS_PRWKV); const float* mu = A.in[I_MU] + l * RWKV_COLS;
    h16* R = (h16*)(ws + WS_R); h16* Kk = (h16*)(ws + WS_K); h16* V = (h16*)(ws + WS_V); h16* AL = (h16*)(ws + WS_ALORA);
    const h16* PM = (const h16*)(ws + WS_PMLA); h16* Kc = (h16*)(ws + WS_KC); float* rq = (float*)(ws + WS_RSTDQ); float* rkv = (float*)(ws + WS_RSTDKV);
    const float* cosT = (const float*)(ws + WS_COS); const float* sinT = (const float*)(ws + WS_SIN);
    for (int m = gw; m < M; m += NGW) {
        const int t = m & (T - 1);
#pragma unroll
        for (int j = 0; j < 4; ++j) { const int ch = lane + 64 * j;
            if (ch < 224) { const int c = 8 * ch; float p[8], q[8], o[8];
                ld8(P + (size_t)m * RWKV_COLS + c, p);
                if (t > 0) ld8(P + (size_t)(m - 1) * RWKV_COLS + c, q); else {
#pragma unroll
                    for (int e = 0; e < 8; ++e) q[e] = 0.f; }
                const f32x4 m0 = *(const f32x4*)(mu + c), m1 = *(const f32x4*)(mu + c + 4);
#pragma unroll
                for (int e = 0; e < 8; ++e) o[e] = p[e] + (q[e] - p[e]) * (e < 4 ? m0[e] : m1[e - 4]);
                if (c < 512) st8(R + (size_t)m * RD + c, o);
                else if (c < 1024) st8(Kk + (size_t)m * RD + (c - 512), o);
                else if (c < 1536) st8(V + (size_t)m * RD + (c - 1024), o);
                else { if (c < 1600) {
#pragma unroll
                        for (int e = 0; e < 8; ++e) o[e] = tanhf(o[e]); }
                    else if (c >= 1664) {
#pragma unroll
                        for (int e = 0; e < 8; ++e) o[e] = sigm(o[e]); }
                    st8(AL + (size_t)m * 256 + (c - 1536), o); } } }
        { float x[8]; float ss = 0.f;
            if (lane < 52) { ld8(PM + (size_t)m * 512 + 8 * lane, x);
#pragma unroll
                for (int e = 0; e < 8; ++e) ss += x[e] * x[e]; }
            else {
#pragma unroll
                for (int e = 0; e < 8; ++e) x[e] = 0.f; }
            const float sq = wave_sum(lane < 32 ? ss : 0.f), skv = wave_sum((lane >= 32 && lane < 48) ? ss : 0.f);
            if (lane == 0) { rq[m] = 1.0f / sqrtf(sq * (1.f / 256.f) + RMS_EPS); rkv[m] = 1.0f / sqrtf(skv * (1.f / 128.f) + RMS_EPS); }
            float y[8], o[8];
#pragma unroll
            for (int e = 0; e < 8; ++e) y[e] = __shfl_xor(x[e], 2);
            if (lane >= 48 && lane < 52) { const int i0 = 8 * (lane & 1); const bool second = lane >= 50;
#pragma unroll
                for (int e = 0; e < 8; ++e) { const float cs = cosT[t * 16 + i0 + e], sn = sinT[t * 16 + i0 + e];
                    o[e] = second ? (x[e] * cs + y[e] * sn) : (x[e] * cs - y[e] * sn); }
#pragma unroll
                for (int h = 0; h < 8; ++h) st8(Kc + (size_t)m * 768 + h * 96 + 64 + 8 * (lane - 48), o); } }
    }
}
__device__ __forceinline__ void phase_rwkv_post(Frame& F, int l, const float* xsrc) {
    const int gw = F.bid * NWAVES + F.wave, NGW = F.G * NWAVES; unsigned char* ws = F.ws; const Args& A = *F.a; const int lane = F.lane;
    const h16* R = (const h16*)(ws + WS_R); const h16* Kk = (const h16*)(ws + WS_K); const h16* V = (const h16*)(ws + WS_V);
    const h16* AS = (const h16*)(ws + WS_ASIG); const h16* G = (const h16*)(ws + WS_G); h16* YA = (h16*)(ws + WS_YAIN);
    const int c = 8 * lane;
    float ka[8], rk[8], gg[8], gb[8];
    { const f32x4 a0 = *(const f32x4*)(A.in[I_KA] + l * RD + c), a1 = *(const f32x4*)(A.in[I_KA] + l * RD + c + 4), r0 = *(const f32x4*)(A.in[I_RK] + l * RD + c), r1 = *(const f32x4*)(A.in[I_RK] + l * RD + c + 4);
      const f32x4 g0 = *(const f32x4*)(A.in[I_GNG] + l * RD + c), g1 = *(const f32x4*)(A.in[I_GNG] + l * RD + c + 4), b0 = *(const f32x4*)(A.in[I_GNB] + l * RD + c), b1 = *(const f32x4*)(A.in[I_GNB] + l * RD + c + 4);
#pragma unroll
      for (int e = 0; e < 4; ++e) { ka[e] = a0[e]; ka[4 + e] = a1[e]; rk[e] = r0[e]; rk[4 + e] = r1[e]; gg[e] = g0[e]; gg[4 + e] = g1[e]; gb[e] = b0[e]; gb[4 + e] = b1[e]; } }
    for (int m = gw; m < M; m += NGW) {
        const h16* Y = (const h16*)(ws + (m < T ? WS_YRW0 : WS_YRW1)) + (size_t)(m & (T - 1)) * RD;
        float y[8], v[8], g[8], o[8];
        ld8(Y + c, y); ld8(V + (size_t)m * RD + c, v); ld8(G + (size_t)m * RD + c, g);
        float s = 0.f; const float bs = ((const float*)(ws + WS_BS))[(size_t)m * 8 + (lane >> 3)];
#pragma unroll
        for (int e = 0; e < 8; ++e) s += y[e];
        s += __shfl_xor(s, 1); s += __shfl_xor(s, 2); s += __shfl_xor(s, 4);
        const float mean = s * (1.f / 64.f); float q = 0.f;
#pragma unroll
        for (int e = 0; e < 8; ++e) { y[e] -= mean; q += y[e] * y[e]; }
        q += __shfl_xor(q, 1); q += __shfl_xor(q, 2); q += __shfl_xor(q, 4);
        const float rstd = 1.0f / sqrtf(q * (1.f / 64.f) + GN_EPS);
#pragma unroll
        for (int e = 0; e < 8; ++e) o[e] = (y[e] * rstd * gg[e] + gb[e] + bs * v[e]) * g[e];
        st8(YA + (size_t)m * RD + c, o);
    }
    rows_to_h16(F, xsrc, (h16*)(ws + WS_XH2));
}

constexpr int S5_NC = 32, S5_CL = T / S5_NC;
__device__ __forceinline__ float rdlane(float v, int l) { return __builtin_bit_cast(float, __builtin_amdgcn_readlane(__builtin_bit_cast(int, v), l)); }
__device__ __forceinline__ float gelu_tanh(float x) { const float u = 0.7978845608028654f * (x + 0.044715f * x * x * x); return 0.5f * x * (1.0f + tanhf(u)); }
template <int PASS> __device__ __forceinline__ void phase_s5(Frame& F, int l) {
    const int gw = F.bid * NWAVES + F.wave, NGW = F.G * NWAVES; unsigned char* ws = F.ws; const Args& A = *F.a; const int lane = F.lane;
    const h16* U = (const h16*)(ws + WS_U); h16* Y = (h16*)(ws + WS_YS5); float* END = (float*)(ws + WS_S5END);
    LAS h16* sl = (LAS h16*)(F.lds + F.wave * 8704);
    for (int task = gw; task < BATCH * 32 * S5_NC; task += NGW) {
        const int ch = task % S5_NC, g = (task / S5_NC) % 32, b = task / (S5_NC * 32);
        const int gp = (l * 32 + g) * 64 + lane;
        const float lam_re = fminf(A.in[I_LRE][gp], -1e-4f), lam_im = A.in[I_LIM][gp], step = __expf(A.in[I_LSTEP][l * 32 + g]);
        float sn, cs; sincosf(lam_im * step, &sn, &cs); const float mag = __expf(lam_re * step);
        const float lb_re = mag * cs, lb_im = mag * sn, den = lam_re * lam_re + lam_im * lam_im, n_re = lb_re - 1.0f;
        const float f_re = (n_re * lam_re + lb_im * lam_im) / den, f_im = (lb_im * lam_re - n_re * lam_im) / den;
        float bbr[16], bbi[16];
#pragma unroll
        for (int q = 0; q < 4; ++q) { const f32x4 br = *(const f32x4*)(A.in[I_BRE] + (size_t)gp * 16 + 4 * q), bi = *(const f32x4*)(A.in[I_BIM] + (size_t)gp * 16 + 4 * q);
#pragma unroll
            for (int e = 0; e < 4; ++e) { bbr[4 * q + e] = f_re * br[e] - f_im * bi[e]; bbi[4 * q + e] = f_re * bi[e] + f_im * br[e]; } }
        float s_re = 0.f, s_im = 0.f;
        h16x8 cf[4]; float dsk = 0.f;
        if (PASS == 2) {
            float snL, csL; sincosf(lam_im * step * (float)S5_CL, &snL, &csL); const float magL = __expf(lam_re * step * (float)S5_CL); const float L_re = magL * csL, L_im = magL * snL;
            const float* e0 = END + ((size_t)(b * 32 + g) * S5_NC) * 128 + 2 * lane;
            for (int j = 0; j < ch; ++j) { const f32x2 e = *(const f32x2*)(e0 + j * 128); const float nr = s_re * L_re - s_im * L_im + e.x, ni = s_re * L_im + s_im * L_re + e.y; s_re = nr; s_im = ni; }
            const int c = lane & 15, kg = lane >> 4;
#pragma unroll
            for (int ks = 0; ks < 4; ++ks) { const int k = 32 * ks + 8 * kg; const float* src = (k < 64 ? A.in[I_CRE] : A.in[I_CIM]) + ((size_t)(l * 32 + g) * 16 + c) * 64 + (k & 63); const float sg = k < 64 ? 1.f : -1.f;
                const f32x4 a0 = *(const f32x4*)src, a1 = *(const f32x4*)(src + 4);
                cf[ks] = (h16x8){(h16)(sg * a0[0]), (h16)(sg * a0[1]), (h16)(sg * a0[2]), (h16)(sg * a0[3]), (h16)(sg * a1[0]), (h16)(sg * a1[1]), (h16)(sg * a1[2]), (h16)(sg * a1[3])}; }
            dsk = A.in[I_S5D][l * 512 + 16 * g + c];
        }
        const size_t m0 = (size_t)b * T + (size_t)ch * S5_CL;
        for (int tile = 0; tile < S5_CL / 64; ++tile) {
            float uv[16]; { const h16* up = U + (m0 + 64 * tile + lane) * 512 + 16 * g; float a[8], c2[8]; ld8(up, a); ld8(up + 8, c2);
#pragma unroll
                for (int e = 0; e < 8; ++e) { uv[e] = a[e]; uv[8 + e] = c2[e]; } }
#pragma unroll 1
            for (int half = 0; half < 2; ++half) {
#pragma unroll 2
                for (int tt = 0; tt < 32; ++tt) { const int tl = 32 * half + tt; float br = 0.f, bi = 0.f;
#pragma unroll
                    for (int c = 0; c < 16; ++c) { const float uc = rdlane(uv[c], tl); br += bbr[c] * uc; bi += bbi[c] * uc; }
                    const float nr = s_re * lb_re - s_im * lb_im + br, ni = s_re * lb_im + s_im * lb_re + bi; s_re = nr; s_im = ni;
                    if (PASS == 2) { sl[tt * 136 + lane] = (h16)s_re; sl[tt * 136 + 64 + lane] = (h16)s_im; } }
                if (PASS == 2) {
                    asm volatile("s_waitcnt lgkmcnt(0)" ::: "memory");
                    const int c = lane & 15, kg = lane >> 4;
#pragma unroll
                    for (int mb = 0; mb < 2; ++mb) { f32x4 acc = {0.f, 0.f, 0.f, 0.f};
#pragma unroll
                        for (int ks = 0; ks < 4; ++ks) { const h16x8 af = *(const LAS h16x8*)(sl + (mb * 16 + c) * 136 + 32 * ks + 8 * kg); acc = __builtin_amdgcn_mfma_f32_16x16x32_f16(af, cf[ks], acc, 0, 0, 0); }
#pragma unroll
                        for (int e = 0; e < 4; ++e) { const size_t m = m0 + 64 * tile + 32 * half + mb * 16 + 4 * kg + e; const float uu = (float)U[m * 512 + 16 * g + c];
                            Y[m * 512 + 16 * g + c] = (h16)gelu_tanh(acc[e] + dsk * uu); } }
                    asm volatile("s_waitcnt lgkmcnt(0)" ::: "memory");
                }
            }
        }
        if (PASS == 1) { *(f32x2*)(END + ((size_t)(b * 32 + g) * S5_NC + ch) * 128 + 2 * lane) = (f32x2){s_re, s_im}; }
    }
}

#ifdef DBG_CHUNK
#define CKO_G  WS_SLOT(21)
#define CKO_H  WS_SLOT(23)
#define CKO_RB WS_SLOT(1)
#define CKO_YB WS_SLOT(13)
#define YREF0  WS_SLOT(3)
#define YREF1  WS_SLOT(25)
#else
#define CKO_G  WS_R
#define CKO_H  WS_K
#define CKO_RB WS_LW
#define CKO_YB WS_ASIG
#endif
constexpr int RW_TS = 32, RW_BUF = 5 * 8192 + 2048 + 256;
template <int CTRL> __device__ __forceinline__ float dpp_add(float v) { return v + __builtin_bit_cast(float, __builtin_amdgcn_update_dpp(0, __builtin_bit_cast(int, v), CTRL, 0xf, 0xf, false)); }
__device__ __forceinline__ float red16(float v) { v = dpp_add<0xB1>(v); v = dpp_add<0x4E>(v); v = dpp_add<0x141>(v); v = dpp_add<0x140>(v); return v; }
__device__ __forceinline__ void rwkv_scan_unit(Frame& F, int l, int b, int h, int q) {
    unsigned char* ws = F.ws; const Args& A = *F.a; const int tid = F.tid, lane = F.lane, wave = F.wave;
    const h16* R = (const h16*)(ws + WS_R); const h16* Kk = (const h16*)(ws + WS_K); const h16* V = (const h16*)(ws + WS_V);
    const h16* LW = (const h16*)(ws + WS_LW); const h16* AS = (const h16*)(ws + WS_ASIG);
#ifdef DBG_CHUNK
    h16* Yg = (h16*)(ws + (b == 0 ? YREF0 : YREF1));
#else
    h16* Yg = (h16*)(ws + (b == 0 ? WS_YRW0 : WS_YRW1));
#endif
    LAS unsigned char* lds = F.lds;
    const size_t base = (size_t)b * T * RD + h * 64;
    if (wave >= 4) {
        const int c = lane; const float kkc = A.in[I_KK][l * RD + h * 64 + c], kac = A.in[I_KA][l * RD + h * 64 + c];
        for (int tile = 0; tile < T / RW_TS; ++tile) {
            LAS float* buf = (LAS float*)(lds + (tile & 1) * RW_BUF);
            float r[8], k[8], v[8], lw[8], as[8];
#pragma unroll
            for (int i = 0; i < 8; ++i) { const size_t idx = base + (size_t)(tile * RW_TS + (wave - 4) * 8 + i) * RD + c;
                r[i] = (float)R[idx]; k[i] = (float)Kk[idx]; v[i] = (float)V[idx]; lw[i] = (float)LW[idx]; as[i] = (float)AS[idx]; }
#pragma unroll
            for (int i = 0; i < 8; ++i) { const int tt = (wave - 4) * 8 + i;
                const float kkr = k[i] * kkc; const float n2 = wave_sum(kkr * kkr); const float kk = kkr * (1.0f / sqrtf(fmaxf(n2, 1e-12f)));
                const float bq = kk * as[i], kp = k[i] * (1.0f + (as[i] - 1.0f) * kac), w = __expf(lw[i]);
                const float brs = wave_sum(bq * r[i]), krs = wave_sum(kp * r[i]);
                buf[tt * 64 + c] = -kk; buf[2048 + tt * 64 + c] = w * r[i]; buf[4096 + tt * 64 + c] = w; buf[6144 + tt * 64 + c] = bq; buf[8192 + tt * 64 + c] = kp;
                if ((c >> 4) == q) buf[10240 + tt * 16 + (c & 15)] = v[i];
                if (c == 0) { buf[10752 + tt * 2] = brs; buf[10752 + tt * 2 + 1] = krs; } }
            __syncthreads();
        }
        __syncthreads();
    } else {
        const int row = tid >> 4, kq = tid & 15;
        float S0 = 0.f, S1 = 0.f, S2 = 0.f, S3 = 0.f;
        __syncthreads();
        for (int tile = 0; tile < T / RW_TS; ++tile) {
            const LAS float* buf = (const LAS float*)(lds + (tile & 1) * RW_BUF);
            float y0 = 0.f, y1 = 0.f;
#pragma unroll
            for (int tt = 0; tt < RW_TS; ++tt) {
                const f32x4 a4 = *(const LAS f32x4*)(buf + tt * 64 + 4 * kq), wr4 = *(const LAS f32x4*)(buf + 2048 + tt * 64 + 4 * kq), w4 = *(const LAS f32x4*)(buf + 4096 + tt * 64 + 4 * kq);
                const f32x4 b4 = *(const LAS f32x4*)(buf + 6144 + tt * 64 + 4 * kq), k4 = *(const LAS f32x4*)(buf + 8192 + tt * 64 + 4 * kq);
                const float vv = buf[10240 + tt * 16 + row]; const f32x2 sc = *(const LAS f32x2*)(buf + 10752 + tt * 2);
                float d1 = (S0 * a4[0] + S1 * a4[1]) + (S2 * a4[2] + S3 * a4[3]);
                float d2 = (S0 * wr4[0] + S1 * wr4[1]) + (S2 * wr4[2] + S3 * wr4[3]);
                d1 = red16(d1); d2 = red16(d2);
                S0 = S0 * w4[0] + d1 * b4[0] + vv * k4[0]; S1 = S1 * w4[1] + d1 * b4[1] + vv * k4[1];
                S2 = S2 * w4[2] + d1 * b4[2] + vv * k4[2]; S3 = S3 * w4[3] + d1 * b4[3] + vv * k4[3];
                const float y = d2 + d1 * sc.x + vv * sc.y;
                if (kq == (tt & 15)) { if (tt < 16) y0 = y; else y1 = y; }
            }
            { const size_t o = (size_t)(tile * RW_TS + kq) * RD + h * 64 + 16 * q + row; Yg[o] = (h16)y0; Yg[o + 16 * RD] = (h16)y1; }
            __syncthreads();
        }
    }
}


constexpr int CK_LDH = 72, CK_MAT = 64 * CK_LDH * 2;
constexpr int CK_RT = 0, CK_AT = CK_MAT, CK_BN = 2 * CK_MAT, CK_KN = 3 * CK_MAT, CK_BT = 4 * CK_MAT, CK_KT = 5 * CK_MAT, CK_VT = 6 * CK_MAT, CK_LAK = 7 * CK_MAT, CK_MRB = 8 * CK_MAT, CK_MRK = 9 * CK_MAT,
              CK_ABT = 10 * CK_MAT, CK_UBT = 11 * CK_MAT, CK_L32 = 12 * CK_MAT  , CK_X32 = CK_BN  , CK_SM = CK_L32 + 16384  ;
static_assert(CK_SM + 512 <= 131072 && 2 * CK_MAT >= 16384, "chunk LDS map");
template <int KS> __device__ __forceinline__ void ck_mm2(f32x4& acc0, f32x4& acc1, const LAS unsigned char* A, int mb0, const LAS unsigned char* Bt, int nb, int lane) {
    const int row = lane & 15, kg = lane >> 4;
#pragma unroll
    for (int ks = 0; ks < KS; ++ks) { const h16x8 b = *(const LAS h16x8*)(Bt + ((16 * nb + row) * CK_LDH + 32 * ks + 8 * kg) * 2);
        const h16x8 a0 = *(const LAS h16x8*)(A + ((16 * mb0 + row) * CK_LDH + 32 * ks + 8 * kg) * 2), a1 = *(const LAS h16x8*)(A + ((16 * mb0 + 16 + row) * CK_LDH + 32 * ks + 8 * kg) * 2);
        acc0 = __builtin_amdgcn_mfma_f32_16x16x32_f16(a0, b, acc0, 0, 0, 0); acc1 = __builtin_amdgcn_mfma_f32_16x16x32_f16(a1, b, acc1, 0, 0, 0); }
}
__device__ __forceinline__ void rwkv_chunk_item(Frame& F, int l, int b, int h, int c) {
    unsigned char* ws = F.ws; const Args& A = *F.a; int tid = F.tid; asm volatile("" : "+v"(tid)); const int lane = tid & 63, w = F.wave; LAS unsigned char* lds = F.lds;
    h16* R = (h16*)(ws + WS_R); h16* Kk = (h16*)(ws + WS_K); const h16* V = (const h16*)(ws + WS_V); h16* LW = (h16*)(ws + WS_LW); h16* AS = (h16*)(ws + WS_ASIG); float* BS = (float*)(ws + WS_BS);
    const size_t m0 = (size_t)b * T + (size_t)c * 64; const size_t tile = m0 * RD + h * 64;
    LAS float* cum = (LAS float*)(lds + CK_L32); LAS float* sm = (LAS float*)(lds + CK_SM);
    const int t = tid >> 3, c8 = tid & 7, k0 = 8 * c8;
    float lwv[8]; ld8(LW + tile + (size_t)t * RD + k0, lwv);
    *(LAS f32x4*)(cum + t * 64 + k0) = (f32x4){lwv[0], lwv[1], lwv[2], lwv[3]}; *(LAS f32x4*)(cum + t * 64 + k0 + 4) = (f32x4){lwv[4], lwv[5], lwv[6], lwv[7]};
    float rv[8], kv[8], vv[8], av[8];
    ld8(R + tile + (size_t)t * RD + k0, rv); ld8(Kk + tile + (size_t)t * RD + k0, kv); ld8(V + tile + (size_t)t * RD + k0, vv); ld8(AS + tile + (size_t)t * RD + k0, av);
    __syncthreads();
    if (w == 0) { float run = 0.f, rho = 0.f;
#pragma unroll 8
        for (int tt = 0; tt < 64; ++tt) { run += cum[tt * 64 + lane]; cum[tt * 64 + lane] = run; if (tt == 31) rho = run; }
        sm[lane] = __expf(rho); sm[64 + lane] = __expf(run - rho); sm[128 + lane] = rho; }
    __syncthreads();
    { float kkr[8], n2 = 0.f, bsum = 0.f; float kp[8];
      const f32x4 kk0 = *(const f32x4*)(A.in[I_KK] + l * RD + h * 64 + k0), kk1 = *(const f32x4*)(A.in[I_KK] + l * RD + h * 64 + k0 + 4), ka0 = *(const f32x4*)(A.in[I_KA] + l * RD + h * 64 + k0), ka1 = *(const f32x4*)(A.in[I_KA] + l * RD + h * 64 + k0 + 4);
      const f32x4 rk0 = *(const f32x4*)(A.in[I_RK] + l * RD + h * 64 + k0), rk1 = *(const f32x4*)(A.in[I_RK] + l * RD + h * 64 + k0 + 4);
#pragma unroll
      for (int e = 0; e < 8; ++e) { const float kkc = e < 4 ? kk0[e] : kk1[e - 4], kac = e < 4 ? ka0[e] : ka1[e - 4], rkc = e < 4 ? rk0[e] : rk1[e - 4];
          kkr[e] = kv[e] * kkc; n2 += kkr[e] * kkr[e]; kp[e] = kv[e] * (1.0f + (av[e] - 1.0f) * kac); bsum += rv[e] * kp[e] * rkc; }
      n2 += __shfl_xor(n2, 1); n2 += __shfl_xor(n2, 2); n2 += __shfl_xor(n2, 4); bsum += __shfl_xor(bsum, 1); bsum += __shfl_xor(bsum, 2); bsum += __shfl_xor(bsum, 4);
      if (c8 == 0) BS[(m0 + t) * 8 + h] = bsum;
      const float rn = 1.0f / sqrtf(fmaxf(n2, 1e-12f));
      float Rt[8], At[8], Kt[8], Bt[8];
#pragma unroll
      for (int e = 0; e < 8; ++e) { const float cu = cum[t * 64 + k0 + e], rho = sm[128 + k0 + e]; const float e1 = __expf(cu - rho), e2 = __expf(rho - cu), e0 = __expf(cu - lwv[e] - rho), kk = kkr[e] * rn;
          Rt[e] = rv[e] * e1; At[e] = -kk * e0; Kt[e] = kp[e] * e2; Bt[e] = kk * av[e] * e2; }
      st8((LAS h16*)(lds + CK_RT) + t * CK_LDH + k0, Rt); st8((LAS h16*)(lds + CK_AT) + t * CK_LDH + k0, At); st8((LAS h16*)(lds + CK_BN) + t * CK_LDH + k0, Bt); st8((LAS h16*)(lds + CK_KN) + t * CK_LDH + k0, Kt);
#pragma unroll
      for (int e = 0; e < 8; ++e) { ((LAS h16*)(lds + CK_BT))[(k0 + e) * CK_LDH + t] = (h16)Bt[e]; ((LAS h16*)(lds + CK_KT))[(k0 + e) * CK_LDH + t] = (h16)Kt[e]; ((LAS h16*)(lds + CK_VT))[(k0 + e) * CK_LDH + t] = (h16)vv[e]; } }
    __syncthreads();
    const int nb = w & 3, mb0 = 2 * (w >> 2), n_ = 16 * nb + (lane & 15), kg = lane >> 4;
    { f32x4 a0 = {}, a1 = {}, b0 = {}, b1 = {}, c0 = {}, c1 = {}, d0 = {}, d1 = {};
      ck_mm2<2>(a0, a1, lds + CK_BN, mb0, lds + CK_AT, nb, lane); ck_mm2<2>(b0, b1, lds + CK_KN, mb0, lds + CK_AT, nb, lane);
      ck_mm2<2>(c0, c1, lds + CK_BN, mb0, lds + CK_RT, nb, lane); ck_mm2<2>(d0, d1, lds + CK_KN, mb0, lds + CK_RT, nb, lane);
      __syncthreads();
#pragma unroll
      for (int mbi = 0; mbi < 2; ++mbi) { const int i0 = 16 * (mb0 + mbi) + 4 * kg; const f32x4 la = mbi ? a1 : a0, lk = mbi ? b1 : b0, mr = mbi ? c1 : c0, mk = mbi ? d1 : d0;
          f32x4 o; float x[4], y[4], z[4];
#pragma unroll
          for (int e = 0; e < 4; ++e) { const bool st = (i0 + e) < n_, inc = (i0 + e) <= n_; o[e] = st ? la[e] : 0.f; x[e] = st ? lk[e] : 0.f; y[e] = inc ? mr[e] : 0.f; z[e] = inc ? mk[e] : 0.f; }
          *(LAS f32x4*)((LAS float*)(lds + CK_L32) + n_ * 64 + i0) = o;
          *(LAS u32x2*)((LAS h16*)(lds + CK_LAK) + n_ * CK_LDH + i0) = (u32x2){pkh(x[0], x[1]), pkh(x[2], x[3])};
          *(LAS u32x2*)((LAS h16*)(lds + CK_MRB) + n_ * CK_LDH + i0) = (u32x2){pkh(y[0], y[1]), pkh(y[2], y[3])};
          *(LAS u32x2*)((LAS h16*)(lds + CK_MRK) + n_ * CK_LDH + i0) = (u32x2){pkh(z[0], z[1]), pkh(z[2], z[3])}; } }
    __syncthreads();
    { f32x4 a0 = {}, a1 = {}; ck_mm2<2>(a0, a1, lds + CK_VT, mb0, lds + CK_LAK, nb, lane);
      *(LAS f32x4*)((LAS float*)(lds + CK_X32) + n_ * 64 + 16 * mb0 + 4 * kg) = a0; *(LAS f32x4*)((LAS float*)(lds + CK_X32) + n_ * 64 + 16 * mb0 + 16 + 4 * kg) = a1; }
    __syncthreads();
    asm volatile("" ::: "memory");
    if (w < 2) { float W[64]; int zl = 0; asm volatile("" : "+v"(zl)); const LAS float* L = (const LAS float*)(lds + CK_L32) + zl;
#pragma unroll
        for (int tt = 0; tt < 64; ++tt) { float acc = (w == 0) ? (float)((const LAS h16*)(lds + CK_AT))[tt * CK_LDH + lane] : ((const LAS float*)(lds + CK_X32))[tt * 64 + lane];
#pragma unroll
            for (int i = 0; i < tt; ++i) acc += L[tt * 64 + i] * W[i];
            W[tt] = acc; asm volatile("" : "+v"(W[tt]) :: "memory"); }
        LAS h16* dst = (LAS h16*)(lds + (w == 0 ? CK_ABT : CK_UBT)) + lane * CK_LDH;
#pragma unroll
        for (int q = 0; q < 8; ++q) { const float o8[8] = {W[8 * q], W[8 * q + 1], W[8 * q + 2], W[8 * q + 3], W[8 * q + 4], W[8 * q + 5], W[8 * q + 6], W[8 * q + 7]}; st8(dst + 8 * q, o8); } }
    __syncthreads();
    { f32x4 r0 = {}, r1 = {}, y0 = {}, y1 = {}, g0 = {}, g1 = {}, h0 = {}, h1 = {};
      ck_mm2<2>(r0, r1, lds + CK_ABT, mb0, lds + CK_MRB, nb, lane);
      ck_mm2<2>(y0, y1, lds + CK_MRB, mb0, lds + CK_UBT, nb, lane); ck_mm2<2>(y0, y1, lds + CK_MRK, mb0, lds + CK_VT, nb, lane);
      ck_mm2<2>(g0, g1, lds + CK_ABT, mb0, lds + CK_BT, nb, lane);
      ck_mm2<2>(h0, h1, lds + CK_BT, mb0, lds + CK_UBT, nb, lane); ck_mm2<2>(h0, h1, lds + CK_KT, mb0, lds + CK_VT, nb, lane);
      const float dcn = sm[64 + n_];
#pragma unroll
      for (int mbi = 0; mbi < 2; ++mbi) { const int m_ = 16 * (mb0 + mbi) + 4 * kg; const f32x4 rr = mbi ? r1 : r0, yy = mbi ? y1 : y0, gg = mbi ? g1 : g0, hh = mbi ? h1 : h0;
          const f32x4 er = *(const LAS f32x4*)(sm + m_); const f32x4 rt = h4_to_f4(*(const LAS u32x2*)((const LAS h16*)(lds + CK_RT) + n_ * CK_LDH + m_));
          float o[4];
#pragma unroll
          for (int e = 0; e < 4; ++e) o[e] = (rt[e] + rr[e]) * er[e];
          *(u32x2*)((h16*)(ws + CKO_RB) + tile + (size_t)n_ * RD + m_) = (u32x2){pkh(o[0], o[1]), pkh(o[2], o[3])};
          *(u32x2*)((h16*)(ws + CKO_YB) + tile + (size_t)n_ * RD + m_) = (u32x2){pkh(yy[0], yy[1]), pkh(yy[2], yy[3])};
#pragma unroll
          for (int e = 0; e < 4; ++e) o[e] = dcn * (gg[e] + ((m_ + e) == n_ ? 1.0f : 0.0f)) * er[e];
          *(u32x2*)((h16*)(ws + CKO_G) + tile + (size_t)n_ * RD + m_) = (u32x2){pkh(o[0], o[1]), pkh(o[2], o[3])};
          { const f32x4 dm = *(const LAS f32x4*)(sm + 64 + m_); *(u32x2*)((h16*)(ws + CKO_H) + tile + (size_t)n_ * RD + m_) = (u32x2){pkh(dm[0] * hh[0], dm[1] * hh[1]), pkh(dm[2] * hh[2], dm[3] * hh[3])}; } } }
    __syncthreads();
}
__device__ __forceinline__ void phase_rwkv_chunks(Frame& F, int l) {
    for (int it = F.bid; it < BATCH * RH * (T / 64); it += F.G) rwkv_chunk_item(F, l, it >> 10, (it >> 7) & 7, it & 127);
}


struct SeqOps { u32x2 g[4][2][2], hi[4]; };
__device__ __forceinline__ void seq_load(SeqOps& o, const h16* Gm, const h16* Hm, size_t tile, int w, int lane) {
    const int row = lane & 15, kg = lane >> 4;
#pragma unroll
    for (int blk = 0; blk < 4; ++blk) {
#pragma unroll
        for (int s2 = 0; s2 < 2; ++s2) { const size_t off = tile + (size_t)(16 * blk + row) * RD + 32 * s2 + 4 * kg; o.g[blk][s2][0] = *(const u32x2*)(Gm + off); o.g[blk][s2][1] = *(const u32x2*)(Gm + off + 16); }
        o.hi[blk] = *(const u32x2*)(Hm + tile + (size_t)(16 * w + row) * RD + 16 * blk + 4 * kg); }
}
__device__ __forceinline__ h16x8 mk_frag(u32x2 lo, u32x2 hi) { const u32x4 v = {lo.x, lo.y, hi.x, hi.y}; return __builtin_bit_cast(h16x8, v); }
__device__ __forceinline__ void seq_step(f32x4 (&ST)[4], const SeqOps& o, h16* Sc, size_t soff, int lane) {
    const int kg = lane >> 4; u32x2 pk[4];
#pragma unroll
    for (int kb = 0; kb < 4; ++kb) { pk[kb] = (u32x2){pkh(ST[kb][0], ST[kb][1]), pkh(ST[kb][2], ST[kb][3])}; *(u32x2*)(Sc + soff + 16 * kb + 4 * kg) = pk[kb]; }
    const h16x8 sb0 = mk_frag(pk[0], pk[1]), sb1 = mk_frag(pk[2], pk[3]);
    f32x4 Sn[4];
#pragma unroll
    for (int blk = 0; blk < 4; ++blk) { f32x4 acc = h4_to_f4(o.hi[blk]);
        acc = __builtin_amdgcn_mfma_f32_16x16x32_f16(mk_frag(o.g[blk][0][0], o.g[blk][0][1]), sb0, acc, 0, 0, 0);
        acc = __builtin_amdgcn_mfma_f32_16x16x32_f16(mk_frag(o.g[blk][1][0], o.g[blk][1][1]), sb1, acc, 0, 0, 0); Sn[blk] = acc; }
#pragma unroll
    for (int blk = 0; blk < 4; ++blk) ST[blk] = Sn[blk];
}
__device__ __forceinline__ void rwkv_seq_unit(Frame& F, int b, int h) {
    if (F.wave >= 4) return;
    unsigned char* ws = F.ws; int lane = F.lane; asm volatile("" : "+v"(lane)); const int w = F.wave;
    const h16* Gm = (const h16*)(ws + WS_R); const h16* Hm = (const h16*)(ws + WS_K); h16* Sc = (h16*)(ws + (b == 0 ? WS_YRW0 : WS_YRW1));
    const size_t tile0 = (size_t)b * T * RD + h * 64, cstep = (size_t)64 * RD; const size_t s0 = (size_t)(16 * w + (lane & 15)) * RD + h * 64;
    f32x4 ST[4] = {};
    SeqOps o0, o1, o2, o3; seq_load(o0, Gm, Hm, tile0, w, lane); seq_load(o1, Gm, Hm, tile0 + cstep, w, lane); seq_load(o2, Gm, Hm, tile0 + 2 * cstep, w, lane);
    for (int c = 0; c < T / 64; c += 4) {
        seq_load(o3, Gm, Hm, tile0 + (size_t)(c + 3) * cstep, w, lane); seq_step(ST, o0, Sc, s0 + (size_t)c * cstep, lane);
        if (c + 4 < T / 64) seq_load(o0, Gm, Hm, tile0 + (size_t)(c + 4) * cstep, w, lane); seq_step(ST, o1, Sc, s0 + (size_t)(c + 1) * cstep, lane);
        if (c + 5 < T / 64) seq_load(o1, Gm, Hm, tile0 + (size_t)(c + 5) * cstep, w, lane); seq_step(ST, o2, Sc, s0 + (size_t)(c + 2) * cstep, lane);
        if (c + 6 < T / 64) seq_load(o2, Gm, Hm, tile0 + (size_t)(c + 6) * cstep, w, lane); seq_step(ST, o3, Sc, s0 + (size_t)(c + 3) * cstep, lane);
    }
}
__device__ __forceinline__ void phase_rwkv_out(Frame& F, int l) {
    unsigned char* ws = F.ws; const Args& A = *F.a; const int lane = F.lane, row = lane & 15, kg = lane >> 4;
    const h16* RBm = (const h16*)(ws + WS_LW); const h16* YBm = (const h16*)(ws + WS_ASIG); const h16* V = (const h16*)(ws + WS_V); const h16* G = (const h16*)(ws + WS_G); const float* BS = (const float*)(ws + WS_BS); h16* YA = (h16*)(ws + WS_YAIN);
    const int gw = F.bid * NWAVES + F.wave, NGW = F.G * NWAVES;
    for (int task = gw; task < BATCH * RH * (T / 64) * 4; task += NGW) {
        const int mb = task & 3, c = (task >> 2) & 127, h = (task >> 9) & 7, b = task >> 12;
        const size_t m0 = (size_t)b * T + (size_t)c * 64; const size_t tile = m0 * RD + h * 64;
        const h16* Sc = (const h16*)(ws + (b == 0 ? WS_YRW0 : WS_YRW1)) + (size_t)c * 64 * RD + h * 64;
        const h16x8 a0 = *(const h16x8*)(RBm + tile + (size_t)(16 * mb + row) * RD + 8 * kg), a1 = *(const h16x8*)(RBm + tile + (size_t)(16 * mb + row) * RD + 32 + 8 * kg);
        f32x4 acc[4]; float sum[4] = {0.f, 0.f, 0.f, 0.f};
#pragma unroll
        for (int nb = 0; nb < 4; ++nb) { const h16x8 b0 = *(const h16x8*)(Sc + (size_t)(16 * nb + row) * RD + 8 * kg), b1 = *(const h16x8*)(Sc + (size_t)(16 * nb + row) * RD + 32 + 8 * kg);
            f32x4 ac = h4_to_f4(*(const u32x2*)(YBm + tile + (size_t)(16 * nb + row) * RD + 16 * mb + 4 * kg));
            ac = __builtin_amdgcn_mfma_f32_16x16x32_f16(a0, b0, ac, 0, 0, 0); ac = __builtin_amdgcn_mfma_f32_16x16x32_f16(a1, b1, ac, 0, 0, 0); acc[nb] = ac;
#pragma unroll
            for (int e = 0; e < 4; ++e) sum[e] += ac[e]; }
        float mean[4], rstd[4];
#pragma unroll
        for (int e = 0; e < 4; ++e) { mean[e] = red16(sum[e]) * (1.f / 64.f); float q = 0.f;
#pragma unroll
            for (int nb = 0; nb < 4; ++nb) { const float d = acc[nb][e] - mean[e]; q += d * d; }
            rstd[e] = 1.0f / sqrtf(red16(q) * (1.f / 64.f) + GN_EPS); }
#pragma unroll
        for (int nb = 0; nb < 4; ++nb) { const int ch = h * 64 + 16 * nb + row; const float gg = A.in[I_GNG][l * RD + ch], gb = A.in[I_GNB][l * RD + ch];
#pragma unroll
            for (int e = 0; e < 4; ++e) { const size_t m = m0 + 16 * mb + 4 * kg + e; const float vv = (float)V[m * RD + ch], gt = (float)G[m * RD + ch], bs = BS[m * 8 + h];
                YA[m * RD + ch] = (h16)(((acc[nb][e] - mean[e]) * rstd[e] * gg + gb + bs * vv) * gt); } }
    }
}

constexpr int AT_KB = 64 * 208, AT_VB = 8192, AT_K0 = 0, AT_V0 = 2 * AT_KB, AT_WS = AT_V0 + 2 * AT_VB, AT_TICKET = AT_WS + 8 * 256;
__device__ __forceinline__ int crow(int r, int hi) { return (r & 3) + 8 * (r >> 2) + 4 * hi; }
typedef short v4i16_t __attribute__((ext_vector_type(4)));
__device__ __forceinline__ h16x4 vtr(const LAS unsigned char* p) { return __builtin_bit_cast(h16x4, __builtin_amdgcn_ds_read_tr16_b64_v4i16((LAS v4i16_t*)p)); }
__device__ __forceinline__ void attn_unit(Frame& F, int b, int h, int qb) {
    unsigned char* ws = F.ws; const int tid = F.tid, lane = F.lane, wid = F.wave, r32 = lane & 31, hi = lane >> 5;
    const h16* Qc = (const h16*)(ws + WS_QC); const h16* Kc = (const h16*)(ws + WS_KC); const h16* Va = (const h16*)(ws + WS_VA); h16* O = (h16*)(ws + WS_OATT);
    LAS unsigned char* lds = F.lds; LAS float* wsf = (LAS float*)(lds + AT_WS + wid * 256);
    const size_t rowbase = (size_t)b * T; const int q0 = qb * 256;
    h16x8 qr[6];
    { const h16* Qw = Qc + (rowbase + q0 + wid * 32 + r32) * 768 + h * 96 + hi * 8;
#pragma unroll
        for (int d0 = 0; d0 < 6; ++d0) qr[d0] = *(const h16x8*)(Qw + d0 * 16); }
    const int kp0 = tid, kp1 = tid + 512; const int kk0 = kp0 / 12, kc0 = kp0 % 12, kk1 = kp1 / 12, kc1 = kp1 % 12; const bool has1 = kp1 < 768;
    const h16* ksrc0 = Kc + (rowbase + kk0) * 768 + h * 96 + 8 * kc0; const h16* ksrc1 = Kc + (rowbase + (has1 ? kk1 : 0)) * 768 + h * 96 + 8 * (has1 ? kc1 : 0);
    const int kdst0 = kk0 * 208 + kc0 * 16, kdst1 = kk1 * 208 + kc1 * 16;
    const int vk = tid >> 3, vc = tid & 7; const h16* vsrc = Va + (rowbase + vk) * 512 + h * 64 + 8 * vc;
    const int vdst = (vc >> 2) * 4096 + (vk >> 4) * 1024 + (vk & 15) * 64 + (vc & 3) * 16;
    const int NT = 4 * (qb + 1), my_last = 4 * qb + (wid >> 1);
    float m_run = -1e30f, l_run = 0.f; f32x16 o0 = {}, o1 = {};
    u32x4 kr0, kr1 = {0u, 0u, 0u, 0u}, vr;
    kr0 = *(const u32x4*)ksrc0; if (has1) kr1 = *(const u32x4*)ksrc1; vr = *(const u32x4*)vsrc;
    *(LAS u32x4*)(lds + AT_K0 + kdst0) = kr0; if (has1) *(LAS u32x4*)(lds + AT_K0 + kdst1) = kr1; *(LAS u32x4*)(lds + AT_V0 + vdst) = vr;
    __syncthreads();
    const int vfo = ((lane >> 4) & 1) * 32 + (lane & 3) * 8 + (4 * hi + ((lane & 15) >> 2)) * 64;
    for (int jt = 0; jt < NT; ++jt) {
        const bool more = jt + 1 < NT;
        if (more) { const size_t adv = (size_t)(jt + 1) * 64; kr0 = *(const u32x4*)(ksrc0 + adv * 768); if (has1) kr1 = *(const u32x4*)(ksrc1 + adv * 768); vr = *(const u32x4*)(vsrc + adv * 512); }
        if (jt <= my_last) {
            const LAS unsigned char* Kb = lds + AT_K0 + (jt & 1) * AT_KB; const LAS unsigned char* Vb = lds + AT_V0 + (jt & 1) * AT_VB;
            f32x16 p0 = {}, p1 = {};
#pragma unroll
            for (int d0 = 0; d0 < 6; ++d0) { const h16x8 k0 = *(const LAS h16x8*)(Kb + r32 * 208 + (2 * d0 + hi) * 16), k1 = *(const LAS h16x8*)(Kb + (32 + r32) * 208 + (2 * d0 + hi) * 16);
                p0 = __builtin_amdgcn_mfma_f32_32x32x16_f16(k0, qr[d0], p0, 0, 0, 0); p1 = __builtin_amdgcn_mfma_f32_32x32x16_f16(k1, qr[d0], p1, 0, 0, 0); }
            if (64 * jt + 63 > q0 + 32 * wid) { const int qpos = q0 + 32 * wid + r32, kb = 64 * jt + 4 * hi;
#pragma unroll
                for (int r = 0; r < 16; ++r) { const int kv = kb + (r & 3) + 8 * (r >> 2); if (kv > qpos) p0[r] = -INFINITY; if (kv + 32 > qpos) p1[r] = -INFINITY; } }
            float rm = fmaxf(p0[0], p1[0]);
#pragma unroll
            for (int r = 1; r < 16; ++r) rm = fmaxf(rm, fmaxf(p0[r], p1[r]));
            rm = fmaxf(rm, __shfl_xor(rm, 32));
            const float m_new = fmaxf(m_run, rm), alpha = __builtin_amdgcn_exp2f(m_run - m_new);
            const bool grow = __any(m_new > m_run);
            m_run = m_new;
            float sum = 0.f;
#pragma unroll
            for (int r = 0; r < 16; ++r) { p0[r] = __builtin_amdgcn_exp2f(p0[r] - m_new); p1[r] = __builtin_amdgcn_exp2f(p1[r] - m_new); sum += p0[r] + p1[r]; }
            l_run = l_run * alpha + sum;
            if (grow) { if (hi == 0) wsf[r32] = alpha; asm volatile("s_waitcnt lgkmcnt(0)" ::: "memory");
#pragma unroll
                for (int r = 0; r < 16; ++r) { const float f = wsf[crow(r, hi)]; o0[r] *= f; o1[r] *= f; } }
            h16x8 pa[4];
#pragma unroll
            for (int j = 0; j < 8; ++j) { pa[0][j] = (h16)p0[j]; pa[1][j] = (h16)p0[8 + j]; pa[2][j] = (h16)p1[j]; pa[3][j] = (h16)p1[8 + j]; }
#pragma unroll
            for (int ks = 0; ks < 4; ++ks) {
                const h16x4 a0 = vtr(Vb + vfo + ks * 1024), a1 = vtr(Vb + vfo + ks * 1024 + 512), c0 = vtr(Vb + vfo + 4096 + ks * 1024), c1 = vtr(Vb + vfo + 4096 + ks * 1024 + 512);
                const h16x8 v0 = {a0[0], a0[1], a0[2], a0[3], a1[0], a1[1], a1[2], a1[3]}, v1 = {c0[0], c0[1], c0[2], c0[3], c1[0], c1[1], c1[2], c1[3]};
                o0 = __builtin_amdgcn_mfma_f32_32x32x16_f16(pa[ks], v0, o0, 0, 0, 0); o1 = __builtin_amdgcn_mfma_f32_32x32x16_f16(pa[ks], v1, o1, 0, 0, 0); }
        }
        if (more) { LAS unsigned char* Kn = lds + AT_K0 + ((jt + 1) & 1) * AT_KB; LAS unsigned char* Vn = lds + AT_V0 + ((jt + 1) & 1) * AT_VB;
            *(LAS u32x4*)(Kn + kdst0) = kr0; if (has1) *(LAS u32x4*)(Kn + kdst1) = kr1; *(LAS u32x4*)(Vn + vdst) = vr; }
        __syncthreads();
    }
    l_run += __shfl_xor(l_run, 32);
    if (hi == 0) wsf[r32] = 1.0f / l_run;
    asm volatile("s_waitcnt lgkmcnt(0)" ::: "memory");
    h16* Ow = O + (rowbase + q0 + wid * 32) * 512 + h * 64 + r32;
#pragma unroll
    for (int r = 0; r < 16; ++r) { const int qr_ = crow(r, hi); const float f = wsf[qr_]; Ow[(size_t)qr_ * 512] = (h16)(o0[r] * f); Ow[(size_t)qr_ * 512 + 32] = (h16)(o1[r] * f); }
    __syncthreads();
}


#ifdef DBG_CHUNK
constexpr int CW_DBG = 2048;
__device__ __forceinline__ void dbg_max(Frame& F, float v) {
    v = fmaxf(v, 0.f);
#pragma unroll
    for (int o = 1; o < 64; o <<= 1) v = fmaxf(v, __shfl_xor(v, o));
    if (F.lane == 0) atomicMax((unsigned*)(F.ws + WS_CTL) + CW_DBG, __float_as_uint(v));
}
__device__ __forceinline__ void dbg_emit(Frame& F) {
    if (F.bid == 0 && F.tid == 0) { const float v = __uint_as_float(((unsigned*)(F.ws + WS_CTL))[CW_DBG]);
        int code = v > 1e-6f ? (int)(4.0f * log2f(v * 1e6f) + 0.5f) : 0; code = code > 89 ? 89 : code; F.a->out[0] = (float)((10 + code) * 1000); }
}
__device__ __forceinline__ void dbg_cmp_y(Frame& F) {
    float md = 0.f;
    for (size_t i = (size_t)F.bid * NTHREADS + F.tid; i < (size_t)M * RD; i += (size_t)F.G * NTHREADS) { const int m = (int)(i >> 9), t = m & (T - 1), c = (int)(i & 511);
        if (t >= DBG_TLO && t < DBG_THI) { const float a = (float)((const h16*)(F.ws + (m < T ? WS_YRW0 : WS_YRW1)))[(size_t)t * RD + c], b = (float)((const h16*)(F.ws + (m < T ? YREF0 : YREF1)))[(size_t)t * RD + c];
            md = fmaxf(md, fabsf(a - b) / (1.0f + fabsf(b))); } }
    dbg_max(F, md);
}
#endif

typedef GAS unsigned gu32;
#define XB_TMO      128
#define XB_XCNT(j)  (256  + 64 * (j))
#define XB_XSUB(j)  (1280 + 64 * (j))
#define XB_XGEN(j)  (2304 + 64 * (j))
#define XB_TOP      3328
#define XB_TOPGEN   3392
#define XCD_BAR_WORDS 3456
#define XB_SPIN_CAP (1u << 22)
__device__ __forceinline__ unsigned xb_ld(unsigned* p)              { return __hip_atomic_load(p, __ATOMIC_RELAXED, __HIP_MEMORY_SCOPE_AGENT); }
__device__ __forceinline__ unsigned xb_add(unsigned* p, unsigned v) { return __hip_atomic_fetch_add(p, v, __ATOMIC_RELAXED, __HIP_MEMORY_SCOPE_AGENT); }
__device__ __forceinline__ unsigned xb_xcc_id() { return (unsigned)__builtin_amdgcn_s_getreg((3 << 11) | 20) & 0xFu; }
#define XB_SPIN(cond, bar) do { unsigned _sp = 0; while (cond) { __builtin_amdgcn_s_sleep(1); \
    if ((++_sp & 255u) == 0u) { if (xb_ld(&(bar)[XB_TMO])) break; if (_sp > XB_SPIN_CAP) { atomicAdd(&(bar)[XB_TMO], 1u); break; } } } } while (0)
struct XcdBarrier { unsigned* bar; unsigned x; volatile LAS unsigned* st; };
__device__ __forceinline__ XcdBarrier xcd_barrier_post(unsigned* bar, volatile LAS unsigned* st) {
    XcdBarrier b; b.bar = bar; b.x = xb_xcc_id(); b.st = st;
    if (threadIdx.x == 0) (void)xb_add(&bar[XB_XCNT(b.x)], 1u);
    return b;
}
__device__ __forceinline__ void xcd_barrier_complete(unsigned* bar, unsigned x, unsigned& nloc, unsigned& nx) {
    const unsigned G = gridDim.x * gridDim.y * gridDim.z;
    unsigned sum, cnt, mine, sp = 0u;
    for (;;) {
        sum = 0u; cnt = 0u; mine = 0u;
#pragma unroll
        for (unsigned j = 0; j < 16; ++j) { const unsigned c = xb_ld(&bar[XB_XCNT(j)]); sum += c; cnt += (c > 0u) ? 1u : 0u; mine = (j == x) ? c : mine; }
        if (sum == G) break;
        __builtin_amdgcn_s_sleep(1);
        if ((++sp & 255u) == 0u) { if (xb_ld(&bar[XB_TMO])) break; if (sp > XB_SPIN_CAP) { atomicAdd(&bar[XB_TMO], 1u); break; } }
    }
    nloc = mine > 0u ? mine : 1u; nx = cnt > 0u ? cnt : 1u;
}
__device__ __forceinline__ void xcd_barrier(const XcdBarrier& b) {
    asm volatile("s_waitcnt vmcnt(0)" ::: "memory");
    __syncthreads();
    if (threadIdx.x == 0) {
        unsigned* bar = b.bar;
        __builtin_amdgcn_s_waitcnt(0);
        unsigned nloc = b.st[0], nx = b.st[1];
        if (nloc == 0u) { xcd_barrier_complete(bar, b.x, nloc, nx); b.st[0] = nloc; b.st[1] = nx; }
        const unsigned old = xb_add(&bar[XB_XSUB(b.x)], 1u);
        const unsigned gen = old / nloc;
        if (old + 1u == (gen + 1u) * nloc) {
            __builtin_amdgcn_fence(__ATOMIC_RELEASE, "agent");
            asm volatile("s_waitcnt vmcnt(0)" ::: "memory");
            const unsigned og = xb_add(&bar[XB_TOP], 1u);
            const unsigned tg = og / nx;
            if (og + 1u == (tg + 1u) * nx) xb_add(&bar[XB_TOPGEN], 1u);
            else XB_SPIN(xb_ld(&bar[XB_TOPGEN]) == tg, bar);
            __builtin_amdgcn_fence(__ATOMIC_ACQUIRE, "agent");
            xb_add(&bar[XB_XGEN(b.x)], 1u);
            asm volatile("s_waitcnt vmcnt(0)" ::: "memory");
        } else {
            XB_SPIN(xb_ld(&bar[XB_XGEN(b.x)]) == gen, bar);
            __builtin_amdgcn_fence(__ATOMIC_ACQUIRE, "agent");
            asm volatile("s_waitcnt vmcnt(0)" ::: "memory");
        }
    }
    __syncthreads();
}

constexpr int NPH = 1 + 13 * DEPTH;
__device__ __forceinline__ void run_phase(Frame& F, int ph) {
    { int w_ = F.wave, b_ = F.bid; asm volatile("" : "+v"(F.tid), "+v"(F.lane), "+v"(w_), "+v"(b_)); F.wave = __builtin_amdgcn_readfirstlane(w_); F.bid = __builtin_amdgcn_readfirstlane(b_); }
    unsigned char* ws = F.ws; const Args& A = *F.a; LAS unsigned char* lds = F.lds;
    if (ph == 0) { phase_convert(F, 0); rows_to_h16(F, A.in[I_X], (h16*)(ws + WS_XH)); rope_table(F); return; }
    const int l = (ph - 1) / 13, k = (ph - 1) % 13 + 1;
    const float* xres = (l == 0) ? A.in[I_X] : A.out;
    switch (k) {
    case 1: { pg8::Gemm g{(const h16*)(ws + WS_XH), (const h16*)(ws + WS_WIN), 1024, 1024, 1024}; pg8::StaticOrder S; S.init(M, 2816, F.G, F.bid);
        EpiStoreSplit E{(h16*)(ws + WS_PRWKV), (h16*)(ws + WS_PMLA), (h16*)(ws + WS_U)}; pg8::gemm_phase(lds, g, S, E);
        } break;
    case 2: phase_prep(F, l); phase_s5<1>(F, l); break;
    case 3: {
        { pg8::Gemm g{(const h16*)(ws + WS_ALORA), (const h16*)(ws + WS_WLORA), 256, 256, 256}; pg8::StaticOrder S; S.init(M, 1536, F.G, F.bid);
          EpiLora E{(h16*)(ws + WS_LW), A.in[I_W0] + l * RD, A.in[I_A0] + l * RD}; pg8::gemm_phase(lds, g, S, E); }
        { pg8::Gemm g{(const h16*)(ws + WS_PMLA), (const h16*)(ws + WS_WQ), 512, 256, 256}; pg8::StaticOrder S; S.init(M, 768, F.G, F.bid);
          EpiQ E{(h16*)(ws + WS_QC), (const float*)(ws + WS_RSTDQ), (const float*)(ws + WS_COS), (const float*)(ws + WS_SIN)}; pg8::gemm_phase(lds, g, S, E); }
        { pg8::Gemm g{(const h16*)(ws + WS_PMLA) + 256, (const h16*)(ws + WS_WKV), 512, 128, 128}; pg8::StaticOrder S; S.init(M, 1024, F.G, F.bid);
          EpiKV E{(h16*)(ws + WS_KC), (h16*)(ws + WS_VA), (const float*)(ws + WS_RSTDKV)}; pg8::gemm_phase(lds, g, S, E); }
    } break;
    case 4: phase_s5<2>(F, l); phase_rwkv_chunks(F, l); break;
    case 5: {
        for (int rw = F.bid; rw < 16; rw += F.G) rwkv_seq_unit(F, rw >> 3, rw & 7);
#ifdef DBG_CHUNK
        __syncthreads();
        if (F.bid >= 16) for (int rw = F.bid - 16; rw < 64; rw += F.G) rwkv_scan_unit(F, l, rw >> 5, (rw >> 2) & 7, rw & 3);
        break;
#endif
        unsigned* qh = (unsigned*)(ws + WS_CTL) + CW_QUEUE * (1 + l); LAS unsigned* tk = (LAS unsigned*)(lds + AT_TICKET);
        for (;;) {
            if (F.tid == 0) tk[0] = __hip_atomic_fetch_add(qh, 1u, __ATOMIC_RELAXED, __HIP_MEMORY_SCOPE_AGENT);
            __syncthreads(); const unsigned u = tk[0]; __syncthreads();
            if (u >= 512u) break;
            attn_unit(F, (int)(u & 15u) >> 3, (int)(u & 7u), 31 - (int)(u >> 4));
        }
    } break;
#ifdef DBG_CHUNK
    case 6: if (l == 0) dbg_cmp_y(F); phase_rwkv_post(F, l, xres); break;
#else
    case 6: phase_rwkv_out(F, l); rows_to_h16(F, xres, (h16*)(ws + WS_XH2)); break;
#endif
    case 7: { pg8::Gemm g{(const h16*)(ws + WS_XH2), (const h16*)(ws + WS_WG), 1024, 1024, 1024}; pg8::StaticOrder S; S.init(M, 3072, F.G, F.bid);
        EpiGate E{(h16*)(ws + WS_GATES), A.in[I_GATEB] + l * 3072}; pg8::gemm_phase(lds, g, S, E);
        } break;
    case 8: { pg8::StaticOrder S; S.init(M, 1024, F.G, F.bid); h16* mg = (h16*)(ws + WS_MERGED); const h16* gt = (const h16*)(ws + WS_GATES);
        for (int i = 0;; ++i) { Unit u; if (!S.next(i, u)) break;
            pg8::ListOrder L1{u, u, 1}; pg8::ListOrder L2{Unit{u.pm, 2 * u.pn}, Unit{u.pm, 2 * u.pn + 1}, 2};
            { pg8::Gemm g{(const h16*)(ws + WS_YAIN), (const h16*)(ws + WS_WRO), 512, 512, 512}; EpiBranch<0> E{mg, gt}; pg8::gemm_phase(lds, g, L1, E); }
            { pg8::Gemm g{(const h16*)(ws + WS_OATT), (const h16*)(ws + WS_WMO), 512, 512, 512}; EpiBranch<1> E{mg, gt}; pg8::gemm_phase(lds, g, L1, E); }
            { pg8::Gemm g{(const h16*)(ws + WS_YS5), (const h16*)(ws + WS_WGLU), 512, 512, 512}; EpiBranch<2> E{mg, gt}; pg8::gemm_phase(lds, g, L2, E); } }
    } break;
    case 9: { pg8::Gemm g{(const h16*)(ws + WS_MERGED), (const h16*)(ws + WS_WO), 1024, 1024, 1024}; pg8::StaticOrder S; S.init(M, 1024, F.G, F.bid);
        EpiPre E{xres, (float*)(ws + WS_PRE)}; pg8::gemm_phase(lds, g, S, E); } break;
    case 10: phase_ln(F, (const float*)(ws + WS_PRE), A.in[I_LN1G] + l * D, A.in[I_LN1B] + l * D, A.out, (h16*)(ws + WS_X1H)); break;
    case 11: { pg8::Gemm g{(const h16*)(ws + WS_X1H), (const h16*)(ws + WS_W13), 1024, 1024, 1024}; pg8::StaticOrder S; S.init(M, 5632, F.G, F.bid);
        EpiSwiGLU E{(h16*)(ws + WS_HB)}; pg8::gemm_phase(lds, g, S, E); } break;
    case 12: { pg8::Gemm g{(const h16*)(ws + WS_HB), (const h16*)(ws + WS_W2), DFF, DFF, DFF}; pg8::StaticOrder S; S.init(M, 1024, F.G, F.bid);
        EpiPre E{A.out, (float*)(ws + WS_PRE2)}; pg8::gemm_phase(lds, g, S, E); } break;
    case 13: phase_ln(F, (const float*)(ws + WS_PRE2), A.in[I_LN2G] + l * D, A.in[I_LN2B] + l * D, A.out, (h16*)(ws + WS_XH)); if (l + 1 < DEPTH) phase_convert(F, l + 1); break;
#ifdef DBG_CHUNK
    case 14: break;
#endif
    }
}
__global__ void __launch_bounds__(NTHREADS, 2) fwd(Args args) {
    extern __shared__ __attribute__((aligned(16))) unsigned char lds_raw[];
    Frame F; F.lds = (LAS unsigned char*)lds_raw; F.tid = threadIdx.x; F.lane = F.tid & 63; F.wave = __builtin_amdgcn_readfirstlane(F.tid >> 6);
    F.G = gridDim.x; F.bid = blockIdx.x; F.ws = args.ws; F.a = &args;
    volatile LAS unsigned* MISC = (volatile LAS unsigned*)(F.lds + MISC_OFF);
    if (F.tid < 32) MISC[F.tid] = 0u;
    __syncthreads();
    XcdBarrier bar; bar.bar = (unsigned*)(args.ws + WS_CTL) + CW_BAR; bar.x = 0; bar.st = nullptr;
    if (args.one_launch) bar = xcd_barrier_post((unsigned*)(args.ws + WS_CTL) + CW_BAR, MISC + 8);
    for (int ph = args.ph_lo; ph < args.ph_hi; ++ph) {
        run_phase(F, ph);
        if (ph + 1 < args.ph_hi) xcd_barrier(bar);
    }
#ifdef DBG_CHUNK
    xcd_barrier(bar); dbg_emit(F);
#endif
}

#ifndef MK_ONE_LAUNCH
#define MK_ONE_LAUNCH 1
#endif
extern "C" void kernel_launch(void* const* d_in, const int* in_sizes, int n_in, void* d_out, int out_size, void* d_ws, size_t ws_size, hipStream_t stream) {
    static int grid = 0;
    if (grid == 0) {
        if (n_in != 37 || out_size != M * D || ws_size < WS_END) { fprintf(stderr, "kernel_launch: unexpected shapes n_in %d out %d ws %zu\n", n_in, out_size, ws_size); grid = -1; return; }
        int dev = 0, cus = 0, per_cu = 0;
        if (hipGetDevice(&dev) != hipSuccess || hipDeviceGetAttribute(&cus, hipDeviceAttributeMultiprocessorCount, dev) != hipSuccess) { grid = -1; return; }
        if (hipFuncSetAttribute((const void*)fwd, hipFuncAttributeMaxDynamicSharedMemorySize, LDS_BYTES) != hipSuccess) { fprintf(stderr, "kernel_launch: hipFuncSetAttribute failed\n"); grid = -1; return; }
        if (hipOccupancyMaxActiveBlocksPerMultiprocessor(&per_cu, (const void*)fwd, NTHREADS, LDS_BYTES) != hipSuccess || per_cu < 1) { fprintf(stderr, "kernel_launch: occupancy query says %d\n", per_cu); (void)hipGetLastError(); grid = -1; return; }
        grid = cus;
    }
    if (grid < 0) return;
    (void)hipMemsetAsync((char*)d_ws + WS_CTL, 0, CTL_ZERO_BYTES, stream);
    Args a{};
    for (int i = 0; i < 37; ++i) a.in[i] = (const float*)d_in[i];
    a.out = (float*)d_out; a.ws = (unsigned char*)d_ws;
    for (int i = 0; i < 16; ++i) a.invfreq[i] = (float)pow(10000.0, -(double)i / 16.0);
    a.one_launch = MK_ONE_LAUNCH;
    if (MK_ONE_LAUNCH) { a.ph_lo = 0; a.ph_hi = NPH; hipLaunchKernelGGL(fwd, dim3(grid), dim3(NTHREADS), LDS_BYTES, stream, a); }
    else for (int ph = 0; ph < NPH; ++ph) { a.ph_lo = ph; a.ph_hi = ph + 1; hipLaunchKernelGGL(fwd, dim3(grid), dim3(NTHREADS), LDS_BYTES, stream, a);
    }
}
```

```cpp
#include <hip/hip_runtime.h>
#include <cstdio>
#include <cstdint>


#define LAS __attribute__((address_space(3)))
#define GAS __attribute__((address_space(1)))
typedef _Float16 h16;
typedef _Float16 h16x2 __attribute__((ext_vector_type(2)));
typedef _Float16 h16x4 __attribute__((ext_vector_type(4)));
typedef _Float16 h16x8 __attribute__((ext_vector_type(8)));
typedef float f32x2 __attribute__((ext_vector_type(2)));
typedef float f32x4 __attribute__((ext_vector_type(4)));
typedef float f32x16 __attribute__((ext_vector_type(16)));
typedef unsigned u32x2 __attribute__((ext_vector_type(2)));
typedef unsigned u32x4 __attribute__((ext_vector_type(4)));
typedef short s16x4 __attribute__((ext_vector_type(4)));

constexpr int BATCH = 2, T = 8192, D = 1024, M = BATCH * T, DEPTH = 2;
constexpr int RH = 8, RN = 64, RD = 512;
constexpr int RWKV_COLS = 1792, MLA_COLS = 416, IN_COLS = 5792, DFF = 2816;
constexpr int O_MLA = 1792, O_S5 = 2208, O_GATE = 2720;
constexpr float ALPHA = 1.4142135623730951f;
constexpr float LN_EPS = 1e-5f, RMS_EPS = 1e-6f, GN_EPS = 64e-5f;
constexpr float QSCALE = 0.10206207261596577f * 1.4426950408889634f;

__device__ __forceinline__ unsigned pkh(float lo, float hi) { h16x2 v = {(h16)lo, (h16)hi}; return __builtin_bit_cast(unsigned, v); }
__device__ __forceinline__ float sigm(float x) { return __builtin_amdgcn_rcpf(1.0f + __expf(-x)); }

namespace pg8 {
constexpr int BM = 256, BK = 64, HALF = 128, HTB = HALF * BK * 2, STAGE_BYTES = 8 * HTB, NXCD = 8, WGM = 8;
__host__ __device__ __forceinline__ int lds_byte(int r, int c) { const int st = (r >> 4) * 2 + (c >> 5), rr = r & 15, cc = c & 31, ob = rr * 64 + cc * 2; return st * 1024 + (ob ^ (((ob >> 9) & 1) << 5)); }
__host__ __device__ __forceinline__ void stage_rc(int b, int& R, int& C) { const int st = b / 1024, sb = b % 1024, swz = sb ^ (((sb >> 9) & 1) << 5); R = (st >> 1) * 16 + swz / 64; C = (st & 1) * 32 + (swz % 64) / 2; }
__host__ __device__ __forceinline__ int perm32(int rho) { const int n = rho >> 4, i = rho & 15; return 8 * (i >> 2) + 4 * n + (i & 3); }

struct Unit { int pm, pn; };
struct Gemm { const h16* A; const h16* Bt; int lda, ldb, K; };

struct StaticOrder {
    int nM, nN, nwg, G, c;
    __device__ __forceinline__ void init(int Mr, int N, int G_, int c_) { nM = Mr / BM; nN = N / BM; nwg = nM * nN; G = G_; c = c_; }
    __device__ __forceinline__ bool next(int i, Unit& u) const {
        const long L = (long)i * G + c; if (L >= nwg) return false;
        int wgid = (int)L; { const int q = nwg / NXCD, r = nwg % NXCD, xcd = wgid % NXCD, off = wgid / NXCD; wgid = (xcd < r ? xcd * (q + 1) : r * (q + 1) + (xcd - r) * q) + off; }
        const int nig = WGM * nN, gid = wgid / nig, fm = gid * WGM, gsz = (nM - fm) < WGM ? (nM - fm) : WGM;
        u.pm = fm + ((wgid % nig) % gsz); u.pn = (wgid % nig) / gsz; return true;
    }
};
struct ListOrder {
    Unit u0, u1; int n;
    __device__ __forceinline__ bool next(int i, Unit& u) const { if (i >= n) return false; u = (i == 0) ? u0 : u1; return true; }
};

template <class Epi, class Sched>
__device__ __forceinline__ void gemm_phase(LAS unsigned char* lds, const Gemm g, const Sched& S, const Epi& E) {
    int tid = threadIdx.x; asm volatile("" : "+v"(tid));
    const int wid = __builtin_amdgcn_readfirstlane(tid >> 6), lane = tid & 63, wr = wid >> 2, wc = wid & 3, fr = lane & 15, fq = lane >> 4;
    int K = g.K; asm volatile("" : "+s"(K)); const int nt = K / BK;
    unsigned voffA[2], voffB[2];
#pragma unroll
    for (int i = 0; i < 2; ++i) { int R, C; stage_rc(tid * 16 + i * 8192, R, C); const int Rb = Epi::PERM ? ((R & ~31) + perm32(R & 31)) : R;
        voffA[i] = (unsigned)(R * g.lda + C) * 2u; voffB[i] = (unsigned)(Rb * g.ldb + C) * 2u; }
    const size_t kstep = (size_t)(BK * 2);
    const size_t hstepA = (size_t)HALF * g.lda * 2, hstepB = (size_t)HALF * g.ldb * 2;
    const size_t tstepA = 2 * hstepA, tstepB = 2 * hstepB;
    const unsigned ldsw = (unsigned)wid * 1024u;
    const int aoff = lds_byte(wr * 64 + fr, fq * 8), boff = lds_byte(wc * 32 + fr, fq * 8);
#define PG8_SA(b, h) (((b) * 2 + (h)) * HTB)
#define PG8_SB(b, h) ((4 + (b) * 2 + (h)) * HTB)
#define PG8_STAGE(bufoff, gbase, voff) do { _Pragma("unroll") for (int _i = 0; _i < 2; ++_i) \
        __builtin_amdgcn_global_load_lds((const unsigned*)((const char*)(gbase) + (voff)[_i]), (LAS unsigned*)(lds + (bufoff) + ldsw + _i * 8192), 16, 0, 0); } while (0)
#define PG8_LDA(dst, b, h) do { _Pragma("unroll") for (int m = 0; m < 4; ++m) _Pragma("unroll") for (int k = 0; k < 2; ++k) dst[m][k] = *(const LAS h16x8*)(lds + PG8_SA(b, h) + aoff + m * 2048 + k * 1024); } while (0)
#define PG8_LDB(dst, b, h) do { _Pragma("unroll") for (int n = 0; n < 2; ++n) _Pragma("unroll") for (int k = 0; k < 2; ++k) dst[n][k] = *(const LAS h16x8*)(lds + PG8_SB(b, h) + boff + n * 2048 + k * 1024); } while (0)
#define PG8_MMA(ai, bj, At, Bt) do { __builtin_amdgcn_s_setprio(1); _Pragma("unroll") for (int m = 0; m < 4; ++m) _Pragma("unroll") for (int n = 0; n < 2; ++n) _Pragma("unroll") for (int k = 0; k < 2; ++k) \
        acc[ai][bj][m][n] = __builtin_amdgcn_mfma_f32_16x16x32_f16(Bt[n][k], At[m][k], acc[ai][bj][m][n], 0, 0, 0); __builtin_amdgcn_s_setprio(0); } while (0)
#define PG8_WAIT_V(n) asm volatile("s_waitcnt vmcnt(" #n ")" ::: "memory")
#define PG8_WAIT_L(n) asm volatile("s_waitcnt lgkmcnt(" #n ")" ::: "memory")
#define PG8_BAR __builtin_amdgcn_s_barrier()
#define PG8_SCHED __builtin_amdgcn_sched_barrier(0)
    Unit cur, nxt; int ui = 0;
    if (!S.next(0, cur)) return;
    f32x4 acc[2][2][4][2];
#pragma unroll
    for (int a = 0; a < 2; ++a)
#pragma unroll
        for (int b = 0; b < 2; ++b)
#pragma unroll
            for (int m = 0; m < 4; ++m)
#pragma unroll
                for (int n = 0; n < 2; ++n) acc[a][b][m][n] = (f32x4){0.f, 0.f, 0.f, 0.f};
    h16x8 At[4][2], B0[2][2], B1[2][2];
    const char* cA = (const char*)g.A + (size_t)cur.pm * tstepA; const char* cB = (const char*)g.Bt + (size_t)cur.pn * tstepB;
    {
        PG8_STAGE(PG8_SB(0, 0), cB, voffB); PG8_STAGE(PG8_SB(0, 1), cB + hstepB, voffB); PG8_STAGE(PG8_SA(0, 0), cA, voffA); PG8_STAGE(PG8_SA(0, 1), cA + hstepA, voffA);
        if (wr == 1) PG8_BAR;
        PG8_WAIT_V(2); PG8_BAR;
        PG8_STAGE(PG8_SB(1, 0), cB + kstep, voffB); PG8_STAGE(PG8_SA(1, 0), cA + kstep, voffA); PG8_STAGE(PG8_SB(1, 1), cB + hstepB + kstep, voffB);
        PG8_WAIT_V(6); PG8_BAR;
    }
    for (;;) {
        const bool has_next = S.next(ui + 1, nxt);
        const char* nA = has_next ? (const char*)g.A + (size_t)nxt.pm * tstepA : cA; const char* nB = has_next ? (const char*)g.Bt + (size_t)nxt.pn * tstepB : cB;
        for (int t = 0; t < nt; t += 2) {
            const bool last = (t == nt - 2);
            const char* a1 = cA + (size_t)(t + 1) * kstep;
            const char* a2 = last ? nA : cA + (size_t)(t + 2) * kstep; const char* b2 = last ? nB : cB + (size_t)(t + 2) * kstep;
            const char* a3 = a2 + kstep; const char* b3 = b2 + kstep;
            PG8_LDB(B0, 0, 0); PG8_LDB(B1, 0, 1); PG8_SCHED; PG8_LDA(At, 0, 0); PG8_STAGE(PG8_SA(1, 1), a1 + hstepA, voffA);
            PG8_WAIT_V(8); PG8_WAIT_L(0); PG8_BAR; PG8_MMA(0, 0, At, B0); PG8_MMA(0, 1, At, B1); PG8_BAR; PG8_SCHED;
            PG8_LDA(At, 0, 1); PG8_STAGE(PG8_SB(0, 0), b2, voffB); PG8_STAGE(PG8_SB(0, 1), b2 + hstepB, voffB); PG8_STAGE(PG8_SA(0, 0), a2, voffA);
            PG8_WAIT_V(8); PG8_WAIT_L(0); PG8_BAR; PG8_MMA(1, 0, At, B0); PG8_MMA(1, 1, At, B1); PG8_BAR; PG8_SCHED;
            PG8_LDB(B0, 1, 0); PG8_LDB(B1, 1, 1); PG8_SCHED; PG8_LDA(At, 1, 0); PG8_STAGE(PG8_SA(0, 1), a2 + hstepA, voffA);
            PG8_WAIT_V(8); PG8_WAIT_L(0); PG8_BAR; PG8_MMA(0, 0, At, B0); PG8_MMA(0, 1, At, B1); PG8_BAR; PG8_SCHED;
            PG8_LDA(At, 1, 1); PG8_STAGE(PG8_SB(1, 0), b3, voffB); PG8_STAGE(PG8_SB(1, 1), b3 + hstepB, voffB); PG8_STAGE(PG8_SA(1, 0), a3, voffA);
            PG8_WAIT_V(8); PG8_WAIT_L(0); PG8_BAR; PG8_MMA(1, 0, At, B0); PG8_MMA(1, 1, At, B1); PG8_BAR; PG8_SCHED;
        }
        if (wr == 0) PG8_BAR;
        { int fr_ = fr, fq_ = fq; asm volatile("" : "+v"(fr_), "+v"(fq_)); E(acc, cur, wr, wc, fr_, fq_); }
        if (!has_next) break;
#pragma unroll
        for (int a = 0; a < 2; ++a)
#pragma unroll
            for (int b = 0; b < 2; ++b)
#pragma unroll
                for (int m = 0; m < 4; ++m)
#pragma unroll
                    for (int n = 0; n < 2; ++n) acc[a][b][m][n] = (f32x4){0.f, 0.f, 0.f, 0.f};
        cur = nxt; cA = nA; cB = nB; ++ui;
        if (wr == 1) PG8_BAR;
    }
    PG8_WAIT_V(0);
    PG8_BAR;
#undef PG8_SA
#undef PG8_SB
#undef PG8_STAGE
#undef PG8_LDA
#undef PG8_LDB
#undef PG8_MMA
#undef PG8_WAIT_V
#undef PG8_WAIT_L
#undef PG8_BAR
#undef PG8_SCHED
}
}

using pg8::Unit; using pg8::HALF; using pg8::BM;
struct EpiStoreSplit {
    static constexpr bool PERM = true;
    h16* p_rwkv; h16* p_mla; h16* u;
    __device__ __forceinline__ void operator()(const f32x4 (&acc)[2][2][4][2], const Unit& un, int wr, int wc, int fr, int fq) const {
        h16* base; int ldc, colt;
        if (un.pn < 7) { base = p_rwkv; ldc = RWKV_COLS; colt = un.pn * BM; } else if (un.pn < 9) { base = p_mla; ldc = 512; colt = (un.pn - 7) * BM; } else { base = u; ldc = 512; colt = (un.pn - 9) * BM; }
        const int row0 = un.pm * BM + wr * 64 + fr, col0 = colt + wc * 32 + 8 * fq;
#pragma unroll
        for (int ai = 0; ai < 2; ++ai)
#pragma unroll
            for (int m = 0; m < 4; ++m) { h16* rowp = base + (size_t)(row0 + ai * HALF + m * 16) * ldc + col0;
#pragma unroll
                for (int bj = 0; bj < 2; ++bj) { const f32x4 v0 = acc[ai][bj][m][0], v1 = acc[ai][bj][m][1];
                    u32x4 w; w.x = pkh(v0[0], v0[1]); w.y = pkh(v0[2], v0[3]); w.z = pkh(v1[0], v1[1]); w.w = pkh(v1[2], v1[3]);
                    *(u32x4*)(rowp + bj * HALF) = w; } }
    }
};
struct EpiLora {
    static constexpr bool PERM = true;
    h16* lw; const float* w0; const float* a0;
    __device__ __forceinline__ void operator()(const f32x4 (&acc)[2][2][4][2], const Unit& un, int wr, int wc, int fr, int fq) const {
        const int kind = un.pn >> 1; h16* base = lw + (size_t)kind * (size_t)(8u << 20); const float* bias = kind == 0 ? w0 : a0;
        const int colt = (un.pn & 1) * BM; const int row0 = un.pm * BM + wr * 64 + fr, col0 = colt + wc * 32 + 8 * fq;
        f32x4 bv[2][2];
#pragma unroll
        for (int bj = 0; bj < 2; ++bj)
#pragma unroll
            for (int n = 0; n < 2; ++n) bv[bj][n] = kind < 2 ? *(const f32x4*)(bias + col0 + bj * HALF + 4 * n) : (f32x4){0.f, 0.f, 0.f, 0.f};
#pragma unroll
        for (int ai = 0; ai < 2; ++ai)
#pragma unroll
            for (int m = 0; m < 4; ++m) { h16* rowp = base + (size_t)(row0 + ai * HALF + m * 16) * RD + col0;
#pragma unroll
                for (int bj = 0; bj < 2; ++bj) { f32x4 v0 = acc[ai][bj][m][0] + bv[bj][0], v1 = acc[ai][bj][m][1] + bv[bj][1];
                    if (kind < 2) { const float sc = kind == 0 ? -0.6065306597126334f : 1.0f;
#pragma unroll
                        for (int e = 0; e < 4; ++e) { v0[e] = sc * sigm(v0[e]); v1[e] = sc * sigm(v1[e]); } }
                    u32x4 w; w.x = pkh(v0[0], v0[1]); w.y = pkh(v0[2], v0[3]); w.z = pkh(v1[0], v1[1]); w.w = pkh(v1[2], v1[3]);
                    *(u32x4*)(rowp + bj * HALF) = w; } }
    }
};
struct EpiQ {
    static constexpr bool PERM = false;
    h16* Qc; const float* rstd; const float* cosT; const float* sinT;
    __device__ __forceinline__ void operator()(const f32x4 (&acc)[2][2][4][2], const Unit& un, int wr, int wc, int fr, int fq) const {
        const int row0 = un.pm * BM + wr * 64 + fr;
#pragma unroll
        for (int ai = 0; ai < 2; ++ai)
#pragma unroll
            for (int m = 0; m < 4; ++m) { const int row = row0 + ai * HALF + m * 16; const float rs = rstd[row] * QSCALE; const int pos = row & (T - 1);
                const f32x4 cs = *(const f32x4*)(cosT + pos * 16 + 4 * fq), sn = *(const f32x4*)(sinT + pos * 16 + 4 * fq);
#pragma unroll
                for (int bj = 0; bj < 2; ++bj) { const int cb = un.pn * 8 + bj * 4 + wc;
                    f32x4 v0 = acc[ai][bj][m][0] * rs, v1 = acc[ai][bj][m][1] * rs;
                    if (cb % 3 == 2) { const f32x4 a = v0, b = v1; v0 = a * cs - b * sn; v1 = b * cs + a * sn; }
                    h16* p = Qc + (size_t)row * 768 + cb * 32 + 4 * fq;
                    u32x2 w0; w0.x = pkh(v0[0], v0[1]); w0.y = pkh(v0[2], v0[3]); *(u32x2*)p = w0;
                    u32x2 w1; w1.x = pkh(v1[0], v1[1]); w1.y = pkh(v1[2], v1[3]); *(u32x2*)(p + 16) = w1; } }
    }
};
struct EpiKV {
    static constexpr bool PERM = true;
    h16* Kc; h16* Va; const float* rstd;
    __device__ __forceinline__ void operator()(const f32x4 (&acc)[2][2][4][2], const Unit& un, int wr, int wc, int fr, int fq) const {
        const int row0 = un.pm * BM + wr * 64 + fr;
#pragma unroll
        for (int ai = 0; ai < 2; ++ai)
#pragma unroll
            for (int m = 0; m < 4; ++m) { const int row = row0 + ai * HALF + m * 16; const float rs = rstd[row];
#pragma unroll
                for (int bj = 0; bj < 2; ++bj) { const int c = un.pn * BM + bj * HALF + wc * 32 + 8 * fq, h = c >> 7, w = c & 127;
                    const f32x4 v0 = acc[ai][bj][m][0] * rs, v1 = acc[ai][bj][m][1] * rs;
                    u32x4 o; o.x = pkh(v0[0], v0[1]); o.y = pkh(v0[2], v0[3]); o.z = pkh(v1[0], v1[1]); o.w = pkh(v1[2], v1[3]);
                    h16* p = (w < 64) ? Kc + (size_t)row * 768 + h * 96 + w : Va + (size_t)row * 512 + h * 64 + (w - 64);
                    *(u32x4*)p = o; } }
    }
};
struct EpiGate {
    static constexpr bool PERM = true;
    h16* g0; const float* gb;
    __device__ __forceinline__ void operator()(const f32x4 (&acc)[2][2][4][2], const Unit& un, int wr, int wc, int fr, int fq) const {
        const int row0 = un.pm * BM + wr * 64 + fr, col0 = un.pn * BM + wc * 32 + 8 * fq; const int br = un.pn >> 2; h16* gbase = g0 + (size_t)(4 * br + 8 * (br >> 1)) * (size_t)(4u << 20);
        f32x4 bv[2][2];
#pragma unroll
        for (int bj = 0; bj < 2; ++bj)
#pragma unroll
            for (int n = 0; n < 2; ++n) bv[bj][n] = *(const f32x4*)(gb + col0 + bj * HALF + 4 * n);
#pragma unroll
        for (int ai = 0; ai < 2; ++ai)
#pragma unroll
            for (int m = 0; m < 4; ++m) { h16* rowp = gbase + (size_t)(row0 + ai * HALF + m * 16) * 1024 + (col0 & 1023);
#pragma unroll
                for (int bj = 0; bj < 2; ++bj) { f32x4 v0 = acc[ai][bj][m][0] + bv[bj][0], v1 = acc[ai][bj][m][1] + bv[bj][1];
#pragma unroll
                    for (int e = 0; e < 4; ++e) { v0[e] = sigm(v0[e]); v1[e] = sigm(v1[e]); }
                    u32x4 w; w.x = pkh(v0[0], v0[1]); w.y = pkh(v0[2], v0[3]); w.z = pkh(v1[0], v1[1]); w.w = pkh(v1[2], v1[3]);
                    *(u32x4*)(rowp + bj * HALF) = w; } }
    }
};
__device__ __forceinline__ void unpk8(const u32x4 w, float (&o)[8]) {
    const unsigned a0 = w.x, a1 = w.y, a2 = w.z, a3 = w.w;
    const h16x2 h0 = __builtin_bit_cast(h16x2, a0), h1 = __builtin_bit_cast(h16x2, a1), h2 = __builtin_bit_cast(h16x2, a2), h3 = __builtin_bit_cast(h16x2, a3);
    o[0] = (float)h0[0]; o[1] = (float)h0[1]; o[2] = (float)h1[0]; o[3] = (float)h1[1]; o[4] = (float)h2[0]; o[5] = (float)h2[1]; o[6] = (float)h3[0]; o[7] = (float)h3[1];
}
__device__ __forceinline__ f32x4 h4_to_f4(u32x2 q) { const unsigned q0 = q.x, q1 = q.y; const h16x2 a = __builtin_bit_cast(h16x2, q0), b = __builtin_bit_cast(h16x2, q1); return (f32x4){(float)a[0], (float)a[1], (float)b[0], (float)b[1]}; }
template <int KIND> struct EpiBranch {
    static constexpr bool PERM = true;
    h16* merged; const h16* gates;
    __device__ __forceinline__ void operator()(const f32x4 (&acc)[2][2][4][2], const Unit& un, int wr, int wc, int fr, int fq) const {
        const int row0 = un.pm * BM + wr * 64 + fr;
#pragma unroll
        for (int ai = 0; ai < 2; ++ai)
#pragma unroll
            for (int m = 0; m < 4; ++m) { const int row = row0 + ai * HALF + m * 16;
#pragma unroll
                for (int bj = 0; bj < (KIND == 2 ? 1 : 2); ++bj) {
                    const int col = (KIND == 2 ? un.pn * HALF : un.pn * BM + bj * HALF) + wc * 32 + 8 * fq;
                    float v[8];
                    if (KIND == 2) { const f32x4 a0 = acc[ai][0][m][0], a1 = acc[ai][0][m][1], b0 = acc[ai][1][m][0], b1 = acc[ai][1][m][1];
#pragma unroll
                        for (int e = 0; e < 4; ++e) { v[e] = a0[e] * sigm(b0[e]); v[4 + e] = a1[e] * sigm(b1[e]); } }
                    else { const f32x4 a0 = acc[ai][bj][m][0], a1 = acc[ai][bj][m][1];
#pragma unroll
                        for (int e = 0; e < 4; ++e) { v[e] = a0[e]; v[4 + e] = a1[e]; } }
                    float gt[8]; unpk8(*(const u32x4*)(gates + (size_t)row * 1024 + col), gt);
                    h16* mp = merged + (size_t)row * 1024 + col;
                    if (KIND != 0) { float old[8]; unpk8(*(const u32x4*)mp, old);
#pragma unroll
                        for (int e = 0; e < 8; ++e) v[e] = old[e] + gt[e] * v[e]; }
                    else {
#pragma unroll
                        for (int e = 0; e < 8; ++e) v[e] = gt[e] * v[e]; }
                    u32x4 w; w.x = pkh(v[0], v[1]); w.y = pkh(v[2], v[3]); w.z = pkh(v[4], v[5]); w.w = pkh(v[6], v[7]);
                    *(u32x4*)mp = w; } }
    }
};
struct EpiPre {
    static constexpr bool PERM = false;
    const float* xres; float* pre;
    __device__ __forceinline__ void operator()(const f32x4 (&acc)[2][2][4][2], const Unit& un, int wr, int wc, int fr, int fq) const {
        const int row0 = un.pm * BM + wr * 64 + fr, col0 = un.pn * BM + wc * 32 + 4 * fq;
#pragma unroll
        for (int ai = 0; ai < 2; ++ai)
#pragma unroll
            for (int m = 0; m < 4; ++m) { const size_t off = (size_t)(row0 + ai * HALF + m * 16) * D + col0;
#pragma unroll
                for (int bj = 0; bj < 2; ++bj)
#pragma unroll
                    for (int n = 0; n < 2; ++n) { const f32x4 xr = *(const f32x4*)(xres + off + bj * HALF + n * 16);
                        *(f32x4*)(pre + off + bj * HALF + n * 16) = xr * ALPHA + acc[ai][bj][m][n]; } }
    }
};
struct EpiSwiGLU {
    static constexpr bool PERM = true;
    h16* hb;
    __device__ __forceinline__ void operator()(const f32x4 (&acc)[2][2][4][2], const Unit& un, int wr, int wc, int fr, int fq) const {
        const int row0 = un.pm * BM + wr * 64 + fr, col0 = un.pn * HALF + wc * 32 + 8 * fq;
#pragma unroll
        for (int ai = 0; ai < 2; ++ai)
#pragma unroll
            for (int m = 0; m < 4; ++m) { const f32x4 a0 = acc[ai][0][m][0], a1 = acc[ai][0][m][1], b0 = acc[ai][1][m][0], b1 = acc[ai][1][m][1]; float v[8];
#pragma unroll
                for (int e = 0; e < 4; ++e) { v[e] = a0[e] * sigm(a0[e]) * b0[e]; v[4 + e] = a1[e] * sigm(a1[e]) * b1[e]; }
                u32x4 w; w.x = pkh(v[0], v[1]); w.y = pkh(v[2], v[3]); w.z = pkh(v[4], v[5]); w.w = pkh(v[6], v[7]);
                *(u32x4*)(hb + (size_t)(row0 + ai * HALF + m * 16) * DFF + col0) = w; }
    }
};

constexpr size_t MiB = 1u << 20;
constexpr size_t WS_CTL = 0, CTL_ZERO_BYTES = 1 * MiB;
constexpr size_t WS_COS = 1 * MiB, WS_SIN = 1 * MiB + 512 * 1024;
constexpr size_t WS_RSTDQ = 2 * MiB, WS_RSTDKV = 2 * MiB + 64 * 1024;
constexpr size_t WS_BS = 3 * MiB + 512 * 1024;
constexpr size_t WS_S5END = 2 * MiB + 512 * 1024;
constexpr size_t WS_WIN = 4 * MiB;
constexpr size_t WS_WG = WS_WIN + 5632 * 1024;
constexpr size_t WS_WLORA = WS_WG + 6 * MiB;
constexpr size_t WS_WQ = WS_WLORA + 768 * 1024;
constexpr size_t WS_WKV = WS_WQ + 384 * 1024;
constexpr size_t WS_WRO = WS_WKV + 256 * 1024;
constexpr size_t WS_WMO = WS_WRO + 1 * MiB;
constexpr size_t WS_WGLU = WS_WMO + 1 * MiB;
constexpr size_t WS_WO = WS_WGLU + 2 * MiB;
constexpr size_t WS_W13 = WS_WO + 2 * MiB;
constexpr size_t WS_W2 = WS_W13 + 11 * MiB;
static_assert(WS_W2 + 5632 * 1024 <= 40 * MiB, "weights region");
constexpr size_t SLOT0 = 40 * MiB, SLOT = 8 * MiB;
#define WS_SLOT(s) (SLOT0 + (size_t)(s) * SLOT)
constexpr size_t WS_XH = WS_SLOT(0), WS_PRWKV = WS_SLOT(4), WS_PMLA = WS_SLOT(11), WS_U = WS_SLOT(13);
constexpr size_t WS_KC = WS_SLOT(1), WS_ALORA = WS_SLOT(0), WS_R = WS_SLOT(15), WS_K = WS_SLOT(17), WS_V = WS_SLOT(19);
constexpr size_t WS_LW = WS_SLOT(5), WS_ASIG = WS_SLOT(7), WS_G = WS_SLOT(9), WS_QC = WS_SLOT(21), WS_VA = WS_SLOT(24);
constexpr size_t WS_YS5 = WS_SLOT(11), WS_OATT = WS_SLOT(13), WS_YRW0 = WS_SLOT(0), WS_YRW1 = WS_SLOT(26);
constexpr size_t WS_XH2 = WS_SLOT(15), WS_YAIN = WS_SLOT(1), WS_GATES0 = WS_SLOT(3), WS_GATES1 = WS_SLOT(7), WS_GATES2 = WS_SLOT(19), WS_MERGED = WS_SLOT(23);
constexpr size_t WS_PRE = WS_SLOT(11), WS_X1H = WS_SLOT(0), WS_HB = WS_SLOT(4), WS_PRE2 = WS_SLOT(15);
constexpr size_t WS_END = WS_SLOT(27);
static_assert(WS_GATES1 == WS_GATES0 + 4 * SLOT && WS_GATES2 == WS_GATES0 + 16 * SLOT, "EpiGate strides");
static_assert(WS_ASIG == WS_LW + 16 * MiB && WS_G == WS_LW + 32 * MiB, "EpiLora strides");
static_assert(WS_END == 256 * MiB, "ws map");
constexpr int CW_BAR = 4096;
constexpr int CW_QUEUE = 64;

constexpr int LDS_BYTES = 147456;
constexpr int MISC_OFF = 131072 + 320;
constexpr int NWAVES = 8, NTHREADS = 512;

struct Args {
    const float* in[37]; float* out; unsigned char* ws; float invfreq[16]; int ph_lo, ph_hi; int one_launch, pad;
};
enum { I_X = 0, I_WIN, I_MU, I_W0, I_W2, I_A0, I_A2, I_G2, I_KK, I_KA, I_RK, I_GNG, I_GNB, I_ROUT, I_QNORM, I_QUP, I_KVNORM, I_KVUP, I_MOUT,
       I_LRE, I_LIM, I_LSTEP, I_BRE, I_BIM, I_CRE, I_CIM, I_S5D, I_GLU, I_GATEB, I_WOUT, I_LN1G, I_LN1B, I_W1, I_W3, I_FW2, I_LN2G, I_LN2B };

struct Frame {
    LAS unsigned char* lds; int tid, lane, wave, G, bid; unsigned char* ws; const Args* a; int rep;
};
__device__ __forceinline__ float wave_sum(float v) {
#pragma unroll
    for (int o = 1; o < 64; o <<= 1) v += __shfl_xor(v, o);
    return v;
}

__device__ __forceinline__ void cvt_item(const float* src, int ldsrc, int k0, int n0, h16* dst, int lddst, int drow0, int dk0, const float* kscale, LAS float* scr, int lane) {
    if (src) {
#pragma unroll 8
        for (int i = 0; i < 32; ++i) { const int kk = 2 * i + (lane >> 5); float v = src[(size_t)(k0 + kk) * ldsrc + n0 + (lane & 31)]; if (kscale) v *= kscale[k0 + kk]; scr[kk * 33 + (lane & 31)] = v; }
    }
    asm volatile("s_waitcnt lgkmcnt(0)" ::: "memory");
    const int c = lane & 7;
#pragma unroll
    for (int j = 0; j < 4; ++j) { const int n = (lane >> 3) + 8 * j; const LAS float* s = scr + (8 * c) * 33 + n;
        u32x4 o = {0u, 0u, 0u, 0u};
        if (src) { o.x = pkh(s[0 * 33], s[1 * 33]); o.y = pkh(s[2 * 33], s[3 * 33]); o.z = pkh(s[4 * 33], s[5 * 33]); o.w = pkh(s[6 * 33], s[7 * 33]); }
        *(u32x4*)(dst + (size_t)(drow0 + n) * lddst + dk0 + 8 * c) = o; }
    asm volatile("s_waitcnt lgkmcnt(0)" ::: "memory");
}
__device__ __forceinline__ void phase_convert(Frame& F, int l) {
    LAS float* scr = (LAS float*)(F.lds + F.wave * 16384);
    const int gw = F.bid * NWAVES + F.wave, NGW = F.G * NWAVES; unsigned char* ws = F.ws; const Args& A = *F.a;
    const float* win = A.in[I_WIN] + (size_t)l * D * IN_COLS;
    constexpr int N_WIN = 16 * 88, N_WG = 16 * 96, N_LORA = 4 * 48, N_Q = 4 * 24, N_KV = 2 * 32, N_RO = 8 * 32, N_MO = 8 * 32, N_GLU = 8 * 64, N_O = 16 * 32, N_13 = 16 * 176, N_2 = 44 * 32;
    constexpr int NITEMS = N_WIN + N_WG + N_LORA + N_Q + N_KV + N_RO + N_MO + N_GLU + N_O + N_13 + N_2;
    for (int it = gw; it < NITEMS; it += NGW) {
        int r = it;
        if (r < N_WIN) { const int kb = r / 88, db = r % 88;
            int sc; if (db < 56) sc = 32 * db; else if (db < 69) sc = O_MLA + 32 * (db - 56); else if (db < 72) sc = -1; else sc = O_S5 + 32 * (db - 72);
            cvt_item(sc >= 0 ? win : nullptr, IN_COLS, 64 * kb, sc, (h16*)(ws + WS_WIN), 1024, 32 * db, 64 * kb, nullptr, scr, F.lane); continue; } r -= N_WIN;
        if (r < N_WG) { const int kb = r / 96, db = r % 96;
            cvt_item(win, IN_COLS, 64 * kb, O_GATE + 32 * db, (h16*)(ws + WS_WG), 1024, 32 * db, 64 * kb, nullptr, scr, F.lane); continue; } r -= N_WG;
        if (r < N_LORA) { const int kb = r / 48, db = r % 48; const float* s = nullptr; int k0 = 0, n0 = 0;
            if (db < 16) { if (kb == 0) { s = A.in[I_W2] + (size_t)l * 64 * 512; k0 = 0; n0 = 32 * db; } }
            else if (db < 32) { if (kb == 1) { s = A.in[I_A2] + (size_t)l * 64 * 512; k0 = 0; n0 = 32 * (db - 16); } }
            else { if (kb >= 2) { s = A.in[I_G2] + (size_t)l * 128 * 512; k0 = 64 * (kb - 2); n0 = 32 * (db - 32); } }
            cvt_item(s, 512, k0, n0, (h16*)(ws + WS_WLORA), 256, 32 * db, 64 * kb, nullptr, scr, F.lane); continue; } r -= N_LORA;
        if (r < N_Q) { const int kb = r / 24, db = r % 24;
            cvt_item(A.in[I_QUP] + (size_t)l * 256 * 768, 768, 64 * kb, 32 * db, (h16*)(ws + WS_WQ), 256, 32 * db, 64 * kb, A.in[I_QNORM] + l * 256, scr, F.lane); continue; } r -= N_Q;
        if (r < N_KV) { const int kb = r / 32, db = r % 32;
            cvt_item(A.in[I_KVUP] + (size_t)l * 128 * 1024, 1024, 64 * kb, 32 * db, (h16*)(ws + WS_WKV), 128, 32 * db, 64 * kb, A.in[I_KVNORM] + l * 128, scr, F.lane); continue; } r -= N_KV;
        if (r < N_RO) { const int kb = r / 32, db = r % 32;
            cvt_item(A.in[I_ROUT] + (size_t)l * 512 * 1024, 1024, 64 * kb, 32 * db, (h16*)(ws + WS_WRO), 512, 32 * db, 64 * kb, nullptr, scr, F.lane); continue; } r -= N_RO;
        if (r < N_MO) { const int kb = r / 32, db = r % 32;
            cvt_item(A.in[I_MOUT] + (size_t)l * 512 * 1024, 1024, 64 * kb, 32 * db, (h16*)(ws + WS_WMO), 512, 32 * db, 64 * kb, nullptr, scr, F.lane); continue; } r -= N_MO;
        if (r < N_GLU) { const int kb = r / 64, db = r % 64, t = db >> 3, w = db & 7; const int sc = (w < 4) ? 128 * t + 32 * w : 1024 + 128 * t + 32 * (w - 4);
            cvt_item(A.in[I_GLU] + (size_t)l * 512 * 2048, 2048, 64 * kb, sc, (h16*)(ws + WS_WGLU), 512, 32 * db, 64 * kb, nullptr, scr, F.lane); continue; } r -= N_GLU;
        if (r < N_O) { const int kb = r / 32, db = r % 32;
            cvt_item(A.in[I_WOUT] + (size_t)l * 1024 * 1024, 1024, 64 * kb, 32 * db, (h16*)(ws + WS_WO), 1024, 32 * db, 64 * kb, nullptr, scr, F.lane); continue; } r -= N_O;
        if (r < N_13) { const int kb = r / 176, db = r % 176, t = db >> 3, w = db & 7; const float* s = (w < 4 ? A.in[I_W1] : A.in[I_W3]) + (size_t)l * 1024 * DFF;
            cvt_item(s, DFF, 64 * kb, 128 * t + 32 * (w & 3), (h16*)(ws + WS_W13), 1024, 32 * db, 64 * kb, nullptr, scr, F.lane); continue; } r -= N_13;
        { const int kb = r / 32, db = r % 32;
            cvt_item(A.in[I_FW2] + (size_t)l * DFF * 1024, 1024, 64 * kb, 32 * db, (h16*)(ws + WS_W2), DFF, 32 * db, 64 * kb, nullptr, scr, F.lane); }
    }
}
__device__ __forceinline__ void rows_to_h16(Frame& F, const float* x, h16* xh) {
    const int gw = F.bid * NWAVES + F.wave, NGW = F.G * NWAVES;
    for (int m = gw; m < M; m += NGW) { const f32x4* xr = (const f32x4*)(x + (size_t)m * D) + F.lane; u32x2* o = (u32x2*)(xh + (size_t)m * D) + F.lane;
#pragma unroll
        for (int j = 0; j < 4; ++j) { const f32x4 v = xr[64 * j]; u32x2 w; w.x = pkh(v.x, v.y); w.y = pkh(v.z, v.w); o[64 * j] = w; } }
}
__device__ __forceinline__ void rope_table(Frame& F) {
    float* cosT = (float*)(F.ws + WS_COS); float* sinT = (float*)(F.ws + WS_SIN);
    for (int i = F.bid * NTHREADS + F.tid; i < T * 16; i += F.G * NTHREADS) { const int pos = i >> 4, f = i & 15; const float ang = (float)pos * exp2f(-(float)f * 0.8304820237218406f); float s, c; sincosf(ang, &s, &c); cosT[i] = c; sinT[i] = s; }
}
__device__ __forceinline__ void phase_ln(Frame& F, const float* pre, const float* g, const float* b, float* xo, h16* xoh) {
    const int gw = F.bid * NWAVES + F.wave, NGW = F.G * NWAVES;
    f32x4 gv[4], bv[4];
#pragma unroll
    for (int j = 0; j < 4; ++j) { gv[j] = ((const f32x4*)g)[F.lane + 64 * j]; bv[j] = ((const f32x4*)b)[F.lane + 64 * j]; }
    for (int m = gw; m < M; m += NGW) {
        const f32x4* xr = (const f32x4*)(pre + (size_t)m * D) + F.lane; f32x4 v[4]; float s = 0.f;
#pragma unroll
        for (int j = 0; j < 4; ++j) { v[j] = xr[64 * j]; s += (v[j].x + v[j].y) + (v[j].z + v[j].w); }
        const float mean = wave_sum(s) * (1.f / D); float s2 = 0.f;
#pragma unroll
        for (int j = 0; j < 4; ++j) { v[j] = v[j] - mean; s2 += (v[j].x * v[j].x + v[j].y * v[j].y) + (v[j].z * v[j].z + v[j].w * v[j].w); }
        const float rstd = 1.f / sqrtf(wave_sum(s2) * (1.f / D) + LN_EPS);
        f32x4* o = (f32x4*)(xo + (size_t)m * D) + F.lane; u32x2* oh = (u32x2*)(xoh + (size_t)m * D) + F.lane;
#pragma unroll
        for (int j = 0; j < 4; ++j) { const f32x4 y = v[j] * rstd * gv[j] + bv[j]; o[64 * j] = y; u32x2 w; w.x = pkh(y.x, y.y); w.y = pkh(y.z, y.w); oh[64 * j] = w; }
    }
}

__device__ __forceinline__ void ld8(const h16* p, float (&o)[8]) { unpk8(*(const u32x4*)p, o); }
__device__ __forceinline__ void st8(LAS h16* p, const float (&v)[8]) { u32x4 w; w.x = pkh(v[0], v[1]); w.y = pkh(v[2], v[3]); w.z = pkh(v[4], v[5]); w.w = pkh(v[6], v[7]); *(LAS u32x4*)p = w; }
__device__ __forceinline__ void st8(h16* p, const float (&v)[8]) { u32x4 w; w.x = pkh(v[0], v[1]); w.y = pkh(v[2], v[3]); w.z = pkh(v[4], v[5]); w.w = pkh(v[6], v[7]); *(u32x4*)p = w; }
__device__ __forceinline__ void phase_prep(Frame& F, int l) {
    const int gw = F.bid * NWAVES + F.wave, NGW = F.G * NWAVES; unsigned char* ws = F.ws; const Args& A = *F.a; const int lane = F.lane;
    const h16* P = (const h16*)(ws + WS_PRWKV); const float* mu = A.in[I_MU] + l * RWKV_COLS;
    h16* R = (h16*)(ws + WS_R); h16* Kk = (h16*)(ws + WS_K); h16* V = (h16*)(ws + WS_V); h16* AL = (h16*)(ws + WS_ALORA);
    const h16* PM = (const h16*)(ws + WS_PMLA); h16* Kc = (h16*)(ws + WS_KC); float* rq = (float*)(ws + WS_RSTDQ); float* rkv = (float*)(ws + WS_RSTDKV);
    const float* cosT = (const float*)(ws + WS_COS); const float* sinT = (const float*)(ws + WS_SIN);
    for (int m = gw; m < M; m += NGW) {
        const int t = m & (T - 1);
#pragma unroll
        for (int j = 0; j < 4; ++j) { const int ch = lane + 64 * j;
            if (ch < 224) { const int c = 8 * ch; float p[8], q[8], o[8];
                ld8(P + (size_t)m * RWKV_COLS + c, p);
                if (t > 0) ld8(P + (size_t)(m - 1) * RWKV_COLS + c, q); else {
#pragma unroll
                    for (int e = 0; e < 8; ++e) q[e] = 0.f; }
                const f32x4 m0 = *(const f32x4*)(mu + c), m1 = *(const f32x4*)(mu + c + 4);
#pragma unroll
                for (int e = 0; e < 8; ++e) o[e] = p[e] + (q[e] - p[e]) * (e < 4 ? m0[e] : m1[e - 4]);
                if (c < 512) st8(R + (size_t)m * RD + c, o);
                else if (c < 1024) st8(Kk + (size_t)m * RD + (c - 512), o);
                else if (c < 1536) st8(V + (size_t)m * RD + (c - 1024), o);
                else { if (c < 1600) {
#pragma unroll
                        for (int e = 0; e < 8; ++e) o[e] = tanhf(o[e]); }
                    else if (c >= 1664) {
#pragma unroll
                        for (int e = 0; e < 8; ++e) o[e] = sigm(o[e]); }
                    st8(AL + (size_t)m * 256 + (c - 1536), o); } } }
        { float x[8]; float ss = 0.f;
            if (lane < 52) { ld8(PM + (size_t)m * 512 + 8 * lane, x);
#pragma unroll
                for (int e = 0; e < 8; ++e) ss += x[e] * x[e]; }
            else {
#pragma unroll
                for (int e = 0; e < 8; ++e) x[e] = 0.f; }
            const float sq = wave_sum(lane < 32 ? ss : 0.f), skv = wave_sum((lane >= 32 && lane < 48) ? ss : 0.f);
            if (lane == 0) { rq[m] = 1.0f / sqrtf(sq * (1.f / 256.f) + RMS_EPS); rkv[m] = 1.0f / sqrtf(skv * (1.f / 128.f) + RMS_EPS); }
            float y[8], o[8];
#pragma unroll
            for (int e = 0; e < 8; ++e) y[e] = __shfl_xor(x[e], 2);
            if (lane >= 48 && lane < 52) { const int i0 = 8 * (lane & 1); const bool second = lane >= 50;
#pragma unroll
                for (int e = 0; e < 8; ++e) { const float cs = cosT[t * 16 + i0 + e], sn = sinT[t * 16 + i0 + e];
                    o[e] = second ? (x[e] * cs + y[e] * sn) : (x[e] * cs - y[e] * sn); }
#pragma unroll
                for (int h = 0; h < 8; ++h) st8(Kc + (size_t)m * 768 + h * 96 + 64 + 8 * (lane - 48), o); } }
    }
}
__device__ __forceinline__ void phase_rwkv_post(Frame& F, int l, const float* xsrc) {
    const int gw = F.bid * NWAVES + F.wave, NGW = F.G * NWAVES; unsigned char* ws = F.ws; const Args& A = *F.a; const int lane = F.lane;
    const h16* R = (const h16*)(ws + WS_R); const h16* Kk = (const h16*)(ws + WS_K); const h16* V = (const h16*)(ws + WS_V);
    const h16* AS = (const h16*)(ws + WS_ASIG); const h16* G = (const h16*)(ws + WS_G); h16* YA = (h16*)(ws + WS_YAIN);
    const int c = 8 * lane;
    float ka[8], rk[8], gg[8], gb[8];
    { const f32x4 a0 = *(const f32x4*)(A.in[I_KA] + l * RD + c), a1 = *(const f32x4*)(A.in[I_KA] + l * RD + c + 4), r0 = *(const f32x4*)(A.in[I_RK] + l * RD + c), r1 = *(const f32x4*)(A.in[I_RK] + l * RD + c + 4);
      const f32x4 g0 = *(const f32x4*)(A.in[I_GNG] + l * RD + c), g1 = *(const f32x4*)(A.in[I_GNG] + l * RD + c + 4), b0 = *(const f32x4*)(A.in[I_GNB] + l * RD + c), b1 = *(const f32x4*)(A.in[I_GNB] + l * RD + c + 4);
#pragma unroll
      for (int e = 0; e < 4; ++e) { ka[e] = a0[e]; ka[4 + e] = a1[e]; rk[e] = r0[e]; rk[4 + e] = r1[e]; gg[e] = g0[e]; gg[4 + e] = g1[e]; gb[e] = b0[e]; gb[4 + e] = b1[e]; } }
    for (int m = gw; m < M; m += NGW) {
        const h16* Y = (const h16*)(ws + (m < T ? WS_YRW0 : WS_YRW1)) + (size_t)(m & (T - 1)) * RD;
        float y[8], v[8], g[8], o[8];
        ld8(Y + c, y); ld8(V + (size_t)m * RD + c, v); ld8(G + (size_t)m * RD + c, g);
        float s = 0.f; const float bs = ((const float*)(ws + WS_BS))[(size_t)m * 8 + (lane >> 3)];
#pragma unroll
        for (int e = 0; e < 8; ++e) s += y[e];
        s += __shfl_xor(s, 1); s += __shfl_xor(s, 2); s += __shfl_xor(s, 4);
        const float mean = s * (1.f / 64.f); float q = 0.f;
#pragma unroll
        for (int e = 0; e < 8; ++e) { y[e] -= mean; q += y[e] * y[e]; }
        q += __shfl_xor(q, 1); q += __shfl_xor(q, 2); q += __shfl_xor(q, 4);
        const float rstd = 1.0f / sqrtf(q * (1.f / 64.f) + GN_EPS);
#pragma unroll
        for (int e = 0; e < 8; ++e) o[e] = (y[e] * rstd * gg[e] + gb[e] + bs * v[e]) * g[e];
        st8(YA + (size_t)m * RD + c, o);
    }
    rows_to_h16(F, xsrc, (h16*)(ws + WS_XH2));
}

constexpr int S5_NC = 32, S5_CL = T / S5_NC;
__device__ __forceinline__ float rdlane(float v, int l) { return __builtin_bit_cast(float, __builtin_amdgcn_readlane(__builtin_bit_cast(int, v), l)); }
__device__ __forceinline__ float gelu_tanh(float x) { const float u = 0.7978845608028654f * (x + 0.044715f * x * x * x); return 0.5f * x * (1.0f + tanhf(u)); }
template <int PASS> __device__ __forceinline__ void phase_s5(Frame& F, int l) {
    const int gw = F.bid * NWAVES + F.wave, NGW = F.G * NWAVES; unsigned char* ws = F.ws; const Args& A = *F.a; const int lane = F.lane;
    const h16* U = (const h16*)(ws + WS_U); h16* Y = (h16*)(ws + WS_YS5); float* END = (float*)(ws + WS_S5END);
    LAS h16* sl = (LAS h16*)(F.lds + F.wave * 8704);
    for (int task = gw; task < BATCH * 32 * S5_NC; task += NGW) {
        const int ch = task % S5_NC, g = (task / S5_NC) % 32, b = task / (S5_NC * 32);
        const int gp = (l * 32 + g) * 64 + lane;
        const float lam_re = fminf(A.in[I_LRE][gp], -1e-4f), lam_im = A.in[I_LIM][gp], step = __expf(A.in[I_LSTEP][l * 32 + g]);
        float sn, cs; sincosf(lam_im * step, &sn, &cs); const float mag = __expf(lam_re * step);
        const float lb_re = mag * cs, lb_im = mag * sn, den = lam_re * lam_re + lam_im * lam_im, n_re = lb_re - 1.0f;
        const float f_re = (n_re * lam_re + lb_im * lam_im) / den, f_im = (lb_im * lam_re - n_re * lam_im) / den;
        float bbr[16], bbi[16];
#pragma unroll
        for (int q = 0; q < 4; ++q) { const f32x4 br = *(const f32x4*)(A.in[I_BRE] + (size_t)gp * 16 + 4 * q), bi = *(const f32x4*)(A.in[I_BIM] + (size_t)gp * 16 + 4 * q);
#pragma unroll
            for (int e = 0; e < 4; ++e) { bbr[4 * q + e] = f_re * br[e] - f_im * bi[e]; bbi[4 * q + e] = f_re * bi[e] + f_im * br[e]; } }
        float s_re = 0.f, s_im = 0.f;
        h16x8 cf[4]; float dsk = 0.f;
        if (PASS == 2) {
            float snL, csL; sincosf(lam_im * step * (float)S5_CL, &snL, &csL); const float magL = __expf(lam_re * step * (float)S5_CL); const float L_re = magL * csL, L_im = magL * snL;
            const float* e0 = END + ((size_t)(b * 32 + g) * S5_NC) * 128 + 2 * lane;
            for (int j = 0; j < ch; ++j) { const f32x2 e = *(const f32x2*)(e0 + j * 128); const float nr = s_re * L_re - s_im * L_im + e.x, ni = s_re * L_im + s_im * L_re + e.y; s_re = nr; s_im = ni; }
            const int c = lane & 15, kg = lane >> 4;
#pragma unroll
            for (int ks = 0; ks < 4; ++ks) { const int k = 32 * ks + 8 * kg; const float* src = (k < 64 ? A.in[I_CRE] : A.in[I_CIM]) + ((size_t)(l * 32 + g) * 16 + c) * 64 + (k & 63); const float sg = k < 64 ? 1.f : -1.f;
                const f32x4 a0 = *(const f32x4*)src, a1 = *(const f32x4*)(src + 4);
                cf[ks] = (h16x8){(h16)(sg * a0[0]), (h16)(sg * a0[1]), (h16)(sg * a0[2]), (h16)(sg * a0[3]), (h16)(sg * a1[0]), (h16)(sg * a1[1]), (h16)(sg * a1[2]), (h16)(sg * a1[3])}; }
            dsk = A.in[I_S5D][l * 512 + 16 * g + c];
        }
        const size_t m0 = (size_t)b * T + (size_t)ch * S5_CL;
        for (int tile = 0; tile < S5_CL / 64; ++tile) {
            float uv[16]; { const h16* up = U + (m0 + 64 * tile + lane) * 512 + 16 * g; float a[8], c2[8]; ld8(up, a); ld8(up + 8, c2);
#pragma unroll
                for (int e = 0; e < 8; ++e) { uv[e] = a[e]; uv[8 + e] = c2[e]; } }
#pragma unroll 1
            for (int half = 0; half < 2; ++half) {
#pragma unroll 2
                for (int tt = 0; tt < 32; ++tt) { const int tl = 32 * half + tt; float br = 0.f, bi = 0.f;
#pragma unroll
                    for (int c = 0; c < 16; ++c) { const float uc = rdlane(uv[c], tl); br += bbr[c] * uc; bi += bbi[c] * uc; }
                    const float nr = s_re * lb_re - s_im * lb_im + br, ni = s_re * lb_im + s_im * lb_re + bi; s_re = nr; s_im = ni;
                    if (PASS == 2) { sl[tt * 136 + lane] = (h16)s_re; sl[tt * 136 + 64 + lane] = (h16)s_im; } }
                if (PASS == 2) {
                    asm volatile("s_waitcnt lgkmcnt(0)" ::: "memory");
                    const int c = lane & 15, kg = lane >> 4;
#pragma unroll
                    for (int mb = 0; mb < 2; ++mb) { f32x4 acc = {0.f, 0.f, 0.f, 0.f};
#pragma unroll
                        for (int ks = 0; ks < 4; ++ks) { const h16x8 af = *(const LAS h16x8*)(sl + (mb * 16 + c) * 136 + 32 * ks + 8 * kg); acc = __builtin_amdgcn_mfma_f32_16x16x32_f16(af, cf[ks], acc, 0, 0, 0); }
#pragma unroll
                        for (int e = 0; e < 4; ++e) { const size_t m = m0 + 64 * tile + 32 * half + mb * 16 + 4 * kg + e; const float uu = (float)U[m * 512 + 16 * g + c];
                            Y[m * 512 + 16 * g + c] = (h16)gelu_tanh(acc[e] + dsk * uu); } }
                    asm volatile("s_waitcnt lgkmcnt(0)" ::: "memory");
                }
            }
        }
        if (PASS == 1) { *(f32x2*)(END + ((size_t)(b * 32 + g) * S5_NC + ch) * 128 + 2 * lane) = (f32x2){s_re, s_im}; }
    }
}

#ifdef DBG_CHUNK
#define CKO_G  WS_SLOT(21)
#define CKO_H  WS_SLOT(23)
#define CKO_RB WS_SLOT(1)
#define CKO_YB WS_SLOT(13)
#define YREF0  WS_SLOT(3)
#define YREF1  WS_SLOT(25)
#else
#define CKO_G  WS_R
#define CKO_H  WS_K
#define CKO_RB WS_LW
#define CKO_YB WS_ASIG
#endif
constexpr int RW_TS = 32, RW_BUF = 5 * 8192 + 2048 + 256;
template <int CTRL> __device__ __forceinline__ float dpp_add(float v) { return v + __builtin_bit_cast(float, __builtin_amdgcn_update_dpp(0, __builtin_bit_cast(int, v), CTRL, 0xf, 0xf, false)); }
__device__ __forceinline__ float red16(float v) { v = dpp_add<0xB1>(v); v = dpp_add<0x4E>(v); v = dpp_add<0x141>(v); v = dpp_add<0x140>(v); return v; }
__device__ __forceinline__ void rwkv_scan_unit(Frame& F, int l, int b, int h, int q) {
    unsigned char* ws = F.ws; const Args& A = *F.a; const int tid = F.tid, lane = F.lane, wave = F.wave;
    const h16* R = (const h16*)(ws + WS_R); const h16* Kk = (const h16*)(ws + WS_K); const h16* V = (const h16*)(ws + WS_V);
    const h16* LW = (const h16*)(ws + WS_LW); const h16* AS = (const h16*)(ws + WS_ASIG);
#ifdef DBG_CHUNK
    h16* Yg = (h16*)(ws + (b == 0 ? YREF0 : YREF1));
#else
    h16* Yg = (h16*)(ws + (b == 0 ? WS_YRW0 : WS_YRW1));
#endif
    LAS unsigned char* lds = F.lds;
    const size_t base = (size_t)b * T * RD + h * 64;
    if (wave >= 4) {
        const int c = lane; const float kkc = A.in[I_KK][l * RD + h * 64 + c], kac = A.in[I_KA][l * RD + h * 64 + c];
        for (int tile = 0; tile < T / RW_TS; ++tile) {
            LAS float* buf = (LAS float*)(lds + (tile & 1) * RW_BUF);
            float r[8], k[8], v[8], lw[8], as[8];
#pragma unroll
            for (int i = 0; i < 8; ++i) { const size_t idx = base + (size_t)(tile * RW_TS + (wave - 4) * 8 + i) * RD + c;
                r[i] = (float)R[idx]; k[i] = (float)Kk[idx]; v[i] = (float)V[idx]; lw[i] = (float)LW[idx]; as[i] = (float)AS[idx]; }
#pragma unroll
            for (int i = 0; i < 8; ++i) { const int tt = (wave - 4) * 8 + i;
                const float kkr = k[i] * kkc; const float n2 = wave_sum(kkr * kkr); const float kk = kkr * (1.0f / sqrtf(fmaxf(n2, 1e-12f)));
                const float bq = kk * as[i], kp = k[i] * (1.0f + (as[i] - 1.0f) * kac), w = __expf(lw[i]);
                const float brs = wave_sum(bq * r[i]), krs = wave_sum(kp * r[i]);
                buf[tt * 64 + c] = -kk; buf[2048 + tt * 64 + c] = w * r[i]; buf[4096 + tt * 64 + c] = w; buf[6144 + tt * 64 + c] = bq; buf[8192 + tt * 64 + c] = kp;
                if ((c >> 4) == q) buf[10240 + tt * 16 + (c & 15)] = v[i];
                if (c == 0) { buf[10752 + tt * 2] = brs; buf[10752 + tt * 2 + 1] = krs; } }
            __syncthreads();
        }
        __syncthreads();
    } else {
        const int row = tid >> 4, kq = tid & 15;
        float S0 = 0.f, S1 = 0.f, S2 = 0.f, S3 = 0.f;
        __syncthreads();
        for (int tile = 0; tile < T / RW_TS; ++tile) {
            const LAS float* buf = (const LAS float*)(lds + (tile & 1) * RW_BUF);
            float y0 = 0.f, y1 = 0.f;
#pragma unroll
            for (int tt = 0; tt < RW_TS; ++tt) {
                const f32x4 a4 = *(const LAS f32x4*)(buf + tt * 64 + 4 * kq), wr4 = *(const LAS f32x4*)(buf + 2048 + tt * 64 + 4 * kq), w4 = *(const LAS f32x4*)(buf + 4096 + tt * 64 + 4 * kq);
                const f32x4 b4 = *(const LAS f32x4*)(buf + 6144 + tt * 64 + 4 * kq), k4 = *(const LAS f32x4*)(buf + 8192 + tt * 64 + 4 * kq);
                const float vv = buf[10240 + tt * 16 + row]; const f32x2 sc = *(const LAS f32x2*)(buf + 10752 + tt * 2);
                float d1 = (S0 * a4[0] + S1 * a4[1]) + (S2 * a4[2] + S3 * a4[3]);
                float d2 = (S0 * wr4[0] + S1 * wr4[1]) + (S2 * wr4[2] + S3 * wr4[3]);
                d1 = red16(d1); d2 = red16(d2);
                S0 = S0 * w4[0] + d1 * b4[0] + vv * k4[0]; S1 = S1 * w4[1] + d1 * b4[1] + vv * k4[1];
                S2 = S2 * w4[2] + d1 * b4[2] + vv * k4[2]; S3 = S3 * w4[3] + d1 * b4[3] + vv * k4[3];
                const float y = d2 + d1 * sc.x + vv * sc.y;
                if (kq == (tt & 15)) { if (tt < 16) y0 = y; else y1 = y; }
            }
            { const size_t o = (size_t)(tile * RW_TS + kq) * RD + h * 64 + 16 * q + row; Yg[o] = (h16)y0; Yg[o + 16 * RD] = (h16)y1; }
            __syncthreads();
        }
    }
}


constexpr int CK_LDH = 72, CK_MAT = 64 * CK_LDH * 2;
constexpr int CK_RT = 0, CK_BT = CK_MAT, CK_KT = 2 * CK_MAT, CK_VT = 3 * CK_MAT, CK_ATT = 4 * CK_MAT, CK_MRB = 5 * CK_MAT, CK_MRK = 6 * CK_MAT, CK_AN = 7 * CK_MAT  , CK_BN = 8 * CK_MAT  ,
              CK_KN = 9 * CK_MAT  , CK_LAK = 10 * CK_MAT  , CK_P = 11 * CK_MAT, CK_PT = 12 * CK_MAT, CK_TACC = 13 * CK_MAT, CK_CUM = CK_P  , CK_SM = 14 * CK_MAT;
static_assert(CK_SM + 768 <= 131072 && 2 * CK_MAT >= 16384, "chunk LDS map");
template <int KS> __device__ __forceinline__ void ck_mm2(f32x4& acc0, f32x4& acc1, const LAS unsigned char* A, int mb0, const LAS unsigned char* Bt, int nb, int lane) {
    const int row = lane & 15, kg = lane >> 4;
#pragma unroll
    for (int ks = 0; ks < KS; ++ks) { const h16x8 b = *(const LAS h16x8*)(Bt + ((16 * nb + row) * CK_LDH + 32 * ks + 8 * kg) * 2);
        const h16x8 a0 = *(const LAS h16x8*)(A + ((16 * mb0 + row) * CK_LDH + 32 * ks + 8 * kg) * 2), a1 = *(const LAS h16x8*)(A + ((16 * mb0 + 16 + row) * CK_LDH + 32 * ks + 8 * kg) * 2);
        acc0 = __builtin_amdgcn_mfma_f32_16x16x32_f16(a0, b, acc0, 0, 0, 0); acc1 = __builtin_amdgcn_mfma_f32_16x16x32_f16(a1, b, acc1, 0, 0, 0); }
}
__device__ __forceinline__ void ck_st(LAS unsigned char* base, int n_, int m_, const f32x4 v) { *(LAS u32x2*)(base + (n_ * CK_LDH + m_) * 2) = (u32x2){pkh(v[0], v[1]), pkh(v[2], v[3])}; }
__device__ __forceinline__ void rwkv_chunk_item(Frame& F, int l, int b, int h, int c) {
    unsigned char* ws = F.ws; const Args& A = *F.a; int tid = F.tid; asm volatile("" : "+v"(tid)); const int lane = tid & 63, w = F.wave; LAS unsigned char* lds = F.lds;
    h16* R = (h16*)(ws + WS_R); h16* Kk = (h16*)(ws + WS_K); const h16* V = (const h16*)(ws + WS_V); h16* LW = (h16*)(ws + WS_LW); h16* AS = (h16*)(ws + WS_ASIG); float* BS = (float*)(ws + WS_BS);
    const size_t m0 = (size_t)b * T + (size_t)c * 64; const size_t tile = m0 * RD + h * 64;
    LAS float* cum = (LAS float*)(lds + CK_CUM); LAS float* sm = (LAS float*)(lds + CK_SM);
    const int t = tid >> 3, c8 = tid & 7, k0 = 8 * c8;
    float lwv[8]; ld8(LW + tile + (size_t)t * RD + k0, lwv);
    *(LAS f32x4*)(cum + t * 64 + k0) = (f32x4){lwv[0], lwv[1], lwv[2], lwv[3]}; *(LAS f32x4*)(cum + t * 64 + k0 + 4) = (f32x4){lwv[4], lwv[5], lwv[6], lwv[7]};
    float rv[8], kv[8], vv[8], av[8];
    ld8(R + tile + (size_t)t * RD + k0, rv); ld8(Kk + tile + (size_t)t * RD + k0, kv); ld8(V + tile + (size_t)t * RD + k0, vv); ld8(AS + tile + (size_t)t * RD + k0, av);
    __syncthreads();
    if (w == 0) { float run = 0.f, rho = 0.f;
#pragma unroll 8
        for (int tt = 0; tt < 64; ++tt) { run += cum[tt * 64 + lane]; cum[tt * 64 + lane] = run; if (tt == 31) rho = run; }
        sm[lane] = __expf(rho); sm[64 + lane] = __expf(run - rho); sm[128 + lane] = rho; }
    __syncthreads();
    { float kkr[8], n2 = 0.f, bsum = 0.f; float kp[8];
      const f32x4 kk0 = *(const f32x4*)(A.in[I_KK] + l * RD + h * 64 + k0), kk1 = *(const f32x4*)(A.in[I_KK] + l * RD + h * 64 + k0 + 4), ka0 = *(const f32x4*)(A.in[I_KA] + l * RD + h * 64 + k0), ka1 = *(const f32x4*)(A.in[I_KA] + l * RD + h * 64 + k0 + 4);
      const f32x4 rk0 = *(const f32x4*)(A.in[I_RK] + l * RD + h * 64 + k0), rk1 = *(const f32x4*)(A.in[I_RK] + l * RD + h * 64 + k0 + 4);
#pragma unroll
      for (int e = 0; e < 8; ++e) { const float kkc = e < 4 ? kk0[e] : kk1[e - 4], kac = e < 4 ? ka0[e] : ka1[e - 4], rkc = e < 4 ? rk0[e] : rk1[e - 4];
          kkr[e] = kv[e] * kkc; n2 += kkr[e] * kkr[e]; kp[e] = kv[e] * (1.0f + (av[e] - 1.0f) * kac); bsum += rv[e] * kp[e] * rkc; }
      n2 += __shfl_xor(n2, 1); n2 += __shfl_xor(n2, 2); n2 += __shfl_xor(n2, 4); bsum += __shfl_xor(bsum, 1); bsum += __shfl_xor(bsum, 2); bsum += __shfl_xor(bsum, 4);
      if (c8 == 0) BS[(m0 + t) * 8 + h] = bsum;
      const float rn = 1.0f / sqrtf(fmaxf(n2, 1e-12f));
      float Rt[8], At[8], Kt[8], Bt[8];
#pragma unroll
      for (int e = 0; e < 8; ++e) { const float cu = cum[t * 64 + k0 + e], rho = sm[128 + k0 + e]; const float e1 = __expf(cu - rho), e2 = __expf(rho - cu), e0 = __expf(cu - lwv[e] - rho), kk = kkr[e] * rn;
          Rt[e] = rv[e] * e1; At[e] = -kk * e0; Kt[e] = kp[e] * e2; Bt[e] = kk * av[e] * e2; }
      __syncthreads();
      st8((LAS h16*)(lds + CK_RT) + t * CK_LDH + k0, Rt); st8((LAS h16*)(lds + CK_AN) + t * CK_LDH + k0, At); st8((LAS h16*)(lds + CK_BN) + t * CK_LDH + k0, Bt); st8((LAS h16*)(lds + CK_KN) + t * CK_LDH + k0, Kt);
#pragma unroll
      for (int e = 0; e < 8; ++e) { ((LAS h16*)(lds + CK_BT))[(k0 + e) * CK_LDH + t] = (h16)Bt[e]; ((LAS h16*)(lds + CK_KT))[(k0 + e) * CK_LDH + t] = (h16)Kt[e]; ((LAS h16*)(lds + CK_VT))[(k0 + e) * CK_LDH + t] = (h16)vv[e]; ((LAS h16*)(lds + CK_ATT))[(k0 + e) * CK_LDH + t] = (h16)At[e]; } }
    __syncthreads();
    const int nb = w & 3, mb0 = 2 * (w >> 2), n_ = 16 * nb + (lane & 15), kg = lane >> 4;
    { f32x4 a0 = {}, a1 = {}, t0 = {}, t1 = {}, b0 = {}, b1 = {}, c0 = {}, c1 = {}, d0 = {}, d1 = {};
      ck_mm2<2>(a0, a1, lds + CK_BN, mb0, lds + CK_AN, nb, lane);
      ck_mm2<2>(t0, t1, lds + CK_AN, mb0, lds + CK_BN, nb, lane);
      ck_mm2<2>(b0, b1, lds + CK_KN, mb0, lds + CK_AN, nb, lane); ck_mm2<2>(c0, c1, lds + CK_BN, mb0, lds + CK_RT, nb, lane); ck_mm2<2>(d0, d1, lds + CK_KN, mb0, lds + CK_RT, nb, lane);
#pragma unroll
      for (int mbi = 0; mbi < 2; ++mbi) { const int m_ = 16 * (mb0 + mbi) + 4 * kg; f32x4 la = mbi ? a1 : a0, lt = mbi ? t1 : t0, lk = mbi ? b1 : b0, mr = mbi ? c1 : c0, mk = mbi ? d1 : d0, ta;
#pragma unroll
          for (int e = 0; e < 4; ++e) { const bool st = (m_ + e) < n_, inc = (m_ + e) <= n_; la[e] = st ? la[e] : 0.f; ta[e] = la[e] + ((m_ + e) == n_ ? 1.f : 0.f); lk[e] = st ? lk[e] : 0.f; mr[e] = inc ? mr[e] : 0.f; mk[e] = inc ? mk[e] : 0.f;
              lt[e] = (m_ + e) > n_ ? lt[e] : 0.f; }
          ck_st(lds + CK_P, n_, m_, la); ck_st(lds + CK_TACC, n_, m_, ta); ck_st(lds + CK_PT, n_, m_, lt); ck_st(lds + CK_LAK, n_, m_, lk); ck_st(lds + CK_MRB, n_, m_, mr); ck_st(lds + CK_MRK, n_, m_, mk); } }
    __syncthreads();
    { f32x4 x0 = {}, x1 = {}; ck_mm2<2>(x0, x1, lds + CK_LAK, mb0, lds + CK_VT, nb, lane); ck_st(lds + CK_AN, n_, 16 * mb0 + 4 * kg, x0); ck_st(lds + CK_AN, n_, 16 * mb0 + 16 + 4 * kg, x1); }
#pragma unroll
    for (int r = 0; r < 5; ++r) {
        const int pa = (r & 1) ? CK_BN : CK_P, pat = (r & 1) ? CK_KN : CK_PT, pb = (r & 1) ? CK_P : CK_BN, pbt = (r & 1) ? CK_PT : CK_KN;
        { f32x4 p0 = {}, p1 = {}, q0 = {}, q1 = {};
          ck_mm2<2>(p0, p1, lds + pat, mb0, lds + pa, nb, lane);
          ck_mm2<2>(q0, q1, lds + pa, mb0, lds + pat, nb, lane);
          ck_st(lds + pb, n_, 16 * mb0 + 4 * kg, p0); ck_st(lds + pb, n_, 16 * mb0 + 16 + 4 * kg, p1); ck_st(lds + pbt, n_, 16 * mb0 + 4 * kg, q0); ck_st(lds + pbt, n_, 16 * mb0 + 16 + 4 * kg, q1); }
        __syncthreads();
        { f32x4 u0 = {}, u1 = {}; ck_mm2<2>(u0, u1, lds + pbt, mb0, lds + CK_TACC, nb, lane);
          const f32x4 o0 = h4_to_f4(*(const LAS u32x2*)(lds + CK_TACC + (n_ * CK_LDH + 16 * mb0 + 4 * kg) * 2)), o1 = h4_to_f4(*(const LAS u32x2*)(lds + CK_TACC + (n_ * CK_LDH + 16 * mb0 + 16 + 4 * kg) * 2));
          __syncthreads();
          ck_st(lds + CK_TACC, n_, 16 * mb0 + 4 * kg, u0 + o0); ck_st(lds + CK_TACC, n_, 16 * mb0 + 16 + 4 * kg, u1 + o1); }
    }
    __syncthreads();
    { f32x4 a0 = {}, a1 = {}, u0 = {}, u1 = {}; ck_mm2<2>(a0, a1, lds + CK_TACC, mb0, lds + CK_ATT, nb, lane); ck_mm2<2>(u0, u1, lds + CK_TACC, mb0, lds + CK_AN, nb, lane);
      ck_st(lds + CK_LAK, n_, 16 * mb0 + 4 * kg, a0); ck_st(lds + CK_LAK, n_, 16 * mb0 + 16 + 4 * kg, a1); ck_st(lds + CK_BN, n_, 16 * mb0 + 4 * kg, u0); ck_st(lds + CK_BN, n_, 16 * mb0 + 16 + 4 * kg, u1); }
    __syncthreads();
    constexpr int CK_ABT = CK_LAK, CK_UBT = CK_BN;
    { f32x4 r0 = {}, r1 = {}, y0 = {}, y1 = {}, g0 = {}, g1 = {}, h0 = {}, h1 = {};
      ck_mm2<2>(r0, r1, lds + CK_ABT, mb0, lds + CK_MRB, nb, lane);
      ck_mm2<2>(y0, y1, lds + CK_MRB, mb0, lds + CK_UBT, nb, lane); ck_mm2<2>(y0, y1, lds + CK_MRK, mb0, lds + CK_VT, nb, lane);
      ck_mm2<2>(g0, g1, lds + CK_ABT, mb0, lds + CK_BT, nb, lane);
      ck_mm2<2>(h0, h1, lds + CK_BT, mb0, lds + CK_UBT, nb, lane); ck_mm2<2>(h0, h1, lds + CK_KT, mb0, lds + CK_VT, nb, lane);
      const float dcn = sm[64 + n_];
#pragma unroll
      for (int mbi = 0; mbi < 2; ++mbi) { const int m_ = 16 * (mb0 + mbi) + 4 * kg; const f32x4 rr = mbi ? r1 : r0, yy = mbi ? y1 : y0, gg = mbi ? g1 : g0, hh = mbi ? h1 : h0;
          const f32x4 er = *(const LAS f32x4*)(sm + m_); const f32x4 rt = h4_to_f4(*(const LAS u32x2*)((const LAS h16*)(lds + CK_RT) + n_ * CK_LDH + m_));
          float o[4];
#pragma unroll
          for (int e = 0; e < 4; ++e) o[e] = (rt[e] + rr[e]) * er[e];
          *(u32x2*)(LW + tile + (size_t)n_ * RD + m_) = (u32x2){pkh(o[0], o[1]), pkh(o[2], o[3])};
          *(u32x2*)(AS + tile + (size_t)n_ * RD + m_) = (u32x2){pkh(yy[0], yy[1]), pkh(yy[2], yy[3])};
#pragma unroll
          for (int e = 0; e < 4; ++e) o[e] = dcn * (gg[e] + ((m_ + e) == n_ ? 1.0f : 0.0f)) * er[e];
          *(u32x2*)(R + tile + (size_t)n_ * RD + m_) = (u32x2){pkh(o[0], o[1]), pkh(o[2], o[3])};
          { const f32x4 dm = *(const LAS f32x4*)(sm + 64 + m_); *(u32x2*)(Kk + tile + (size_t)n_ * RD + m_) = (u32x2){pkh(dm[0] * hh[0], dm[1] * hh[1]), pkh(dm[2] * hh[2], dm[3] * hh[3])}; } } }
    __syncthreads();
}
__device__ __forceinline__ void phase_rwkv_chunks(Frame& F, int l) {
    for (int it = F.bid; it < BATCH * RH * (T / 64); it += F.G) rwkv_chunk_item(F, l, it >> 10, (it >> 7) & 7, it & 127);
}


constexpr int SQ_BUF = 2 * CK_MAT;
__device__ __forceinline__ h16x8 mk_frag(u32x2 lo, u32x2 hi) { const u32x4 v = {lo.x, lo.y, hi.x, hi.y}; return __builtin_bit_cast(h16x8, v); }
__device__ __forceinline__ void rwkv_seq_unit(Frame& F, int b, int h) {
    unsigned char* ws = F.ws; int tid = F.tid; asm volatile("" : "+v"(tid)); const int lane = tid & 63, w = F.wave; LAS unsigned char* lds = F.lds;
    const h16* Gm = (const h16*)(ws + WS_R); const h16* Hm = (const h16*)(ws + WS_K); h16* Sc = (h16*)(ws + (b == 0 ? WS_YRW0 : WS_YRW1));
    const size_t tile0 = (size_t)b * T * RD + h * 64, cstep = (size_t)64 * RD;
    constexpr int NC = T / 64;
    if (w >= 4) {
        const int lt = tid - 256; u32x4 r0[4], r1[4], r2[4], r3[4];
        size_t goff[4]; int loff[4];
#pragma unroll
        for (int j2 = 0; j2 < 4; ++j2) { const int p = lt + 256 * j2, q = p >> 9, row = (p >> 3) & 63, ch = p & 7; goff[j2] = (size_t)row * RD + 8 * ch + (q ? (size_t)((const char*)Hm - (const char*)Gm) / 2 : 0); loff[j2] = q * CK_MAT + (row * CK_LDH + 8 * ch) * 2; }
#define SQ_LD(R, cc) do { _Pragma("unroll") for (int j2 = 0; j2 < 4; ++j2) R[j2] = *(const u32x4*)(Gm + tile0 + (size_t)(cc) * cstep + goff[j2]); } while (0)
#define SQ_ST(R, cc) do { _Pragma("unroll") for (int j2 = 0; j2 < 4; ++j2) *(LAS u32x4*)(lds + ((cc) & 3) * SQ_BUF + loff[j2]) = R[j2]; } while (0)
        SQ_LD(r0, 0); SQ_LD(r1, 1); SQ_LD(r2, 2); SQ_ST(r0, 0); SQ_ST(r1, 1); SQ_ST(r2, 2);
        SQ_LD(r0, 3); SQ_LD(r1, 4); SQ_LD(r2, 5); SQ_LD(r3, 6);
        __syncthreads();
        for (int c = 0; c < NC; c += 4) {
            if (c + 3 < NC) SQ_ST(r0, c + 3); if (c + 7 < NC) SQ_LD(r0, c + 7); __syncthreads();
            if (c + 4 < NC) SQ_ST(r1, c + 4); if (c + 8 < NC) SQ_LD(r1, c + 8); __syncthreads();
            if (c + 5 < NC) SQ_ST(r2, c + 5); if (c + 9 < NC) SQ_LD(r2, c + 9); __syncthreads();
            if (c + 6 < NC) SQ_ST(r3, c + 6); if (c + 10 < NC) SQ_LD(r3, c + 10); __syncthreads();
        }
#undef SQ_LD
#undef SQ_ST
    } else {
        const int row = lane & 15, kg = lane >> 4; const size_t s0 = (size_t)(16 * w + row) * RD + h * 64;
        f32x4 ST[4] = {};
        __syncthreads();
        for (int c = 0; c < NC; ++c) {
            const LAS unsigned char* buf = lds + (c & 3) * SQ_BUF;
            u32x2 pk[4];
#pragma unroll
            for (int kb = 0; kb < 4; ++kb) { pk[kb] = (u32x2){pkh(ST[kb][0], ST[kb][1]), pkh(ST[kb][2], ST[kb][3])}; *(u32x2*)(Sc + s0 + (size_t)c * cstep + 16 * kb + 4 * kg) = pk[kb]; }
            const h16x8 sb0 = mk_frag(pk[0], pk[1]), sb1 = mk_frag(pk[2], pk[3]);
            f32x4 Sn[4];
#pragma unroll
            for (int blk = 0; blk < 4; ++blk) { const LAS unsigned char* gr = buf + ((16 * blk + row) * CK_LDH + 4 * kg) * 2;
                f32x4 acc = h4_to_f4(*(const LAS u32x2*)(buf + CK_MAT + ((16 * w + row) * CK_LDH + 16 * blk + 4 * kg) * 2));
                acc = __builtin_amdgcn_mfma_f32_16x16x32_f16(mk_frag(*(const LAS u32x2*)gr, *(const LAS u32x2*)(gr + 32)), sb0, acc, 0, 0, 0);
                acc = __builtin_amdgcn_mfma_f32_16x16x32_f16(mk_frag(*(const LAS u32x2*)(gr + 64), *(const LAS u32x2*)(gr + 96)), sb1, acc, 0, 0, 0); Sn[blk] = acc; }
#pragma unroll
            for (int blk = 0; blk < 4; ++blk) ST[blk] = Sn[blk];
            __syncthreads();
        }
    }
}
__device__ __forceinline__ void phase_rwkv_out(Frame& F, int l) {
    unsigned char* ws = F.ws; const Args& A = *F.a; const int lane = F.lane, row = lane & 15, kg = lane >> 4;
    const h16* RBm = (const h16*)(ws + WS_LW); const h16* YBm = (const h16*)(ws + WS_ASIG); const h16* V = (const h16*)(ws + WS_V); const h16* G = (const h16*)(ws + WS_G); const float* BS = (const float*)(ws + WS_BS); h16* YA = (h16*)(ws + WS_YAIN);
    const int gw = F.bid * NWAVES + F.wave, NGW = F.G * NWAVES;
    for (int task = gw; task < BATCH * RH * (T / 64) * 4; task += NGW) {
        const int mb = task & 3, c = (task >> 2) & 127, h = (task >> 9) & 7, b = task >> 12;
        const size_t m0 = (size_t)b * T + (size_t)c * 64; const size_t tile = m0 * RD + h * 64;
        const h16* Sc = (const h16*)(ws + (b == 0 ? WS_YRW0 : WS_YRW1)) + (size_t)c * 64 * RD + h * 64;
        const h16x8 a0 = *(const h16x8*)(RBm + tile + (size_t)(16 * mb + row) * RD + 8 * kg), a1 = *(const h16x8*)(RBm + tile + (size_t)(16 * mb + row) * RD + 32 + 8 * kg);
        f32x4 acc[4]; float sum[4] = {0.f, 0.f, 0.f, 0.f};
#pragma unroll
        for (int nb = 0; nb < 4; ++nb) { const h16x8 b0 = *(const h16x8*)(Sc + (size_t)(16 * nb + row) * RD + 8 * kg), b1 = *(const h16x8*)(Sc + (size_t)(16 * nb + row) * RD + 32 + 8 * kg);
            f32x4 ac = h4_to_f4(*(const u32x2*)(YBm + tile + (size_t)(16 * nb + row) * RD + 16 * mb + 4 * kg));
            ac = __builtin_amdgcn_mfma_f32_16x16x32_f16(a0, b0, ac, 0, 0, 0); ac = __builtin_amdgcn_mfma_f32_16x16x32_f16(a1, b1, ac, 0, 0, 0); acc[nb] = ac;
#pragma unroll
            for (int e = 0; e < 4; ++e) sum[e] += ac[e]; }
        float mean[4], rstd[4];
#pragma unroll
        for (int e = 0; e < 4; ++e) { mean[e] = red16(sum[e]) * (1.f / 64.f); float q = 0.f;
#pragma unroll
            for (int nb = 0; nb < 4; ++nb) { const float d = acc[nb][e] - mean[e]; q += d * d; }
            rstd[e] = 1.0f / sqrtf(red16(q) * (1.f / 64.f) + GN_EPS); }
#pragma unroll
        for (int nb = 0; nb < 4; ++nb) { const int ch = h * 64 + 16 * nb + row; const float gg = A.in[I_GNG][l * RD + ch], gb = A.in[I_GNB][l * RD + ch];
#pragma unroll
            for (int e = 0; e < 4; ++e) { const size_t m = m0 + 16 * mb + 4 * kg + e; const float vv = (float)V[m * RD + ch], gt = (float)G[m * RD + ch], bs = BS[m * 8 + h];
                YA[m * RD + ch] = (h16)(((acc[nb][e] - mean[e]) * rstd[e] * gg + gb + bs * vv) * gt); } }
    }
}

constexpr int AT_KB = 64 * 208, AT_VB = 8192, AT_K0 = 0, AT_V0 = 2 * AT_KB, AT_WS = AT_V0 + 2 * AT_VB, AT_TICKET = AT_WS + 8 * 256;
__device__ __forceinline__ int crow(int r, int hi) { return (r & 3) + 8 * (r >> 2) + 4 * hi; }
typedef short v4i16_t __attribute__((ext_vector_type(4)));
__device__ __forceinline__ h16x4 vtr(const LAS unsigned char* p) { return __builtin_bit_cast(h16x4, __builtin_amdgcn_ds_read_tr16_b64_v4i16((LAS v4i16_t*)p)); }
__device__ __forceinline__ void attn_unit(Frame& F, int b, int h, int qb) {
    unsigned char* ws = F.ws; const int tid = F.tid, lane = F.lane, wid = F.wave, r32 = lane & 31, hi = lane >> 5;
    const h16* Qc = (const h16*)(ws + WS_QC); const h16* Kc = (const h16*)(ws + WS_KC); const h16* Va = (const h16*)(ws + WS_VA); h16* O = (h16*)(ws + WS_OATT);
    LAS unsigned char* lds = F.lds; LAS float* wsf = (LAS float*)(lds + AT_WS + wid * 256);
    const size_t rowbase = (size_t)b * T; const int q0 = qb * 256;
    h16x8 qr[6];
    { const h16* Qw = Qc + (rowbase + q0 + wid * 32 + r32) * 768 + h * 96 + hi * 8;
#pragma unroll
        for (int d0 = 0; d0 < 6; ++d0) qr[d0] = *(const h16x8*)(Qw + d0 * 16); }
    const int kp0 = tid, kp1 = tid + 512; const int kk0 = kp0 / 12, kc0 = kp0 % 12, kk1 = kp1 / 12, kc1 = kp1 % 12; const bool has1 = kp1 < 768;
    const h16* ksrc0 = Kc + (rowbase + kk0) * 768 + h * 96 + 8 * kc0; const h16* ksrc1 = Kc + (rowbase + (has1 ? kk1 : 0)) * 768 + h * 96 + 8 * (has1 ? kc1 : 0);
    const int kdst0 = kk0 * 208 + kc0 * 16, kdst1 = kk1 * 208 + kc1 * 16;
    const int vk = tid >> 3, vc = tid & 7; const h16* vsrc = Va + (rowbase + vk) * 512 + h * 64 + 8 * vc;
    const int vdst = (vc >> 2) * 4096 + (vk >> 4) * 1024 + (vk & 15) * 64 + (vc & 3) * 16;
    const int NT = 4 * (qb + 1), my_last = 4 * qb + (wid >> 1);
    float m_run = -1e30f, l_run = 0.f; f32x16 o0 = {}, o1 = {};
    u32x4 kr0, kr1 = {0u, 0u, 0u, 0u}, vr;
    kr0 = *(const u32x4*)ksrc0; if (has1) kr1 = *(const u32x4*)ksrc1; vr = *(const u32x4*)vsrc;
    *(LAS u32x4*)(lds + AT_K0 + kdst0) = kr0; if (has1) *(LAS u32x4*)(lds + AT_K0 + kdst1) = kr1; *(LAS u32x4*)(lds + AT_V0 + vdst) = vr;
    __syncthreads();
    const int vfo = ((lane >> 4) & 1) * 32 + (lane & 3) * 8 + (4 * hi + ((lane & 15) >> 2)) * 64;
    for (int jt = 0; jt < NT; ++jt) {
        const bool more = jt + 1 < NT;
        if (more) { const size_t adv = (size_t)(jt + 1) * 64; kr0 = *(const u32x4*)(ksrc0 + adv * 768); if (has1) kr1 = *(const u32x4*)(ksrc1 + adv * 768); vr = *(const u32x4*)(vsrc + adv * 512); }
        if (jt <= my_last) {
            const LAS unsigned char* Kb = lds + AT_K0 + (jt & 1) * AT_KB; const LAS unsigned char* Vb = lds + AT_V0 + (jt & 1) * AT_VB;
            f32x16 p0 = {}, p1 = {};
#pragma unroll
            for (int d0 = 0; d0 < 6; ++d0) { const h16x8 k0 = *(const LAS h16x8*)(Kb + r32 * 208 + (2 * d0 + hi) * 16), k1 = *(const LAS h16x8*)(Kb + (32 + r32) * 208 + (2 * d0 + hi) * 16);
                p0 = __builtin_amdgcn_mfma_f32_32x32x16_f16(k0, qr[d0], p0, 0, 0, 0); p1 = __builtin_amdgcn_mfma_f32_32x32x16_f16(k1, qr[d0], p1, 0, 0, 0); }
            if (64 * jt + 63 > q0 + 32 * wid) { const int qpos = q0 + 32 * wid + r32, kb = 64 * jt + 4 * hi;
#pragma unroll
                for (int r = 0; r < 16; ++r) { const int kv = kb + (r & 3) + 8 * (r >> 2); if (kv > qpos) p0[r] = -INFINITY; if (kv + 32 > qpos) p1[r] = -INFINITY; } }
            float rm = fmaxf(p0[0], p1[0]);
#pragma unroll
            for (int r = 1; r < 16; ++r) rm = fmaxf(rm, fmaxf(p0[r], p1[r]));
            rm = fmaxf(rm, __shfl_xor(rm, 32));
            const float m_new = fmaxf(m_run, rm), alpha = __builtin_amdgcn_exp2f(m_run - m_new);
            const bool grow = __any(m_new > m_run);
            m_run = m_new;
            float sum = 0.f;
#pragma unroll
            for (int r = 0; r < 16; ++r) { p0[r] = __builtin_amdgcn_exp2f(p0[r] - m_new); p1[r] = __builtin_amdgcn_exp2f(p1[r] - m_new); sum += p0[r] + p1[r]; }
            l_run = l_run * alpha + sum;
            if (grow) { if (hi == 0) wsf[r32] = alpha; asm volatile("s_waitcnt lgkmcnt(0)" ::: "memory");
#pragma unroll
                for (int r = 0; r < 16; ++r) { const float f = wsf[crow(r, hi)]; o0[r] *= f; o1[r] *= f; } }
            h16x8 pa[4];
#pragma unroll
            for (int j = 0; j < 8; ++j) { pa[0][j] = (h16)p0[j]; pa[1][j] = (h16)p0[8 + j]; pa[2][j] = (h16)p1[j]; pa[3][j] = (h16)p1[8 + j]; }
#pragma unroll
            for (int ks = 0; ks < 4; ++ks) {
                const h16x4 a0 = vtr(Vb + vfo + ks * 1024), a1 = vtr(Vb + vfo + ks * 1024 + 512), c0 = vtr(Vb + vfo + 4096 + ks * 1024), c1 = vtr(Vb + vfo + 4096 + ks * 1024 + 512);
                const h16x8 v0 = {a0[0], a0[1], a0[2], a0[3], a1[0], a1[1], a1[2], a1[3]}, v1 = {c0[0], c0[1], c0[2], c0[3], c1[0], c1[1], c1[2], c1[3]};
                o0 = __builtin_amdgcn_mfma_f32_32x32x16_f16(pa[ks], v0, o0, 0, 0, 0); o1 = __builtin_amdgcn_mfma_f32_32x32x16_f16(pa[ks], v1, o1, 0, 0, 0); }
        }
        if (more) { LAS unsigned char* Kn = lds + AT_K0 + ((jt + 1) & 1) * AT_KB; LAS unsigned char* Vn = lds + AT_V0 + ((jt + 1) & 1) * AT_VB;
            *(LAS u32x4*)(Kn + kdst0) = kr0; if (has1) *(LAS u32x4*)(Kn + kdst1) = kr1; *(LAS u32x4*)(Vn + vdst) = vr; }
        __syncthreads();
    }
    l_run += __shfl_xor(l_run, 32);
    if (hi == 0) wsf[r32] = 1.0f / l_run;
    asm volatile("s_waitcnt lgkmcnt(0)" ::: "memory");
    h16* Ow = O + (rowbase + q0 + wid * 32) * 512 + h * 64 + r32;
#pragma unroll
    for (int r = 0; r < 16; ++r) { const int qr_ = crow(r, hi); const float f = wsf[qr_]; Ow[(size_t)qr_ * 512] = (h16)(o0[r] * f); Ow[(size_t)qr_ * 512 + 32] = (h16)(o1[r] * f); }
    __syncthreads();
}


#ifdef DBG_CHUNK
constexpr int CW_DBG = 2048;
__device__ __forceinline__ void dbg_max(Frame& F, float v) {
    v = fmaxf(v, 0.f);
#pragma unroll
    for (int o = 1; o < 64; o <<= 1) v = fmaxf(v, __shfl_xor(v, o));
    if (F.lane == 0) atomicMax((unsigned*)(F.ws + WS_CTL) + CW_DBG, __float_as_uint(v));
}
__device__ __forceinline__ void dbg_emit(Frame& F) {
    if (F.bid == 0 && F.tid == 0) { const float v = __uint_as_float(((unsigned*)(F.ws + WS_CTL))[CW_DBG]);
        int code = v > 1e-6f ? (int)(4.0f * log2f(v * 1e6f) + 0.5f) : 0; code = code > 89 ? 89 : code; F.a->out[0] = (float)((10 + code) * 1000); }
}
__device__ __forceinline__ void dbg_cmp_y(Frame& F) {
    float md = 0.f;
    for (size_t i = (size_t)F.bid * NTHREADS + F.tid; i < (size_t)M * RD; i += (size_t)F.G * NTHREADS) { const int m = (int)(i >> 9), t = m & (T - 1), c = (int)(i & 511);
        if (t >= DBG_TLO && t < DBG_THI) { const float a = (float)((const h16*)(F.ws + (m < T ? WS_YRW0 : WS_YRW1)))[(size_t)t * RD + c], b = (float)((const h16*)(F.ws + (m < T ? YREF0 : YREF1)))[(size_t)t * RD + c];
            md = fmaxf(md, fabsf(a - b) / (1.0f + fabsf(b))); } }
    dbg_max(F, md);
}
#endif

typedef GAS unsigned gu32;
#define XB_TMO      128
#define XB_XCNT(j)  (256  + 64 * (j))
#define XB_XSUB(j)  (1280 + 64 * (j))
#define XB_XGEN(j)  (2304 + 64 * (j))
#define XB_TOP      3328
#define XB_TOPGEN   3392
#define XCD_BAR_WORDS 3456
#define XB_SPIN_CAP (1u << 22)
__device__ __forceinline__ unsigned xb_ld(unsigned* p)              { return __hip_atomic_load(p, __ATOMIC_RELAXED, __HIP_MEMORY_SCOPE_AGENT); }
__device__ __forceinline__ unsigned xb_add(unsigned* p, unsigned v) { return __hip_atomic_fetch_add(p, v, __ATOMIC_RELAXED, __HIP_MEMORY_SCOPE_AGENT); }
__device__ __forceinline__ unsigned xb_xcc_id() { return (unsigned)__builtin_amdgcn_s_getreg((3 << 11) | 20) & 0xFu; }
#define XB_SPIN(cond, bar) do { unsigned _sp = 0; while (cond) { __builtin_amdgcn_s_sleep(1); \
    if ((++_sp & 255u) == 0u) { if (xb_ld(&(bar)[XB_TMO])) break; if (_sp > XB_SPIN_CAP) { atomicAdd(&(bar)[XB_TMO], 1u); break; } } } } while (0)
struct XcdBarrier { unsigned* bar; unsigned x; volatile LAS unsigned* st; };
__device__ __forceinline__ XcdBarrier xcd_barrier_post(unsigned* bar, volatile LAS unsigned* st) {
    XcdBarrier b; b.bar = bar; b.x = xb_xcc_id(); b.st = st;
    if (threadIdx.x == 0) (void)xb_add(&bar[XB_XCNT(b.x)], 1u);
    return b;
}
__device__ __forceinline__ void xcd_barrier_complete(unsigned* bar, unsigned x, unsigned& nloc, unsigned& nx) {
    const unsigned G = gridDim.x * gridDim.y * gridDim.z;
    unsigned sum, cnt, mine, sp = 0u;
    for (;;) {
        sum = 0u; cnt = 0u; mine = 0u;
#pragma unroll
        for (unsigned j = 0; j < 16; ++j) { const unsigned c = xb_ld(&bar[XB_XCNT(j)]); sum += c; cnt += (c > 0u) ? 1u : 0u; mine = (j == x) ? c : mine; }
        if (sum == G) break;
        __builtin_amdgcn_s_sleep(1);
        if ((++sp & 255u) == 0u) { if (xb_ld(&bar[XB_TMO])) break; if (sp > XB_SPIN_CAP) { atomicAdd(&bar[XB_TMO], 1u); break; } }
    }
    nloc = mine > 0u ? mine : 1u; nx = cnt > 0u ? cnt : 1u;
}
__device__ __forceinline__ void xcd_barrier(const XcdBarrier& b) {
    asm volatile("s_waitcnt vmcnt(0)" ::: "memory");
    __syncthreads();
    if (threadIdx.x == 0) {
        unsigned* bar = b.bar;
        __builtin_amdgcn_s_waitcnt(0);
        unsigned nloc = b.st[0], nx = b.st[1];
        if (nloc == 0u) { xcd_barrier_complete(bar, b.x, nloc, nx); b.st[0] = nloc; b.st[1] = nx; }
        const unsigned old = xb_add(&bar[XB_XSUB(b.x)], 1u);
        const unsigned gen = old / nloc;
        if (old + 1u == (gen + 1u) * nloc) {
            __builtin_amdgcn_fence(__ATOMIC_RELEASE, "agent");
            asm volatile("s_waitcnt vmcnt(0)" ::: "memory");
            const unsigned og = xb_add(&bar[XB_TOP], 1u);
            const unsigned tg = og / nx;
            if (og + 1u == (tg + 1u) * nx) xb_add(&bar[XB_TOPGEN], 1u);
            else XB_SPIN(xb_ld(&bar[XB_TOPGEN]) == tg, bar);
            __builtin_amdgcn_fence(__ATOMIC_ACQUIRE, "agent");
            xb_add(&bar[XB_XGEN(b.x)], 1u);
            asm volatile("s_waitcnt vmcnt(0)" ::: "memory");
        } else {
            XB_SPIN(xb_ld(&bar[XB_XGEN(b.x)]) == gen, bar);
            __builtin_amdgcn_fence(__ATOMIC_ACQUIRE, "agent");
            asm volatile("s_waitcnt vmcnt(0)" ::: "memory");
        }
    }
    __syncthreads();
}

constexpr int NPH = 1 + 13 * DEPTH;
__device__ __forceinline__ void run_phase(Frame& F, int ph) {
    { int w_ = F.wave, b_ = F.bid; asm volatile("" : "+v"(F.tid), "+v"(F.lane), "+v"(w_), "+v"(b_)); F.wave = __builtin_amdgcn_readfirstlane(w_); F.bid = __builtin_amdgcn_readfirstlane(b_); }
    unsigned char* ws = F.ws; const Args& A = *F.a; LAS unsigned char* lds = F.lds;
    if (ph == 0) { phase_convert(F, 0); rows_to_h16(F, A.in[I_X], (h16*)(ws + WS_XH)); rope_table(F); return; }
    const int l = (ph - 1) / 13, k = (ph - 1) % 13 + 1;
    const float* xres = (l == 0) ? A.in[I_X] : A.out;
    switch (k) {
    case 1: { pg8::Gemm g{(const h16*)(ws + WS_XH), (const h16*)(ws + WS_WIN), 1024, 1024, 1024}; pg8::StaticOrder S; S.init(M, 2816, F.G, F.bid);
        EpiStoreSplit E{(h16*)(ws + WS_PRWKV), (h16*)(ws + WS_PMLA), (h16*)(ws + WS_U)}; pg8::gemm_phase(lds, g, S, E);
        } break;
    case 2: phase_prep(F, l); phase_s5<1>(F, l); break;
    case 3: {
        { pg8::Gemm g{(const h16*)(ws + WS_ALORA), (const h16*)(ws + WS_WLORA), 256, 256, 256}; pg8::StaticOrder S; S.init(M, 1536, F.G, F.bid);
          EpiLora E{(h16*)(ws + WS_LW), A.in[I_W0] + l * RD, A.in[I_A0] + l * RD}; pg8::gemm_phase(lds, g, S, E); }
        { pg8::Gemm g{(const h16*)(ws + WS_PMLA), (const h16*)(ws + WS_WQ), 512, 256, 256}; pg8::StaticOrder S; S.init(M, 768, F.G, F.bid);
          EpiQ E{(h16*)(ws + WS_QC), (const float*)(ws + WS_RSTDQ), (const float*)(ws + WS_COS), (const float*)(ws + WS_SIN)}; pg8::gemm_phase(lds, g, S, E); }
        { pg8::Gemm g{(const h16*)(ws + WS_PMLA) + 256, (const h16*)(ws + WS_WKV), 512, 128, 128}; pg8::StaticOrder S; S.init(M, 1024, F.G, F.bid);
          EpiKV E{(h16*)(ws + WS_KC), (h16*)(ws + WS_VA), (const float*)(ws + WS_RSTDKV)}; pg8::gemm_phase(lds, g, S, E); }
    } break;
    case 4: phase_s5<2>(F, l); phase_rwkv_chunks(F, l); break;
    case 5: {
        if (F.rep != 1) for (int rw = F.bid; rw < 16; rw += F.G) rwkv_seq_unit(F, rw >> 3, rw & 7);
        if (F.rep == 2) break;
#ifdef DBG_CHUNK
        __syncthreads();
        if (F.bid >= 16) for (int rw = F.bid - 16; rw < 64; rw += F.G) rwkv_scan_unit(F, l, rw >> 5, (rw >> 2) & 7, rw & 3);
        break;
#endif
        unsigned* qh = (unsigned*)(ws + WS_CTL) + CW_QUEUE * (1 + l) + 16 * F.rep; LAS unsigned* tk = (LAS unsigned*)(lds + AT_TICKET);
        for (;;) {
            if (F.tid == 0) tk[0] = __hip_atomic_fetch_add(qh, 1u, __ATOMIC_RELAXED, __HIP_MEMORY_SCOPE_AGENT);
            __syncthreads(); const unsigned u = tk[0]; __syncthreads();
            if (u >= 512u) break;
            attn_unit(F, (int)(u & 15u) >> 3, (int)(u & 7u), 31 - (int)(u >> 4));
        }
    } break;
#ifdef DBG_CHUNK
    case 6: if (l == 0) dbg_cmp_y(F); phase_rwkv_post(F, l, xres); break;
#else
    case 6: phase_rwkv_out(F, l); rows_to_h16(F, xres, (h16*)(ws + WS_XH2)); break;
#endif
    case 7: { pg8::Gemm g{(const h16*)(ws + WS_XH2), (const h16*)(ws + WS_WG), 1024, 1024, 1024}; pg8::StaticOrder S; S.init(M, 3072, F.G, F.bid);
        EpiGate E{(h16*)(ws + WS_GATES0), A.in[I_GATEB] + l * 3072}; pg8::gemm_phase(lds, g, S, E);
        } break;
    case 8: { pg8::StaticOrder S; S.init(M, 1024, F.G, F.bid); h16* mg = (h16*)(ws + WS_MERGED);
        for (int i = 0;; ++i) { Unit u; if (!S.next(i, u)) break;
            pg8::ListOrder L1{u, u, 1}; pg8::ListOrder L2{Unit{u.pm, 2 * u.pn}, Unit{u.pm, 2 * u.pn + 1}, 2};
            { pg8::Gemm g{(const h16*)(ws + WS_YAIN), (const h16*)(ws + WS_WRO), 512, 512, 512}; EpiBranch<0> E{mg, (const h16*)(ws + WS_GATES0)}; pg8::gemm_phase(lds, g, L1, E); }
            { pg8::Gemm g{(const h16*)(ws + WS_OATT), (const h16*)(ws + WS_WMO), 512, 512, 512}; EpiBranch<1> E{mg, (const h16*)(ws + WS_GATES1)}; pg8::gemm_phase(lds, g, L1, E); }
            { pg8::Gemm g{(const h16*)(ws + WS_YS5), (const h16*)(ws + WS_WGLU), 512, 512, 512}; EpiBranch<2> E{mg, (const h16*)(ws + WS_GATES2)}; pg8::gemm_phase(lds, g, L2, E); } }
    } break;
    case 9: { pg8::Gemm g{(const h16*)(ws + WS_MERGED), (const h16*)(ws + WS_WO), 1024, 1024, 1024}; pg8::StaticOrder S; S.init(M, 1024, F.G, F.bid);
        EpiPre E{xres, (float*)(ws + WS_PRE)}; pg8::gemm_phase(lds, g, S, E); } break;
    case 10: phase_ln(F, (const float*)(ws + WS_PRE), A.in[I_LN1G] + l * D, A.in[I_LN1B] + l * D, A.out, (h16*)(ws + WS_X1H)); break;
    case 11: { pg8::Gemm g{(const h16*)(ws + WS_X1H), (const h16*)(ws + WS_W13), 1024, 1024, 1024}; pg8::StaticOrder S; S.init(M, 5632, F.G, F.bid);
        EpiSwiGLU E{(h16*)(ws + WS_HB)}; pg8::gemm_phase(lds, g, S, E); } break;
    case 12: { pg8::Gemm g{(const h16*)(ws + WS_HB), (const h16*)(ws + WS_W2), DFF, DFF, DFF}; pg8::StaticOrder S; S.init(M, 1024, F.G, F.bid);
        EpiPre E{A.out, (float*)(ws + WS_PRE2)}; pg8::gemm_phase(lds, g, S, E); } break;
    case 13: phase_ln(F, (const float*)(ws + WS_PRE2), A.in[I_LN2G] + l * D, A.in[I_LN2B] + l * D, A.out, (h16*)(ws + WS_XH)); if (l + 1 < DEPTH) phase_convert(F, l + 1); break;
#ifdef DBG_CHUNK
    case 14: break;
#endif
    }
}
__global__ void __launch_bounds__(NTHREADS, 2) fwd(Args args) {
    extern __shared__ __attribute__((aligned(16))) unsigned char lds_raw[];
    Frame F; F.lds = (LAS unsigned char*)lds_raw; F.tid = threadIdx.x; F.lane = F.tid & 63; F.wave = __builtin_amdgcn_readfirstlane(F.tid >> 6);
    F.G = gridDim.x; F.bid = blockIdx.x; F.ws = args.ws; F.a = &args; F.rep = 0;
    volatile LAS unsigned* MISC = (volatile LAS unsigned*)(F.lds + MISC_OFF);
    if (F.tid < 32) MISC[F.tid] = 0u;
    __syncthreads();
    XcdBarrier bar; bar.bar = (unsigned*)(args.ws + WS_CTL) + CW_BAR; bar.x = 0; bar.st = nullptr;
    if (args.one_launch) bar = xcd_barrier_post((unsigned*)(args.ws + WS_CTL) + CW_BAR, MISC + 8);
    for (int ph = args.ph_lo; ph < args.ph_hi; ++ph) {
        run_phase(F, ph);
#ifdef REPEAT_MASK
        if (ph > 0 && ((REPEAT_MASK >> ((ph - 1) % 13 + 1)) & 1)) { xcd_barrier(bar); F.rep = REPEAT_MODE; run_phase(F, ph); F.rep = 0; }
#endif
        if (ph + 1 < args.ph_hi) xcd_barrier(bar);
    }
#ifdef DBG_CHUNK
    xcd_barrier(bar); dbg_emit(F);
#endif
}

#ifndef MK_ONE_LAUNCH
#define MK_ONE_LAUNCH 1
#endif
extern "C" void kernel_launch(void* const* d_in, const int* in_sizes, int n_in, void* d_out, int out_size, void* d_ws, size_t ws_size, hipStream_t stream) {
    static int grid = 0;
    if (grid == 0) {
        if (n_in != 37 || out_size != M * D || ws_size < WS_END) { fprintf(stderr, "kernel_launch: unexpected shapes n_in %d out %d ws %zu\n", n_in, out_size, ws_size); grid = -1; return; }
        int dev = 0, cus = 0, per_cu = 0;
        if (hipGetDevice(&dev) != hipSuccess || hipDeviceGetAttribute(&cus, hipDeviceAttributeMultiprocessorCount, dev) != hipSuccess) { grid = -1; return; }
        if (hipFuncSetAttribute((const void*)fwd, hipFuncAttributeMaxDynamicSharedMemorySize, LDS_BYTES) != hipSuccess) { fprintf(stderr, "kernel_launch: hipFuncSetAttribute failed\n"); grid = -1; return; }
        if (hipOccupancyMaxActiveBlocksPerMultiprocessor(&per_cu, (const void*)fwd, NTHREADS, LDS_BYTES) != hipSuccess || per_cu < 1) { fprintf(stderr, "kernel_launch: occupancy query says %d\n", per_cu); (void)hipGetLastError(); grid = -1; return; }
        grid = cus;
    }
    if (grid < 0) return;
    (void)hipMemsetAsync((char*)d_ws + WS_CTL, 0, CTL_ZERO_BYTES, stream);
    Args a{};
    for (int i = 0; i < 37; ++i) a.in[i] = (const float*)d_in[i];
    a.out = (float*)d_out; a.ws = (unsigned char*)d_ws;
    for (int i = 0; i < 16; ++i) a.invfreq[i] = (float)pow(10000.0, -(double)i / 16.0);
    a.one_launch = MK_ONE_LAUNCH;
    if (MK_ONE_LAUNCH) { a.ph_lo = 0; a.ph_hi = NPH; hipLaunchKernelGGL(fwd, dim3(grid), dim3(NTHREADS), LDS_BYTES, stream, a); }
    else for (int ph = 0; ph < NPH; ++ph) { a.ph_lo = ph; a.ph_hi = ph + 1; hipLaunchKernelGGL(fwd, dim3(grid), dim3(NTHREADS), LDS_BYTES, stream, a);
    }
}
```

```cpp
#include <hip/hip_runtime.h>
#include <cstdio>
#include <cstdint>


#define LAS __attribute__((address_space(3)))
#define GAS __attribute__((address_space(1)))
typedef _Float16 h16;
typedef _Float16 h16x2 __attribute__((ext_vector_type(2)));
typedef _Float16 h16x4 __attribute__((ext_vector_type(4)));
typedef _Float16 h16x8 __attribute__((ext_vector_type(8)));
typedef float f32x2 __attribute__((ext_vector_type(2)));
typedef float f32x4 __attribute__((ext_vector_type(4)));
typedef float f32x16 __attribute__((ext_vector_type(16)));
typedef unsigned u32x2 __attribute__((ext_vector_type(2)));
typedef unsigned u32x4 __attribute__((ext_vector_type(4)));
typedef short s16x4 __attribute__((ext_vector_type(4)));

constexpr int BATCH = 2, T = 8192, D = 1024, M = BATCH * T, DEPTH = 2;
constexpr int RH = 8, RN = 64, RD = 512;
constexpr int RWKV_COLS = 1792, MLA_COLS = 416, IN_COLS = 5792, DFF = 2816;
constexpr int O_MLA = 1792, O_S5 = 2208, O_GATE = 2720;
constexpr float ALPHA = 1.4142135623730951f;
constexpr float LN_EPS = 1e-5f, RMS_EPS = 1e-6f, GN_EPS = 64e-5f;
constexpr float QSCALE = 0.10206207261596577f * 1.4426950408889634f;

__device__ __forceinline__ unsigned pkh(float lo, float hi) { h16x2 v = {(h16)lo, (h16)hi}; return __builtin_bit_cast(unsigned, v); }
__device__ __forceinline__ float sigm(float x) { return __builtin_amdgcn_rcpf(1.0f + __expf(-x)); }

namespace pg8 {
constexpr int BM = 256, BK = 64, HALF = 128, HTB = HALF * BK * 2, STAGE_BYTES = 8 * HTB, NXCD = 8, WGM = 8;
__host__ __device__ __forceinline__ int lds_byte(int r, int c) { const int st = (r >> 4) * 2 + (c >> 5), rr = r & 15, cc = c & 31, ob = rr * 64 + cc * 2; return st * 1024 + (ob ^ (((ob >> 9) & 1) << 5)); }
__host__ __device__ __forceinline__ void stage_rc(int b, int& R, int& C) { const int st = b / 1024, sb = b % 1024, swz = sb ^ (((sb >> 9) & 1) << 5); R = (st >> 1) * 16 + swz / 64; C = (st & 1) * 32 + (swz % 64) / 2; }
__host__ __device__ __forceinline__ int perm32(int rho) { const int n = rho >> 4, i = rho & 15; return 8 * (i >> 2) + 4 * n + (i & 3); }

struct Unit { int pm, pn; };
struct Gemm { const h16* A; const h16* Bt; int lda, ldb, K; };

struct StaticOrder {
    int nM, nN, nwg, G, c;
    __device__ __forceinline__ void init(int Mr, int N, int G_, int c_) { nM = Mr / BM; nN = N / BM; nwg = nM * nN; G = G_; c = c_; }
    __device__ __forceinline__ bool next(int i, Unit& u) const {
        const long L = (long)i * G + c; if (L >= nwg) return false;
        int wgid = (int)L; { const int q = nwg / NXCD, r = nwg % NXCD, xcd = wgid % NXCD, off = wgid / NXCD; wgid = (xcd < r ? xcd * (q + 1) : r * (q + 1) + (xcd - r) * q) + off; }
        const int nig = WGM * nN, gid = wgid / nig, fm = gid * WGM, gsz = (nM - fm) < WGM ? (nM - fm) : WGM;
        u.pm = fm + ((wgid % nig) % gsz); u.pn = (wgid % nig) / gsz; return true;
    }
};
struct ListOrder {
    Unit u0, u1; int n;
    __device__ __forceinline__ bool next(int i, Unit& u) const { if (i >= n) return false; u = (i == 0) ? u0 : u1; return true; }
};

template <class Epi, class Sched>
__device__ __forceinline__ void gemm_phase(LAS unsigned char* lds, const Gemm g, const Sched& S, const Epi& E) {
    int tid = threadIdx.x; asm volatile("" : "+v"(tid));
    const int wid = __builtin_amdgcn_readfirstlane(tid >> 6), lane = tid & 63, wr = wid >> 2, wc = wid & 3, fr = lane & 15, fq = lane >> 4;
    int K = g.K; asm volatile("" : "+s"(K)); const int nt = K / BK;
    unsigned voffA[2], voffB[2];
#pragma unroll
    for (int i = 0; i < 2; ++i) { int R, C; stage_rc(tid * 16 + i * 8192, R, C); const int Rb = Epi::PERM ? ((R & ~31) + perm32(R & 31)) : R;
        voffA[i] = (unsigned)(R * g.lda + C) * 2u; voffB[i] = (unsigned)(Rb * g.ldb + C) * 2u; }
    const size_t kstep = (size_t)(BK * 2);
    const size_t hstepA = (size_t)HALF * g.lda * 2, hstepB = (size_t)HALF * g.ldb * 2;
    const size_t tstepA = 2 * hstepA, tstepB = 2 * hstepB;
    const unsigned ldsw = (unsigned)wid * 1024u;
    const int aoff = lds_byte(wr * 64 + fr, fq * 8), boff = lds_byte(wc * 32 + fr, fq * 8);
#define PG8_SA(b, h) (((b) * 2 + (h)) * HTB)
#define PG8_SB(b, h) ((4 + (b) * 2 + (h)) * HTB)
#define PG8_STAGE(bufoff, gbase, voff) do { _Pragma("unroll") for (int _i = 0; _i < 2; ++_i) \
        __builtin_amdgcn_global_load_lds((const unsigned*)((const char*)(gbase) + (voff)[_i]), (LAS unsigned*)(lds + (bufoff) + ldsw + _i * 8192), 16, 0, 0); } while (0)
#define PG8_LDA(dst, b, h) do { _Pragma("unroll") for (int m = 0; m < 4; ++m) _Pragma("unroll") for (int k = 0; k < 2; ++k) dst[m][k] = *(const LAS h16x8*)(lds + PG8_SA(b, h) + aoff + m * 2048 + k * 1024); } while (0)
#define PG8_LDB(dst, b, h) do { _Pragma("unroll") for (int n = 0; n < 2; ++n) _Pragma("unroll") for (int k = 0; k < 2; ++k) dst[n][k] = *(const LAS h16x8*)(lds + PG8_SB(b, h) + boff + n * 2048 + k * 1024); } while (0)
#define PG8_MMA(ai, bj, At, Bt) do { __builtin_amdgcn_s_setprio(1); _Pragma("unroll") for (int m = 0; m < 4; ++m) _Pragma("unroll") for (int n = 0; n < 2; ++n) _Pragma("unroll") for (int k = 0; k < 2; ++k) \
        acc[ai][bj][m][n] = __builtin_amdgcn_mfma_f32_16x16x32_f16(Bt[n][k], At[m][k], acc[ai][bj][m][n], 0, 0, 0); __builtin_amdgcn_s_setprio(0); } while (0)
#define PG8_WAIT_V(n) asm volatile("s_waitcnt vmcnt(" #n ")" ::: "memory")
#define PG8_WAIT_L(n) asm volatile("s_waitcnt lgkmcnt(" #n ")" ::: "memory")
#define PG8_BAR __builtin_amdgcn_s_barrier()
#define PG8_SCHED __builtin_amdgcn_sched_barrier(0)
    Unit cur, nxt; int ui = 0;
    if (!S.next(0, cur)) return;
    f32x4 acc[2][2][4][2];
#pragma unroll
    for (int a = 0; a < 2; ++a)
#pragma unroll
        for (int b = 0; b < 2; ++b)
#pragma unroll
            for (int m = 0; m < 4; ++m)
#pragma unroll
                for (int n = 0; n < 2; ++n) acc[a][b][m][n] = (f32x4){0.f, 0.f, 0.f, 0.f};
    h16x8 At[4][2], B0[2][2], B1[2][2];
    const char* cA = (const char*)g.A + (size_t)cur.pm * tstepA; const char* cB = (const char*)g.Bt + (size_t)cur.pn * tstepB;
    {
        PG8_STAGE(PG8_SB(0, 0), cB, voffB); PG8_STAGE(PG8_SB(0, 1), cB + hstepB, voffB); PG8_STAGE(PG8_SA(0, 0), cA, voffA); PG8_STAGE(PG8_SA(0, 1), cA + hstepA, voffA);
        if (wr == 1) PG8_BAR;
        PG8_WAIT_V(2); PG8_BAR;
        PG8_STAGE(PG8_SB(1, 0), cB + kstep, voffB); PG8_STAGE(PG8_SA(1, 0), cA + kstep, voffA); PG8_STAGE(PG8_SB(1, 1), cB + hstepB + kstep, voffB);
        PG8_WAIT_V(6); PG8_BAR;
    }
    for (;;) {
        const bool has_next = S.next(ui + 1, nxt);
        const char* nA = has_next ? (const char*)g.A + (size_t)nxt.pm * tstepA : cA; const char* nB = has_next ? (const char*)g.Bt + (size_t)nxt.pn * tstepB : cB;
        for (int t = 0; t < nt; t += 2) {
            const bool last = (t == nt - 2);
            const char* a1 = cA + (size_t)(t + 1) * kstep;
            const char* a2 = last ? nA : cA + (size_t)(t + 2) * kstep; const char* b2 = last ? nB : cB + (size_t)(t + 2) * kstep;
            const char* a3 = a2 + kstep; const char* b3 = b2 + kstep;
            PG8_LDB(B0, 0, 0); PG8_LDB(B1, 0, 1); PG8_SCHED; PG8_LDA(At, 0, 0); PG8_STAGE(PG8_SA(1, 1), a1 + hstepA, voffA);
            PG8_WAIT_V(8); PG8_WAIT_L(0); PG8_BAR; PG8_MMA(0, 0, At, B0); PG8_MMA(0, 1, At, B1); PG8_BAR; PG8_SCHED;
            PG8_LDA(At, 0, 1); PG8_STAGE(PG8_SB(0, 0), b2, voffB); PG8_STAGE(PG8_SB(0, 1), b2 + hstepB, voffB); PG8_STAGE(PG8_SA(0, 0), a2, voffA);
            PG8_WAIT_V(8); PG8_WAIT_L(0); PG8_BAR; PG8_MMA(1, 0, At, B0); PG8_MMA(1, 1, At, B1); PG8_BAR; PG8_SCHED;
            PG8_LDB(B0, 1, 0); PG8_LDB(B1, 1, 1); PG8_SCHED; PG8_LDA(At, 1, 0); PG8_STAGE(PG8_SA(0, 1), a2 + hstepA, voffA);
            PG8_WAIT_V(8); PG8_WAIT_L(0); PG8_BAR; PG8_MMA(0, 0, At, B0); PG8_MMA(0, 1, At, B1); PG8_BAR; PG8_SCHED;
            PG8_LDA(At, 1, 1); PG8_STAGE(PG8_SB(1, 0), b3, voffB); PG8_STAGE(PG8_SB(1, 1), b3 + hstepB, voffB); PG8_STAGE(PG8_SA(1, 0), a3, voffA);
            PG8_WAIT_V(8); PG8_WAIT_L(0); PG8_BAR; PG8_MMA(1, 0, At, B0); PG8_MMA(1, 1, At, B1); PG8_BAR; PG8_SCHED;
        }
        if (wr == 0) PG8_BAR;
        { int fr_ = fr, fq_ = fq; asm volatile("" : "+v"(fr_), "+v"(fq_)); E(acc, cur, wr, wc, fr_, fq_); }
        if (!has_next) break;
#pragma unroll
        for (int a = 0; a < 2; ++a)
#pragma unroll
            for (int b = 0; b < 2; ++b)
#pragma unroll
                for (int m = 0; m < 4; ++m)
#pragma unroll
                    for (int n = 0; n < 2; ++n) acc[a][b][m][n] = (f32x4){0.f, 0.f, 0.f, 0.f};
        cur = nxt; cA = nA; cB = nB; ++ui;
        if (wr == 1) PG8_BAR;
    }
    PG8_WAIT_V(0);
    PG8_BAR;
#undef PG8_SA
#undef PG8_SB
#undef PG8_STAGE
#undef PG8_LDA
#undef PG8_LDB
#undef PG8_MMA
#undef PG8_WAIT_V
#undef PG8_WAIT_L
#undef PG8_BAR
#undef PG8_SCHED
}
}

using pg8::Unit; using pg8::HALF; using pg8::BM;
struct EpiStoreSplit {
    static constexpr bool PERM = true;
    h16* p_rwkv; h16* p_mla; h16* u;
    __device__ __forceinline__ void operator()(const f32x4 (&acc)[2][2][4][2], const Unit& un, int wr, int wc, int fr, int fq) const {
        h16* base; int ldc, colt;
        if (un.pn < 7) { base = p_rwkv; ldc = RWKV_COLS; colt = un.pn * BM; } else if (un.pn < 9) { base = p_mla; ldc = 512; colt = (un.pn - 7) * BM; } else { base = u; ldc = 512; colt = (un.pn - 9) * BM; }
        const int row0 = un.pm * BM + wr * 64 + fr, col0 = colt + wc * 32 + 8 * fq;
#pragma unroll
        for (int ai = 0; ai < 2; ++ai)
#pragma unroll
            for (int m = 0; m < 4; ++m) { h16* rowp = base + (size_t)(row0 + ai * HALF + m * 16) * ldc + col0;
#pragma unroll
                for (int bj = 0; bj < 2; ++bj) { const f32x4 v0 = acc[ai][bj][m][0], v1 = acc[ai][bj][m][1];
                    u32x4 w; w.x = pkh(v0[0], v0[1]); w.y = pkh(v0[2], v0[3]); w.z = pkh(v1[0], v1[1]); w.w = pkh(v1[2], v1[3]);
                    *(u32x4*)(rowp + bj * HALF) = w; } }
    }
};
struct EpiLora {
    static constexpr bool PERM = true;
    h16* lw; const float* w0; const float* a0;
    __device__ __forceinline__ void operator()(const f32x4 (&acc)[2][2][4][2], const Unit& un, int wr, int wc, int fr, int fq) const {
        const int kind = un.pn >> 1; h16* base = lw + (size_t)kind * (size_t)(8u << 20); const float* bias = kind == 0 ? w0 : a0;
        const int colt = (un.pn & 1) * BM; const int row0 = un.pm * BM + wr * 64 + fr, col0 = colt + wc * 32 + 8 * fq;
        f32x4 bv[2][2];
#pragma unroll
        for (int bj = 0; bj < 2; ++bj)
#pragma unroll
            for (int n = 0; n < 2; ++n) bv[bj][n] = kind < 2 ? *(const f32x4*)(bias + col0 + bj * HALF + 4 * n) : (f32x4){0.f, 0.f, 0.f, 0.f};
#pragma unroll
        for (int ai = 0; ai < 2; ++ai)
#pragma unroll
            for (int m = 0; m < 4; ++m) { h16* rowp = base + (size_t)(row0 + ai * HALF + m * 16) * RD + col0;
#pragma unroll
                for (int bj = 0; bj < 2; ++bj) { f32x4 v0 = acc[ai][bj][m][0] + bv[bj][0], v1 = acc[ai][bj][m][1] + bv[bj][1];
                    if (kind < 2) { const float sc = kind == 0 ? -0.6065306597126334f : 1.0f;
#pragma unroll
                        for (int e = 0; e < 4; ++e) { v0[e] = sc * sigm(v0[e]); v1[e] = sc * sigm(v1[e]); } }
                    u32x4 w; w.x = pkh(v0[0], v0[1]); w.y = pkh(v0[2], v0[3]); w.z = pkh(v1[0], v1[1]); w.w = pkh(v1[2], v1[3]);
                    *(u32x4*)(rowp + bj * HALF) = w; } }
    }
};
struct EpiQ {
    static constexpr bool PERM = false;
    h16* Qc; const float* rstd; const float* cosT; const float* sinT;
    __device__ __forceinline__ void operator()(const f32x4 (&acc)[2][2][4][2], const Unit& un, int wr, int wc, int fr, int fq) const {
        const int row0 = un.pm * BM + wr * 64 + fr;
#pragma unroll
        for (int ai = 0; ai < 2; ++ai)
#pragma unroll
            for (int m = 0; m < 4; ++m) { const int row = row0 + ai * HALF + m * 16; const float rs = rstd[row] * QSCALE; const int pos = row & (T - 1);
                const f32x4 cs = *(const f32x4*)(cosT + pos * 16 + 4 * fq), sn = *(const f32x4*)(sinT + pos * 16 + 4 * fq);
#pragma unroll
                for (int bj = 0; bj < 2; ++bj) { const int cb = un.pn * 8 + bj * 4 + wc;
                    f32x4 v0 = acc[ai][bj][m][0] * rs, v1 = acc[ai][bj][m][1] * rs;
                    if (cb % 3 == 2) { const f32x4 a = v0, b = v1; v0 = a * cs - b * sn; v1 = b * cs + a * sn; }
                    h16* p = Qc + (size_t)row * 768 + cb * 32 + 4 * fq;
                    u32x2 w0; w0.x = pkh(v0[0], v0[1]); w0.y = pkh(v0[2], v0[3]); *(u32x2*)p = w0;
                    u32x2 w1; w1.x = pkh(v1[0], v1[1]); w1.y = pkh(v1[2], v1[3]); *(u32x2*)(p + 16) = w1; } }
    }
};
struct EpiKV {
    static constexpr bool PERM = true;
    h16* Kc; h16* Va; const float* rstd;
    __device__ __forceinline__ void operator()(const f32x4 (&acc)[2][2][4][2], const Unit& un, int wr, int wc, int fr, int fq) const {
        const int row0 = un.pm * BM + wr * 64 + fr;
#pragma unroll
        for (int ai = 0; ai < 2; ++ai)
#pragma unroll
            for (int m = 0; m < 4; ++m) { const int row = row0 + ai * HALF + m * 16; const float rs = rstd[row];
#pragma unroll
                for (int bj = 0; bj < 2; ++bj) { const int c = un.pn * BM + bj * HALF + wc * 32 + 8 * fq, h = c >> 7, w = c & 127;
                    const f32x4 v0 = acc[ai][bj][m][0] * rs, v1 = acc[ai][bj][m][1] * rs;
                    u32x4 o; o.x = pkh(v0[0], v0[1]); o.y = pkh(v0[2], v0[3]); o.z = pkh(v1[0], v1[1]); o.w = pkh(v1[2], v1[3]);
                    h16* p = (w < 64) ? Kc + (size_t)row * 768 + h * 96 + w : Va + (size_t)row * 512 + h * 64 + (w - 64);
                    *(u32x4*)p = o; } }
    }
};
struct EpiGate {
    static constexpr bool PERM = true;
    h16* g0; const float* gb;
    __device__ __forceinline__ void operator()(const f32x4 (&acc)[2][2][4][2], const Unit& un, int wr, int wc, int fr, int fq) const {
        const int row0 = un.pm * BM + wr * 64 + fr, col0 = un.pn * BM + wc * 32 + 8 * fq; const int br = un.pn >> 2; h16* gbase = g0 + (size_t)(4 * br + 8 * (br >> 1)) * (size_t)(4u << 20);
        f32x4 bv[2][2];
#pragma unroll
        for (int bj = 0; bj < 2; ++bj)
#pragma unroll
            for (int n = 0; n < 2; ++n) bv[bj][n] = *(const f32x4*)(gb + col0 + bj * HALF + 4 * n);
#pragma unroll
        for (int ai = 0; ai < 2; ++ai)
#pragma unroll
            for (int m = 0; m < 4; ++m) { h16* rowp = gbase + (size_t)(row0 + ai * HALF + m * 16) * 1024 + (col0 & 1023);
#pragma unroll
                for (int bj = 0; bj < 2; ++bj) { f32x4 v0 = acc[ai][bj][m][0] + bv[bj][0], v1 = acc[ai][bj][m][1] + bv[bj][1];
#pragma unroll
                    for (int e = 0; e < 4; ++e) { v0[e] = sigm(v0[e]); v1[e] = sigm(v1[e]); }
                    u32x4 w; w.x = pkh(v0[0], v0[1]); w.y = pkh(v0[2], v0[3]); w.z = pkh(v1[0], v1[1]); w.w = pkh(v1[2], v1[3]);
                    *(u32x4*)(rowp + bj * HALF) = w; } }
    }
};
__device__ __forceinline__ void unpk8(const u32x4 w, float (&o)[8]) {
    const unsigned a0 = w.x, a1 = w.y, a2 = w.z, a3 = w.w;
    const h16x2 h0 = __builtin_bit_cast(h16x2, a0), h1 = __builtin_bit_cast(h16x2, a1), h2 = __builtin_bit_cast(h16x2, a2), h3 = __builtin_bit_cast(h16x2, a3);
    o[0] = (float)h0[0]; o[1] = (float)h0[1]; o[2] = (float)h1[0]; o[3] = (float)h1[1]; o[4] = (float)h2[0]; o[5] = (float)h2[1]; o[6] = (float)h3[0]; o[7] = (float)h3[1];
}
__device__ __forceinline__ f32x4 h4_to_f4(u32x2 q) { const unsigned q0 = q.x, q1 = q.y; const h16x2 a = __builtin_bit_cast(h16x2, q0), b = __builtin_bit_cast(h16x2, q1); return (f32x4){(float)a[0], (float)a[1], (float)b[0], (float)b[1]}; }
template <int KIND> struct EpiBranch {
    static constexpr bool PERM = true;
    h16* merged; const h16* gates;
    __device__ __forceinline__ void operator()(const f32x4 (&acc)[2][2][4][2], const Unit& un, int wr, int wc, int fr, int fq) const {
        const int row0 = un.pm * BM + wr * 64 + fr;
#pragma unroll
        for (int ai = 0; ai < 2; ++ai)
#pragma unroll
            for (int m = 0; m < 4; ++m) { const int row = row0 + ai * HALF + m * 16;
#pragma unroll
                for (int bj = 0; bj < (KIND == 2 ? 1 : 2); ++bj) {
                    const int col = (KIND == 2 ? un.pn * HALF : un.pn * BM + bj * HALF) + wc * 32 + 8 * fq;
                    float v[8];
                    if (KIND == 2) { const f32x4 a0 = acc[ai][0][m][0], a1 = acc[ai][0][m][1], b0 = acc[ai][1][m][0], b1 = acc[ai][1][m][1];
#pragma unroll
                        for (int e = 0; e < 4; ++e) { v[e] = a0[e] * sigm(b0[e]); v[4 + e] = a1[e] * sigm(b1[e]); } }
                    else { const f32x4 a0 = acc[ai][bj][m][0], a1 = acc[ai][bj][m][1];
#pragma unroll
                        for (int e = 0; e < 4; ++e) { v[e] = a0[e]; v[4 + e] = a1[e]; } }
                    float gt[8]; unpk8(*(const u32x4*)(gates + (size_t)row * 1024 + col), gt);
                    h16* mp = merged + (size_t)row * 1024 + col;
                    if (KIND != 0) { float old[8]; unpk8(*(const u32x4*)mp, old);
#pragma unroll
                        for (int e = 0; e < 8; ++e) v[e] = old[e] + gt[e] * v[e]; }
                    else {
#pragma unroll
                        for (int e = 0; e < 8; ++e) v[e] = gt[e] * v[e]; }
                    u32x4 w; w.x = pkh(v[0], v[1]); w.y = pkh(v[2], v[3]); w.z = pkh(v[4], v[5]); w.w = pkh(v[6], v[7]);
                    *(u32x4*)mp = w; } }
    }
};
struct EpiPre {
    static constexpr bool PERM = false;
    const float* xres; float* pre;
    __device__ __forceinline__ void operator()(const f32x4 (&acc)[2][2][4][2], const Unit& un, int wr, int wc, int fr, int fq) const {
        const int row0 = un.pm * BM + wr * 64 + fr, col0 = un.pn * BM + wc * 32 + 4 * fq;
#pragma unroll
        for (int ai = 0; ai < 2; ++ai)
#pragma unroll
            for (int m = 0; m < 4; ++m) { const size_t off = (size_t)(row0 + ai * HALF + m * 16) * D + col0;
#pragma unroll
                for (int bj = 0; bj < 2; ++bj)
#pragma unroll
                    for (int n = 0; n < 2; ++n) { const f32x4 xr = *(const f32x4*)(xres + off + bj * HALF + n * 16);
                        *(f32x4*)(pre + off + bj * HALF + n * 16) = xr * ALPHA + acc[ai][bj][m][n]; } }
    }
};
struct EpiSwiGLU {
    static constexpr bool PERM = true;
    h16* hb;
    __device__ __forceinline__ void operator()(const f32x4 (&acc)[2][2][4][2], const Unit& un, int wr, int wc, int fr, int fq) const {
        const int row0 = un.pm * BM + wr * 64 + fr, col0 = un.pn * HALF + wc * 32 + 8 * fq;
#pragma unroll
        for (int ai = 0; ai < 2; ++ai)
#pragma unroll
            for (int m = 0; m < 4; ++m) { const f32x4 a0 = acc[ai][0][m][0], a1 = acc[ai][0][m][1], b0 = acc[ai][1][m][0], b1 = acc[ai][1][m][1]; float v[8];
#pragma unroll
                for (int e = 0; e < 4; ++e) { v[e] = a0[e] * sigm(a0[e]) * b0[e]; v[4 + e] = a1[e] * sigm(a1[e]) * b1[e]; }
                u32x4 w; w.x = pkh(v[0], v[1]); w.y = pkh(v[2], v[3]); w.z = pkh(v[4], v[5]); w.w = pkh(v[6], v[7]);
                *(u32x4*)(hb + (size_t)(row0 + ai * HALF + m * 16) * DFF + col0) = w; }
    }
};

constexpr size_t MiB = 1u << 20;
constexpr size_t WS_CTL = 0, CTL_ZERO_BYTES = 1 * MiB;
constexpr size_t WS_COS = 1 * MiB, WS_SIN = 1 * MiB + 512 * 1024;
constexpr size_t WS_RSTDQ = 2 * MiB, WS_RSTDKV = 2 * MiB + 64 * 1024;
constexpr size_t WS_BS = 3 * MiB + 512 * 1024;
constexpr size_t WS_S5END = 2 * MiB + 512 * 1024;
constexpr size_t WS_WIN = 4 * MiB;
constexpr size_t WS_WG = WS_WIN + 5632 * 1024;
constexpr size_t WS_WLORA = WS_WG + 6 * MiB;
constexpr size_t WS_WQ = WS_WLORA + 768 * 1024;
constexpr size_t WS_WKV = WS_WQ + 384 * 1024;
constexpr size_t WS_WRO = WS_WKV + 256 * 1024;
constexpr size_t WS_WMO = WS_WRO + 1 * MiB;
constexpr size_t WS_WGLU = WS_WMO + 1 * MiB;
constexpr size_t WS_WO = WS_WGLU + 2 * MiB;
constexpr size_t WS_W13 = WS_WO + 2 * MiB;
constexpr size_t WS_W2 = WS_W13 + 11 * MiB;
static_assert(WS_W2 + 5632 * 1024 <= 40 * MiB, "weights region");
constexpr size_t SLOT0 = 40 * MiB, SLOT = 8 * MiB;
#define WS_SLOT(s) (SLOT0 + (size_t)(s) * SLOT)
constexpr size_t WS_XH = WS_SLOT(0), WS_PRWKV = WS_SLOT(4), WS_PMLA = WS_SLOT(11), WS_U = WS_SLOT(13);
constexpr size_t WS_KC = WS_SLOT(1), WS_ALORA = WS_SLOT(0), WS_R = WS_SLOT(15), WS_K = WS_SLOT(17), WS_V = WS_SLOT(19);
constexpr size_t WS_LW = WS_SLOT(5), WS_ASIG = WS_SLOT(7), WS_G = WS_SLOT(9), WS_QC = WS_SLOT(21), WS_VA = WS_SLOT(24);
constexpr size_t WS_YS5 = WS_SLOT(11), WS_OATT = WS_SLOT(13), WS_YRW0 = WS_SLOT(0), WS_YRW1 = WS_SLOT(26);
constexpr size_t WS_XH2 = WS_SLOT(15), WS_YAIN = WS_SLOT(1), WS_GATES0 = WS_SLOT(3), WS_GATES1 = WS_SLOT(7), WS_GATES2 = WS_SLOT(19), WS_MERGED = WS_SLOT(23);
constexpr size_t WS_PRE = WS_SLOT(11), WS_X1H = WS_SLOT(0), WS_HB = WS_SLOT(4), WS_PRE2 = WS_SLOT(15);
constexpr size_t WS_END = WS_SLOT(27);
static_assert(WS_GATES1 == WS_GATES0 + 4 * SLOT && WS_GATES2 == WS_GATES0 + 16 * SLOT, "EpiGate strides");
static_assert(WS_ASIG == WS_LW + 16 * MiB && WS_G == WS_LW + 32 * MiB, "EpiLora strides");
static_assert(WS_END == 256 * MiB, "ws map");
constexpr int CW_BAR = 4096;
constexpr int CW_QUEUE = 64;

constexpr int LDS_BYTES = 147456;
constexpr int MISC_OFF = 131072 + 320;
constexpr int NWAVES = 8, NTHREADS = 512;

struct Args {
    const float* in[37]; float* out; unsigned char* ws; float invfreq[16]; int ph_lo, ph_hi; int one_launch, pad;
};
enum { I_X = 0, I_WIN, I_MU, I_W0, I_W2, I_A0, I_A2, I_G2, I_KK, I_KA, I_RK, I_GNG, I_GNB, I_ROUT, I_QNORM, I_QUP, I_KVNORM, I_KVUP, I_MOUT,
       I_LRE, I_LIM, I_LSTEP, I_BRE, I_BIM, I_CRE, I_CIM, I_S5D, I_GLU, I_GATEB, I_WOUT, I_LN1G, I_LN1B, I_W1, I_W3, I_FW2, I_LN2G, I_LN2B };

struct Frame {
    LAS unsigned char* lds; int tid, lane, wave, G, bid; unsigned char* ws; const Args* a; int rep;
};
__device__ __forceinline__ float wave_sum(float v) {
#pragma unroll
    for (int o = 1; o < 64; o <<= 1) v += __shfl_xor(v, o);
    return v;
}

__device__ __forceinline__ void cvt_item(const float* src, int ldsrc, int k0, int n0, h16* dst, int lddst, int drow0, int dk0, const float* kscale, LAS float* scr, int lane) {
    if (src) {
#pragma unroll 8
        for (int i = 0; i < 32; ++i) { const int kk = 2 * i + (lane >> 5); float v = src[(size_t)(k0 + kk) * ldsrc + n0 + (lane & 31)]; if (kscale) v *= kscale[k0 + kk]; scr[kk * 33 + (lane & 31)] = v; }
    }
    asm volatile("s_waitcnt lgkmcnt(0)" ::: "memory");
    const int c = lane & 7;
#pragma unroll
    for (int j = 0; j < 4; ++j) { const int n = (lane >> 3) + 8 * j; const LAS float* s = scr + (8 * c) * 33 + n;
        u32x4 o = {0u, 0u, 0u, 0u};
        if (src) { o.x = pkh(s[0 * 33], s[1 * 33]); o.y = pkh(s[2 * 33], s[3 * 33]); o.z = pkh(s[4 * 33], s[5 * 33]); o.w = pkh(s[6 * 33], s[7 * 33]); }
        *(u32x4*)(dst + (size_t)(drow0 + n) * lddst + dk0 + 8 * c) = o; }
    asm volatile("s_waitcnt lgkmcnt(0)" ::: "memory");
}
__device__ __forceinline__ void phase_convert(Frame& F, int l) {
    LAS float* scr = (LAS float*)(F.lds + F.wave * 16384);
    const int gw = F.bid * NWAVES + F.wave, NGW = F.G * NWAVES; unsigned char* ws = F.ws; const Args& A = *F.a;
    const float* win = A.in[I_WIN] + (size_t)l * D * IN_COLS;
    constexpr int N_WIN = 16 * 88, N_WG = 16 * 96, N_LORA = 4 * 48, N_Q = 4 * 24, N_KV = 2 * 32, N_RO = 8 * 32, N_MO = 8 * 32, N_GLU = 8 * 64, N_O = 16 * 32, N_13 = 16 * 176, N_2 = 44 * 32;
    constexpr int NITEMS = N_WIN + N_WG + N_LORA + N_Q + N_KV + N_RO + N_MO + N_GLU + N_O + N_13 + N_2;
    for (int it = gw; it < NITEMS; it += NGW) {
        int r = it;
        if (r < N_WIN) { const int kb = r / 88, db = r % 88;
            int sc; if (db < 56) sc = 32 * db; else if (db < 69) sc = O_MLA + 32 * (db - 56); else if (db < 72) sc = -1; else sc = O_S5 + 32 * (db - 72);
            cvt_item(sc >= 0 ? win : nullptr, IN_COLS, 64 * kb, sc, (h16*)(ws + WS_WIN), 1024, 32 * db, 64 * kb, nullptr, scr, F.lane); continue; } r -= N_WIN;
        if (r < N_WG) { const int kb = r / 96, db = r % 96;
            cvt_item(win, IN_COLS, 64 * kb, O_GATE + 32 * db, (h16*)(ws + WS_WG), 1024, 32 * db, 64 * kb, nullptr, scr, F.lane); continue; } r -= N_WG;
        if (r < N_LORA) { const int kb = r / 48, db = r % 48; const float* s = nullptr; int k0 = 0, n0 = 0;
            if (db < 16) { if (kb == 0) { s = A.in[I_W2] + (size_t)l * 64 * 512; k0 = 0; n0 = 32 * db; } }
            else if (db < 32) { if (kb == 1) { s = A.in[I_A2] + (size_t)l * 64 * 512; k0 = 0; n0 = 32 * (db - 16); } }
            else { if (kb >= 2) { s = A.in[I_G2] + (size_t)l * 128 * 512; k0 = 64 * (kb - 2); n0 = 32 * (db - 32); } }
            cvt_item(s, 512, k0, n0, (h16*)(ws + WS_WLORA), 256, 32 * db, 64 * kb, nullptr, scr, F.lane); continue; } r -= N_LORA;
        if (r < N_Q) { const int kb = r / 24, db = r % 24;
            cvt_item(A.in[I_QUP] + (size_t)l * 256 * 768, 768, 64 * kb, 32 * db, (h16*)(ws + WS_WQ), 256, 32 * db, 64 * kb, A.in[I_QNORM] + l * 256, scr, F.lane); continue; } r -= N_Q;
        if (r < N_KV) { const int kb = r / 32, db = r % 32;
            cvt_item(A.in[I_KVUP] + (size_t)l * 128 * 1024, 1024, 64 * kb, 32 * db, (h16*)(ws + WS_WKV), 128, 32 * db, 64 * kb, A.in[I_KVNORM] + l * 128, scr, F.lane); continue; } r -= N_KV;
        if (r < N_RO) { const int kb = r / 32, db = r % 32;
            cvt_item(A.in[I_ROUT] + (size_t)l * 512 * 1024, 1024, 64 * kb, 32 * db, (h16*)(ws + WS_WRO), 512, 32 * db, 64 * kb, nullptr, scr, F.lane); continue; } r -= N_RO;
        if (r < N_MO) { const int kb = r / 32, db = r % 32;
            cvt_item(A.in[I_MOUT] + (size_t)l * 512 * 1024, 1024, 64 * kb, 32 * db, (h16*)(ws + WS_WMO), 512, 32 * db, 64 * kb, nullptr, scr, F.lane); continue; } r -= N_MO;
        if (r < N_GLU) { const int kb = r / 64, db = r % 64, t = db >> 3, w = db & 7; const int sc = (w < 4) ? 128 * t + 32 * w : 1024 + 128 * t + 32 * (w - 4);
            cvt_item(A.in[I_GLU] + (size_t)l * 512 * 2048, 2048, 64 * kb, sc, (h16*)(ws + WS_WGLU), 512, 32 * db, 64 * kb, nullptr, scr, F.lane); continue; } r -= N_GLU;
        if (r < N_O) { const int kb = r / 32, db = r % 32;
            cvt_item(A.in[I_WOUT] + (size_t)l * 1024 * 1024, 1024, 64 * kb, 32 * db, (h16*)(ws + WS_WO), 1024, 32 * db, 64 * kb, nullptr, scr, F.lane); continue; } r -= N_O;
        if (r < N_13) { const int kb = r / 176, db = r % 176, t = db >> 3, w = db & 7; const float* s = (w < 4 ? A.in[I_W1] : A.in[I_W3]) + (size_t)l * 1024 * DFF;
            cvt_item(s, DFF, 64 * kb, 128 * t + 32 * (w & 3), (h16*)(ws + WS_W13), 1024, 32 * db, 64 * kb, nullptr, scr, F.lane); continue; } r -= N_13;
        { const int kb = r / 32, db = r % 32;
            cvt_item(A.in[I_FW2] + (size_t)l * DFF * 1024, 1024, 64 * kb, 32 * db, (h16*)(ws + WS_W2), DFF, 32 * db, 64 * kb, nullptr, scr, F.lane); }
    }
}
__device__ __forceinline__ void rows_to_h16(Frame& F, const float* x, h16* xh) {
    const int gw = F.bid * NWAVES + F.wave, NGW = F.G * NWAVES;
    for (int m = gw; m < M; m += NGW) { const f32x4* xr = (const f32x4*)(x + (size_t)m * D) + F.lane; u32x2* o = (u32x2*)(xh + (size_t)m * D) + F.lane;
#pragma unroll
        for (int j = 0; j < 4; ++j) { const f32x4 v = xr[64 * j]; u32x2 w; w.x = pkh(v.x, v.y); w.y = pkh(v.z, v.w); o[64 * j] = w; } }
}
__device__ __forceinline__ void rope_table(Frame& F) {
    float* cosT = (float*)(F.ws + WS_COS); float* sinT = (float*)(F.ws + WS_SIN);
    for (int i = F.bid * NTHREADS + F.tid; i < T * 16; i += F.G * NTHREADS) { const int pos = i >> 4, f = i & 15; const float ang = (float)pos * exp2f(-(float)f * 0.8304820237218406f); float s, c; sincosf(ang, &s, &c); cosT[i] = c; sinT[i] = s; }
}
__device__ __forceinline__ void phase_ln(Frame& F, const float* pre, const float* g, const float* b, float* xo, h16* xoh) {
    const int gw = F.bid * NWAVES + F.wave, NGW = F.G * NWAVES;
    f32x4 gv[4], bv[4];
#pragma unroll
    for (int j = 0; j < 4; ++j) { gv[j] = ((const f32x4*)g)[F.lane + 64 * j]; bv[j] = ((const f32x4*)b)[F.lane + 64 * j]; }
    for (int m = gw; m < M; m += NGW) {
        const f32x4* xr = (const f32x4*)(pre + (size_t)m * D) + F.lane; f32x4 v[4]; float s = 0.f;
#pragma unroll
        for (int j = 0; j < 4; ++j) { v[j] = xr[64 * j]; s += (v[j].x + v[j].y) + (v[j].z + v[j].w); }
        const float mean = wave_sum(s) * (1.f / D); float s2 = 0.f;
#pragma unroll
        for (int j = 0; j < 4; ++j) { v[j] = v[j] - mean; s2 += (v[j].x * v[j].x + v[j].y * v[j].y) + (v[j].z * v[j].z + v[j].w * v[j].w); }
        const float rstd = 1.f / sqrtf(wave_sum(s2) * (1.f / D) + LN_EPS);
        f32x4* o = (f32x4*)(xo + (size_t)m * D) + F.lane; u32x2* oh = (u32x2*)(xoh + (size_t)m * D) + F.lane;
#pragma unroll
        for (int j = 0; j < 4; ++j) { const f32x4 y = v[j] * rstd * gv[j] + bv[j]; o[64 * j] = y; u32x2 w; w.x = pkh(y.x, y.y); w.y = pkh(y.z, y.w); oh[64 * j] = w; }
    }
}

__device__ __forceinline__ void ld8(const h16* p, float (&o)[8]) { unpk8(*(const u32x4*)p, o); }
__device__ __forceinline__ void ld8(const LAS h16* p, float (&o)[8]) { unpk8(*(const LAS u32x4*)p, o); }
__device__ __forceinline__ void st8(LAS h16* p, const float (&v)[8]) { u32x4 w; w.x = pkh(v[0], v[1]); w.y = pkh(v[2], v[3]); w.z = pkh(v[4], v[5]); w.w = pkh(v[6], v[7]); *(LAS u32x4*)p = w; }
__device__ __forceinline__ void st8(h16* p, const float (&v)[8]) { u32x4 w; w.x = pkh(v[0], v[1]); w.y = pkh(v[2], v[3]); w.z = pkh(v[4], v[5]); w.w = pkh(v[6], v[7]); *(u32x4*)p = w; }
__device__ __forceinline__ void phase_prep(Frame& F, int l) {
    const int gw = F.bid * NWAVES + F.wave, NGW = F.G * NWAVES; unsigned char* ws = F.ws; const Args& A = *F.a; const int lane = F.lane;
    const h16* P = (const h16*)(ws + WS_PRWKV); const float* mu = A.in[I_MU] + l * RWKV_COLS;
    h16* R = (h16*)(ws + WS_R); h16* Kk = (h16*)(ws + WS_K); h16* V = (h16*)(ws + WS_V); h16* AL = (h16*)(ws + WS_ALORA);
    const h16* PM = (const h16*)(ws + WS_PMLA); h16* Kc = (h16*)(ws + WS_KC); float* rq = (float*)(ws + WS_RSTDQ); float* rkv = (float*)(ws + WS_RSTDKV);
    const float* cosT = (const float*)(ws + WS_COS); const float* sinT = (const float*)(ws + WS_SIN);
    for (int m = gw; m < M; m += NGW) {
        const int t = m & (T - 1);
#pragma unroll
        for (int j = 0; j < 4; ++j) { const int ch = lane + 64 * j;
            if (ch < 224) { const int c = 8 * ch; float p[8], q[8], o[8];
                ld8(P + (size_t)m * RWKV_COLS + c, p);
                if (t > 0) ld8(P + (size_t)(m - 1) * RWKV_COLS + c, q); else {
#pragma unroll
                    for (int e = 0; e < 8; ++e) q[e] = 0.f; }
                const f32x4 m0 = *(const f32x4*)(mu + c), m1 = *(const f32x4*)(mu + c + 4);
#pragma unroll
                for (int e = 0; e < 8; ++e) o[e] = p[e] + (q[e] - p[e]) * (e < 4 ? m0[e] : m1[e - 4]);
                if (c < 512) st8(R + (size_t)m * RD + c, o);
                else if (c < 1024) st8(Kk + (size_t)m * RD + (c - 512), o);
                else if (c < 1536) st8(V + (size_t)m * RD + (c - 1024), o);
                else { if (c < 1600) {
#pragma unroll
                        for (int e = 0; e < 8; ++e) o[e] = tanhf(o[e]); }
                    else if (c >= 1664) {
#pragma unroll
                        for (int e = 0; e < 8; ++e) o[e] = sigm(o[e]); }
                    st8(AL + (size_t)m * 256 + (c - 1536), o); } } }
        { float x[8]; float ss = 0.f;
            if (lane < 52) { ld8(PM + (size_t)m * 512 + 8 * lane, x);
#pragma unroll
                for (int e = 0; e < 8; ++e) ss += x[e] * x[e]; }
            else {
#pragma unroll
                for (int e = 0; e < 8; ++e) x[e] = 0.f; }
            const float sq = wave_sum(lane < 32 ? ss : 0.f), skv = wave_sum((lane >= 32 && lane < 48) ? ss : 0.f);
            if (lane == 0) { rq[m] = 1.0f / sqrtf(sq * (1.f / 256.f) + RMS_EPS); rkv[m] = 1.0f / sqrtf(skv * (1.f / 128.f) + RMS_EPS); }
            float y[8], o[8];
#pragma unroll
            for (int e = 0; e < 8; ++e) y[e] = __shfl_xor(x[e], 2);
            if (lane >= 48 && lane < 52) { const int i0 = 8 * (lane & 1); const bool second = lane >= 50;
#pragma unroll
                for (int e = 0; e < 8; ++e) { const float cs = cosT[t * 16 + i0 + e], sn = sinT[t * 16 + i0 + e];
                    o[e] = second ? (x[e] * cs + y[e] * sn) : (x[e] * cs - y[e] * sn); }
#pragma unroll
                for (int h = 0; h < 8; ++h) st8(Kc + (size_t)m * 768 + h * 96 + 64 + 8 * (lane - 48), o); } }
    }
}
__device__ __forceinline__ void phase_rwkv_post(Frame& F, int l, const float* xsrc) {
    const int gw = F.bid * NWAVES + F.wave, NGW = F.G * NWAVES; unsigned char* ws = F.ws; const Args& A = *F.a; const int lane = F.lane;
    const h16* R = (const h16*)(ws + WS_R); const h16* Kk = (const h16*)(ws + WS_K); const h16* V = (const h16*)(ws + WS_V);
    const h16* AS = (const h16*)(ws + WS_ASIG); const h16* G = (const h16*)(ws + WS_G); h16* YA = (h16*)(ws + WS_YAIN);
    const int c = 8 * lane;
    float ka[8], rk[8], gg[8], gb[8];
    { const f32x4 a0 = *(const f32x4*)(A.in[I_KA] + l * RD + c), a1 = *(const f32x4*)(A.in[I_KA] + l * RD + c + 4), r0 = *(const f32x4*)(A.in[I_RK] + l * RD + c), r1 = *(const f32x4*)(A.in[I_RK] + l * RD + c + 4);
      const f32x4 g0 = *(const f32x4*)(A.in[I_GNG] + l * RD + c), g1 = *(const f32x4*)(A.in[I_GNG] + l * RD + c + 4), b0 = *(const f32x4*)(A.in[I_GNB] + l * RD + c), b1 = *(const f32x4*)(A.in[I_GNB] + l * RD + c + 4);
#pragma unroll
      for (int e = 0; e < 4; ++e) { ka[e] = a0[e]; ka[4 + e] = a1[e]; rk[e] = r0[e]; rk[4 + e] = r1[e]; gg[e] = g0[e]; gg[4 + e] = g1[e]; gb[e] = b0[e]; gb[4 + e] = b1[e]; } }
    for (int m = gw; m < M; m += NGW) {
        const h16* Y = (const h16*)(ws + (m < T ? WS_YRW0 : WS_YRW1)) + (size_t)(m & (T - 1)) * RD;
        float y[8], v[8], g[8], o[8];
        ld8(Y + c, y); ld8(V + (size_t)m * RD + c, v); ld8(G + (size_t)m * RD + c, g);
        float s = 0.f; const float bs = ((const float*)(ws + WS_BS))[(size_t)m * 8 + (lane >> 3)];
#pragma unroll
        for (int e = 0; e < 8; ++e) s += y[e];
        s += __shfl_xor(s, 1); s += __shfl_xor(s, 2); s += __shfl_xor(s, 4);
        const float mean = s * (1.f / 64.f); float q = 0.f;
#pragma unroll
        for (int e = 0; e < 8; ++e) { y[e] -= mean; q += y[e] * y[e]; }
        q += __shfl_xor(q, 1); q += __shfl_xor(q, 2); q += __shfl_xor(q, 4);
        const float rstd = 1.0f / sqrtf(q * (1.f / 64.f) + GN_EPS);
#pragma unroll
        for (int e = 0; e < 8; ++e) o[e] = (y[e] * rstd * gg[e] + gb[e] + bs * v[e]) * g[e];
        st8(YA + (size_t)m * RD + c, o);
    }
    rows_to_h16(F, xsrc, (h16*)(ws + WS_XH2));
}

constexpr int S5_NC = 32, S5_CL = T / S5_NC;
__device__ __forceinline__ float rdlane(float v, int l) { return __builtin_bit_cast(float, __builtin_amdgcn_readlane(__builtin_bit_cast(int, v), l)); }
__device__ __forceinline__ float gelu_tanh(float x) { const float u = 0.7978845608028654f * (x + 0.044715f * x * x * x); return 0.5f * x * (1.0f + tanhf(u)); }
template <int PASS> __device__ __forceinline__ void phase_s5(Frame& F, int l) {
    const int gw = F.bid * NWAVES + F.wave, NGW = F.G * NWAVES; unsigned char* ws = F.ws; const Args& A = *F.a; const int lane = F.lane, row = lane & 15, kg = lane >> 4;
    const h16* U = (const h16*)(ws + WS_U); h16* Y = (h16*)(ws + WS_YS5); float* END = (float*)(ws + WS_S5END);
    LAS h16* sl = (LAS h16*)(F.lds + F.wave * 8704);
    LAS h16* bl = (LAS h16*)(F.lds + 8 * 8704 + F.wave * 6144);
    for (int task = gw; task < BATCH * 32 * S5_NC; task += NGW) {
        const int ch = task % S5_NC, g = (task / S5_NC) % 32, b = task / (S5_NC * 32);
        const int gp = (l * 32 + g) * 64 + lane;
        const float lam_re = fminf(A.in[I_LRE][gp], -1e-4f), lam_im = A.in[I_LIM][gp], step = __expf(A.in[I_LSTEP][l * 32 + g]);
        float sn, cs; sincosf(lam_im * step, &sn, &cs); const float mag = __expf(lam_re * step);
        const float lb_re = mag * cs, lb_im = mag * sn;
        h16x8 bf[8];
#pragma unroll
        for (int nb = 0; nb < 8; ++nb) { const int p = 16 * (nb & 3) + row; const int gq = (l * 32 + g) * 64 + p;
            const float lr = fminf(A.in[I_LRE][gq], -1e-4f), li = A.in[I_LIM][gq]; float s2, c2; sincosf(li * step, &s2, &c2); const float mg = __expf(lr * step);
            const float br_ = mg * c2, bi_ = mg * s2, den = lr * lr + li * li, n_re = br_ - 1.0f; const float f_re = (n_re * lr + bi_ * li) / den, f_im = (bi_ * lr - n_re * li) / den;
            h16x8 v = {};
            if (kg < 2) { const f32x4 r0 = *(const f32x4*)(A.in[I_BRE] + (size_t)gq * 16 + 8 * kg), r1 = *(const f32x4*)(A.in[I_BRE] + (size_t)gq * 16 + 8 * kg + 4), i0 = *(const f32x4*)(A.in[I_BIM] + (size_t)gq * 16 + 8 * kg), i1 = *(const f32x4*)(A.in[I_BIM] + (size_t)gq * 16 + 8 * kg + 4);
#pragma unroll
                for (int e = 0; e < 8; ++e) { const float br = e < 4 ? r0[e] : r1[e - 4], bi = e < 4 ? i0[e] : i1[e - 4]; v[e] = (h16)(nb < 4 ? (f_re * br - f_im * bi) : (f_re * bi + f_im * br)); } }
            bf[nb] = v; }
        float s_re = 0.f, s_im = 0.f;
        h16x8 cf[4]; float dsk = 0.f;
        if (PASS == 2) {
            float snL, csL; sincosf(lam_im * step * (float)S5_CL, &snL, &csL); const float magL = __expf(lam_re * step * (float)S5_CL); const float L_re = magL * csL, L_im = magL * snL;
            const float* e0 = END + ((size_t)(b * 32 + g) * S5_NC) * 128 + 2 * lane;
            for (int j = 0; j < ch; ++j) { const f32x2 e = *(const f32x2*)(e0 + j * 128); const float nr = s_re * L_re - s_im * L_im + e.x, ni = s_re * L_im + s_im * L_re + e.y; s_re = nr; s_im = ni; }
#pragma unroll
            for (int ks = 0; ks < 4; ++ks) { const int k = 32 * ks + 8 * kg; const float* src = (k < 64 ? A.in[I_CRE] : A.in[I_CIM]) + ((size_t)(l * 32 + g) * 16 + row) * 64 + (k & 63); const float sg = k < 64 ? 1.f : -1.f;
                const f32x4 a0 = *(const f32x4*)src, a1 = *(const f32x4*)(src + 4);
                cf[ks] = (h16x8){(h16)(sg * a0[0]), (h16)(sg * a0[1]), (h16)(sg * a0[2]), (h16)(sg * a0[3]), (h16)(sg * a1[0]), (h16)(sg * a1[1]), (h16)(sg * a1[2]), (h16)(sg * a1[3])}; }
            dsk = A.in[I_S5D][l * 512 + 16 * g + row];
        }
        const size_t m0 = (size_t)b * T + (size_t)ch * S5_CL;
#pragma unroll 1
        for (int t32 = 0; t32 < S5_CL / 32; ++t32) {
#pragma unroll
            for (int t16 = 0; t16 < 2; ++t16) {
                h16x8 af = {}; if (kg < 2) af = *(const h16x8*)(U + (m0 + 32 * t32 + 16 * t16 + row) * 512 + 16 * g + 8 * kg);
#pragma unroll
                for (int nb = 0; nb < 8; ++nb) { f32x4 d = {0.f, 0.f, 0.f, 0.f}; d = __builtin_amdgcn_mfma_f32_16x16x32_f16(af, bf[nb], d, 0, 0, 0);
                    *(LAS u32x2*)(bl + (16 * nb + row) * 24 + 4 * kg) = (u32x2){pkh(d[0], d[1]), pkh(d[2], d[3])}; }
                asm volatile("s_waitcnt lgkmcnt(0)" ::: "memory");
                float bre[16], bim[16];
                { float q[8]; ld8(bl + lane * 24, q);
#pragma unroll
                  for (int e = 0; e < 8; ++e) bre[e] = q[e];
                  ld8(bl + lane * 24 + 8, q);
#pragma unroll
                  for (int e = 0; e < 8; ++e) bre[8 + e] = q[e];
                  ld8(bl + (64 + lane) * 24, q);
#pragma unroll
                  for (int e = 0; e < 8; ++e) bim[e] = q[e];
                  ld8(bl + (64 + lane) * 24 + 8, q);
#pragma unroll
                  for (int e = 0; e < 8; ++e) bim[8 + e] = q[e]; }
#pragma unroll
                for (int tt = 0; tt < 16; ++tt) { const float nr = s_re * lb_re - s_im * lb_im + bre[tt], ni = s_re * lb_im + s_im * lb_re + bim[tt]; s_re = nr; s_im = ni;
                    if (PASS == 2) { sl[(16 * t16 + tt) * 136 + lane] = (h16)s_re; sl[(16 * t16 + tt) * 136 + 64 + lane] = (h16)s_im; } }
                asm volatile("s_waitcnt lgkmcnt(0)" ::: "memory");
            }
            if (PASS == 2) {
#pragma unroll
                for (int mb = 0; mb < 2; ++mb) { f32x4 acc = {0.f, 0.f, 0.f, 0.f};
#pragma unroll
                    for (int ks = 0; ks < 4; ++ks) { const h16x8 af = *(const LAS h16x8*)(sl + (mb * 16 + row) * 136 + 32 * ks + 8 * kg); acc = __builtin_amdgcn_mfma_f32_16x16x32_f16(af, cf[ks], acc, 0, 0, 0); }
#pragma unroll
                    for (int e = 0; e < 4; ++e) { const size_t m = m0 + 32 * t32 + mb * 16 + 4 * kg + e; const float uu = (float)U[m * 512 + 16 * g + row];
                        Y[m * 512 + 16 * g + row] = (h16)gelu_tanh(acc[e] + dsk * uu); } }
                asm volatile("s_waitcnt lgkmcnt(0)" ::: "memory");
            }
        }
        if (PASS == 1) { *(f32x2*)(END + ((size_t)(b * 32 + g) * S5_NC + ch) * 128 + 2 * lane) = (f32x2){s_re, s_im}; }
    }
}

constexpr int RW_TS = 32, RW_BUF = 5 * 8192 + 2048 + 256;
template <int CTRL> __device__ __forceinline__ float dpp_add(float v) { return v + __builtin_bit_cast(float, __builtin_amdgcn_update_dpp(0, __builtin_bit_cast(int, v), CTRL, 0xf, 0xf, false)); }
__device__ __forceinline__ float red16(float v) { v = dpp_add<0xB1>(v); v = dpp_add<0x4E>(v); v = dpp_add<0x141>(v); v = dpp_add<0x140>(v); return v; }
__device__ __forceinline__ void rwkv_scan_unit(Frame& F, int l, int b, int h, int q) {
    unsigned char* ws = F.ws; const Args& A = *F.a; const int tid = F.tid, lane = F.lane, wave = F.wave;
    const h16* R = (const h16*)(ws + WS_R); const h16* Kk = (const h16*)(ws + WS_K); const h16* V = (const h16*)(ws + WS_V);
    const h16* LW = (const h16*)(ws + WS_LW); const h16* AS = (const h16*)(ws + WS_ASIG);
#ifdef DBG_CHUNK
    h16* Yg = (h16*)(ws + (b == 0 ? YREF0 : YREF1));
#else
    h16* Yg = (h16*)(ws + (b == 0 ? WS_YRW0 : WS_YRW1));
#endif
    LAS unsigned char* lds = F.lds;
    const size_t base = (size_t)b * T * RD + h * 64;
    if (wave >= 4) {
        const int c = lane; const float kkc = A.in[I_KK][l * RD + h * 64 + c], kac = A.in[I_KA][l * RD + h * 64 + c];
        for (int tile = 0; tile < T / RW_TS; ++tile) {
            LAS float* buf = (LAS float*)(lds + (tile & 1) * RW_BUF);
            float r[8], k[8], v[8], lw[8], as[8];
#pragma unroll
            for (int i = 0; i < 8; ++i) { const size_t idx = base + (size_t)(tile * RW_TS + (wave - 4) * 8 + i) * RD + c;
                r[i] = (float)R[idx]; k[i] = (float)Kk[idx]; v[i] = (float)V[idx]; lw[i] = (float)LW[idx]; as[i] = (float)AS[idx]; }
#pragma unroll
            for (int i = 0; i < 8; ++i) { const int tt = (wave - 4) * 8 + i;
                const float kkr = k[i] * kkc; const float n2 = wave_sum(kkr * kkr); const float kk = kkr * (1.0f / sqrtf(fmaxf(n2, 1e-12f)));
                const float bq = kk * as[i], kp = k[i] * (1.0f + (as[i] - 1.0f) * kac), w = __expf(lw[i]);
                const float brs = wave_sum(bq * r[i]), krs = wave_sum(kp * r[i]);
                buf[tt * 64 + c] = -kk; buf[2048 + tt * 64 + c] = w * r[i]; buf[4096 + tt * 64 + c] = w; buf[6144 + tt * 64 + c] = bq; buf[8192 + tt * 64 + c] = kp;
                if ((c >> 4) == q) buf[10240 + tt * 16 + (c & 15)] = v[i];
                if (c == 0) { buf[10752 + tt * 2] = brs; buf[10752 + tt * 2 + 1] = krs; } }
            __syncthreads();
        }
        __syncthreads();
    } else {
        const int row = tid >> 4, kq = tid & 15;
        float S0 = 0.f, S1 = 0.f, S2 = 0.f, S3 = 0.f;
        __syncthreads();
        for (int tile = 0; tile < T / RW_TS; ++tile) {
            const LAS float* buf = (const LAS float*)(lds + (tile & 1) * RW_BUF);
            float y0 = 0.f, y1 = 0.f;
#pragma unroll
            for (int tt = 0; tt < RW_TS; ++tt) {
                const f32x4 a4 = *(const LAS f32x4*)(buf + tt * 64 + 4 * kq), wr4 = *(const LAS f32x4*)(buf + 2048 + tt * 64 + 4 * kq), w4 = *(const LAS f32x4*)(buf + 4096 + tt * 64 + 4 * kq);
                const f32x4 b4 = *(const LAS f32x4*)(buf + 6144 + tt * 64 + 4 * kq), k4 = *(const LAS f32x4*)(buf + 8192 + tt * 64 + 4 * kq);
                const float vv = buf[10240 + tt * 16 + row]; const f32x2 sc = *(const LAS f32x2*)(buf + 10752 + tt * 2);
                float d1 = (S0 * a4[0] + S1 * a4[1]) + (S2 * a4[2] + S3 * a4[3]);
                float d2 = (S0 * wr4[0] + S1 * wr4[1]) + (S2 * wr4[2] + S3 * wr4[3]);
                d1 = red16(d1); d2 = red16(d2);
                S0 = S0 * w4[0] + d1 * b4[0] + vv * k4[0]; S1 = S1 * w4[1] + d1 * b4[1] + vv * k4[1];
                S2 = S2 * w4[2] + d1 * b4[2] + vv * k4[2]; S3 = S3 * w4[3] + d1 * b4[3] + vv * k4[3];
                const float y = d2 + d1 * sc.x + vv * sc.y;
                if (kq == (tt & 15)) { if (tt < 16) y0 = y; else y1 = y; }
            }
            { const size_t o = (size_t)(tile * RW_TS + kq) * RD + h * 64 + 16 * q + row; Yg[o] = (h16)y0; Yg[o + 16 * RD] = (h16)y1; }
            __syncthreads();
        }
    }
}


constexpr int CK_LDH = 72, CK_MAT = 64 * CK_LDH * 2;
constexpr int CK_RT = 0, CK_BT = CK_MAT, CK_KT = 2 * CK_MAT, CK_VT = 3 * CK_MAT, CK_ATT = 4 * CK_MAT, CK_MRB = 5 * CK_MAT, CK_MRK = 6 * CK_MAT, CK_AN = 7 * CK_MAT  , CK_BN = 8 * CK_MAT  ,
              CK_KN = 9 * CK_MAT  , CK_LAK = 10 * CK_MAT  , CK_P = 11 * CK_MAT, CK_PT = 12 * CK_MAT, CK_TACC = 13 * CK_MAT, CK_CUM = CK_P  , CK_SM = 14 * CK_MAT;
static_assert(CK_SM + 768 <= 131072 && 2 * CK_MAT >= 16384, "chunk LDS map");
template <int KS> __device__ __forceinline__ void ck_mm2(f32x4& acc0, f32x4& acc1, const LAS unsigned char* A, int mb0, const LAS unsigned char* Bt, int nb, int lane) {
    const int row = lane & 15, kg = lane >> 4;
#pragma unroll
    for (int ks = 0; ks < KS; ++ks) { const h16x8 b = *(const LAS h16x8*)(Bt + ((16 * nb + row) * CK_LDH + 32 * ks + 8 * kg) * 2);
        const h16x8 a0 = *(const LAS h16x8*)(A + ((16 * mb0 + row) * CK_LDH + 32 * ks + 8 * kg) * 2), a1 = *(const LAS h16x8*)(A + ((16 * mb0 + 16 + row) * CK_LDH + 32 * ks + 8 * kg) * 2);
        acc0 = __builtin_amdgcn_mfma_f32_16x16x32_f16(a0, b, acc0, 0, 0, 0); acc1 = __builtin_amdgcn_mfma_f32_16x16x32_f16(a1, b, acc1, 0, 0, 0); }
}
__device__ __forceinline__ void ck_st(LAS unsigned char* base, int n_, int m_, const f32x4 v) { *(LAS u32x2*)(base + (n_ * CK_LDH + m_) * 2) = (u32x2){pkh(v[0], v[1]), pkh(v[2], v[3])}; }
__device__ __forceinline__ void rwkv_chunk_item(Frame& F, int l, int b, int h, int c) {
    unsigned char* ws = F.ws; const Args& A = *F.a; int tid = F.tid; asm volatile("" : "+v"(tid)); const int lane = tid & 63, w = F.wave; LAS unsigned char* lds = F.lds;
    h16* R = (h16*)(ws + WS_R); h16* Kk = (h16*)(ws + WS_K); const h16* V = (const h16*)(ws + WS_V); h16* LW = (h16*)(ws + WS_LW); h16* AS = (h16*)(ws + WS_ASIG); float* BS = (float*)(ws + WS_BS);
    const size_t m0 = (size_t)b * T + (size_t)c * 64; const size_t tile = m0 * RD + h * 64;
    LAS float* cum = (LAS float*)(lds + CK_CUM); LAS float* sm = (LAS float*)(lds + CK_SM);
    const int t = tid >> 3, c8 = tid & 7, k0 = 8 * c8;
    float lwv[8]; ld8(LW + tile + (size_t)t * RD + k0, lwv);
    *(LAS f32x4*)(cum + t * 64 + k0) = (f32x4){lwv[0], lwv[1], lwv[2], lwv[3]}; *(LAS f32x4*)(cum + t * 64 + k0 + 4) = (f32x4){lwv[4], lwv[5], lwv[6], lwv[7]};
    float rv[8], kv[8], vv[8], av[8];
    ld8(R + tile + (size_t)t * RD + k0, rv); ld8(Kk + tile + (size_t)t * RD + k0, kv); ld8(V + tile + (size_t)t * RD + k0, vv); ld8(AS + tile + (size_t)t * RD + k0, av);
    __syncthreads();
    if (w == 0) { float run = 0.f, rho = 0.f;
#pragma unroll 8
        for (int tt = 0; tt < 64; ++tt) { run += cum[tt * 64 + lane]; cum[tt * 64 + lane] = run; if (tt == 31) rho = run; }
        sm[lane] = __expf(rho); sm[64 + lane] = __expf(run - rho); sm[128 + lane] = rho; }
    __syncthreads();
    { float kkr[8], n2 = 0.f, bsum = 0.f; float kp[8];
      const f32x4 kk0 = *(const f32x4*)(A.in[I_KK] + l * RD + h * 64 + k0), kk1 = *(const f32x4*)(A.in[I_KK] + l * RD + h * 64 + k0 + 4), ka0 = *(const f32x4*)(A.in[I_KA] + l * RD + h * 64 + k0), ka1 = *(const f32x4*)(A.in[I_KA] + l * RD + h * 64 + k0 + 4);
      const f32x4 rk0 = *(const f32x4*)(A.in[I_RK] + l * RD + h * 64 + k0), rk1 = *(const f32x4*)(A.in[I_RK] + l * RD + h * 64 + k0 + 4);
#pragma unroll
      for (int e = 0; e < 8; ++e) { const float kkc = e < 4 ? kk0[e] : kk1[e - 4], kac = e < 4 ? ka0[e] : ka1[e - 4], rkc = e < 4 ? rk0[e] : rk1[e - 4];
          kkr[e] = kv[e] * kkc; n2 += kkr[e] * kkr[e]; kp[e] = kv[e] * (1.0f + (av[e] - 1.0f) * kac); bsum += rv[e] * kp[e] * rkc; }
      n2 += __shfl_xor(n2, 1); n2 += __shfl_xor(n2, 2); n2 += __shfl_xor(n2, 4); bsum += __shfl_xor(bsum, 1); bsum += __shfl_xor(bsum, 2); bsum += __shfl_xor(bsum, 4);
      if (c8 == 0) BS[(m0 + t) * 8 + h] = bsum;
      const float rn = 1.0f / sqrtf(fmaxf(n2, 1e-12f));
      float Rt[8], At[8], Kt[8], Bt[8];
#pragma unroll
      for (int e = 0; e < 8; ++e) { const float cu = cum[t * 64 + k0 + e], rho = sm[128 + k0 + e]; const float e1 = __expf(cu - rho), e2 = __expf(rho - cu), e0 = __expf(cu - lwv[e] - rho), kk = kkr[e] * rn;
          Rt[e] = rv[e] * e1; At[e] = -kk * e0; Kt[e] = kp[e] * e2; Bt[e] = kk * av[e] * e2; }
      __syncthreads();
      st8((LAS h16*)(lds + CK_RT) + t * CK_LDH + k0, Rt); st8((LAS h16*)(lds + CK_AN) + t * CK_LDH + k0, At); st8((LAS h16*)(lds + CK_BN) + t * CK_LDH + k0, Bt); st8((LAS h16*)(lds + CK_KN) + t * CK_LDH + k0, Kt);
#pragma unroll
      for (int e = 0; e < 8; ++e) { ((LAS h16*)(lds + CK_BT))[(k0 + e) * CK_LDH + t] = (h16)Bt[e]; ((LAS h16*)(lds + CK_KT))[(k0 + e) * CK_LDH + t] = (h16)Kt[e]; ((LAS h16*)(lds + CK_VT))[(k0 + e) * CK_LDH + t] = (h16)vv[e]; ((LAS h16*)(lds + CK_ATT))[(k0 + e) * CK_LDH + t] = (h16)At[e]; } }
    __syncthreads();
    const int nb = w & 3, mb0 = 2 * (w >> 2), n_ = 16 * nb + (lane & 15), kg = lane >> 4;
    { f32x4 a0 = {}, a1 = {}, t0 = {}, t1 = {}, b0 = {}, b1 = {}, c0 = {}, c1 = {}, d0 = {}, d1 = {};
      ck_mm2<2>(a0, a1, lds + CK_BN, mb0, lds + CK_AN, nb, lane);
      ck_mm2<2>(t0, t1, lds + CK_AN, mb0, lds + CK_BN, nb, lane);
      ck_mm2<2>(b0, b1, lds + CK_KN, mb0, lds + CK_AN, nb, lane); ck_mm2<2>(c0, c1, lds + CK_BN, mb0, lds + CK_RT, nb, lane); ck_mm2<2>(d0, d1, lds + CK_KN, mb0, lds + CK_RT, nb, lane);
#pragma unroll
      for (int mbi = 0; mbi < 2; ++mbi) { const int m_ = 16 * (mb0 + mbi) + 4 * kg; f32x4 la = mbi ? a1 : a0, lt = mbi ? t1 : t0, lk = mbi ? b1 : b0, mr = mbi ? c1 : c0, mk = mbi ? d1 : d0, ta;
#pragma unroll
          for (int e = 0; e < 4; ++e) { const bool st = (m_ + e) < n_, inc = (m_ + e) <= n_; la[e] = st ? la[e] : 0.f; ta[e] = la[e] + ((m_ + e) == n_ ? 1.f : 0.f); lk[e] = st ? lk[e] : 0.f; mr[e] = inc ? mr[e] : 0.f; mk[e] = inc ? mk[e] : 0.f;
              lt[e] = (m_ + e) > n_ ? lt[e] : 0.f; }
          ck_st(lds + CK_P, n_, m_, la); ck_st(lds + CK_TACC, n_, m_, ta); ck_st(lds + CK_PT, n_, m_, lt); ck_st(lds + CK_LAK, n_, m_, lk); ck_st(lds + CK_MRB, n_, m_, mr); ck_st(lds + CK_MRK, n_, m_, mk); } }
    __syncthreads();
    { f32x4 x0 = {}, x1 = {}; ck_mm2<2>(x0, x1, lds + CK_LAK, mb0, lds + CK_VT, nb, lane); ck_st(lds + CK_AN, n_, 16 * mb0 + 4 * kg, x0); ck_st(lds + CK_AN, n_, 16 * mb0 + 16 + 4 * kg, x1); }
#pragma unroll
    for (int r = 0; r < 5; ++r) {
        const int pa = (r & 1) ? CK_BN : CK_P, pat = (r & 1) ? CK_KN : CK_PT, pb = (r & 1) ? CK_P : CK_BN, pbt = (r & 1) ? CK_PT : CK_KN;
        { f32x4 p0 = {}, p1 = {}, q0 = {}, q1 = {};
          ck_mm2<2>(p0, p1, lds + pat, mb0, lds + pa, nb, lane);
          ck_mm2<2>(q0, q1, lds + pa, mb0, lds + pat, nb, lane);
          ck_st(lds + pb, n_, 16 * mb0 + 4 * kg, p0); ck_st(lds + pb, n_, 16 * mb0 + 16 + 4 * kg, p1); ck_st(lds + pbt, n_, 16 * mb0 + 4 * kg, q0); ck_st(lds + pbt, n_, 16 * mb0 + 16 + 4 * kg, q1); }
        __syncthreads();
        { f32x4 u0 = {}, u1 = {}; ck_mm2<2>(u0, u1, lds + pbt, mb0, lds + CK_TACC, nb, lane);
          const f32x4 o0 = h4_to_f4(*(const LAS u32x2*)(lds + CK_TACC + (n_ * CK_LDH + 16 * mb0 + 4 * kg) * 2)), o1 = h4_to_f4(*(const LAS u32x2*)(lds + CK_TACC + (n_ * CK_LDH + 16 * mb0 + 16 + 4 * kg) * 2));
          __syncthreads();
          ck_st(lds + CK_TACC, n_, 16 * mb0 + 4 * kg, u0 + o0); ck_st(lds + CK_TACC, n_, 16 * mb0 + 16 + 4 * kg, u1 + o1); }
    }
    __syncthreads();
    { f32x4 a0 = {}, a1 = {}, u0 = {}, u1 = {}; ck_mm2<2>(a0, a1, lds + CK_TACC, mb0, lds + CK_ATT, nb, lane); ck_mm2<2>(u0, u1, lds + CK_TACC, mb0, lds + CK_AN, nb, lane);
      ck_st(lds + CK_LAK, n_, 16 * mb0 + 4 * kg, a0); ck_st(lds + CK_LAK, n_, 16 * mb0 + 16 + 4 * kg, a1); ck_st(lds + CK_BN, n_, 16 * mb0 + 4 * kg, u0); ck_st(lds + CK_BN, n_, 16 * mb0 + 16 + 4 * kg, u1); }
    __syncthreads();
    constexpr int CK_ABT = CK_LAK, CK_UBT = CK_BN;
    { f32x4 r0 = {}, r1 = {}, y0 = {}, y1 = {}, g0 = {}, g1 = {}, h0 = {}, h1 = {};
      ck_mm2<2>(r0, r1, lds + CK_ABT, mb0, lds + CK_MRB, nb, lane);
      ck_mm2<2>(y0, y1, lds + CK_MRB, mb0, lds + CK_UBT, nb, lane); ck_mm2<2>(y0, y1, lds + CK_MRK, mb0, lds + CK_VT, nb, lane);
      ck_mm2<2>(g0, g1, lds + CK_ABT, mb0, lds + CK_BT, nb, lane);
      ck_mm2<2>(h0, h1, lds + CK_BT, mb0, lds + CK_UBT, nb, lane); ck_mm2<2>(h0, h1, lds + CK_KT, mb0, lds + CK_VT, nb, lane);
      const float dcn = sm[64 + n_];
#pragma unroll
      for (int mbi = 0; mbi < 2; ++mbi) { const int m_ = 16 * (mb0 + mbi) + 4 * kg; const f32x4 rr = mbi ? r1 : r0, yy = mbi ? y1 : y0, gg = mbi ? g1 : g0, hh = mbi ? h1 : h0;
          const f32x4 er = *(const LAS f32x4*)(sm + m_); const f32x4 rt = h4_to_f4(*(const LAS u32x2*)((const LAS h16*)(lds + CK_RT) + n_ * CK_LDH + m_));
          float o[4];
#pragma unroll
          for (int e = 0; e < 4; ++e) o[e] = (rt[e] + rr[e]) * er[e];
          *(u32x2*)(LW + tile + (size_t)n_ * RD + m_) = (u32x2){pkh(o[0], o[1]), pkh(o[2], o[3])};
          *(u32x2*)(AS + tile + (size_t)n_ * RD + m_) = (u32x2){pkh(yy[0], yy[1]), pkh(yy[2], yy[3])};
#pragma unroll
          for (int e = 0; e < 4; ++e) o[e] = dcn * (gg[e] + ((m_ + e) == n_ ? 1.0f : 0.0f)) * er[e];
          *(u32x2*)(R + tile + (size_t)n_ * RD + m_) = (u32x2){pkh(o[0], o[1]), pkh(o[2], o[3])};
          { const f32x4 dm = *(const LAS f32x4*)(sm + 64 + m_); *(u32x2*)(Kk + tile + (size_t)n_ * RD + m_) = (u32x2){pkh(dm[0] * hh[0], dm[1] * hh[1]), pkh(dm[2] * hh[2], dm[3] * hh[3])}; } } }
    __syncthreads();
}
__device__ __forceinline__ void phase_rwkv_chunks(Frame& F, int l) {
    for (int it = F.bid; it < BATCH * RH * (T / 64); it += F.G) rwkv_chunk_item(F, l, it >> 10, (it >> 7) & 7, it & 127);
}


constexpr int SQ_BUF = 2 * CK_MAT;
__device__ __forceinline__ h16x8 mk_frag(u32x2 lo, u32x2 hi) { const u32x4 v = {lo.x, lo.y, hi.x, hi.y}; return __builtin_bit_cast(h16x8, v); }
__device__ __forceinline__ void rwkv_seq_unit(Frame& F, int b, int h) {
    unsigned char* ws = F.ws; int tid = F.tid; asm volatile("" : "+v"(tid)); const int lane = tid & 63, w = F.wave; LAS unsigned char* lds = F.lds;
    const h16* Gm = (const h16*)(ws + WS_R); const h16* Hm = (const h16*)(ws + WS_K); h16* Sc = (h16*)(ws + (b == 0 ? WS_YRW0 : WS_YRW1));
    const size_t tile0 = (size_t)b * T * RD + h * 64, cstep = (size_t)64 * RD;
    constexpr int NC = T / 64;
    if (w >= 4) {
        const int lt = tid - 256; u32x4 r0[4], r1[4], r2[4], r3[4];
        size_t goff[4]; int loff[4];
#pragma unroll
        for (int j2 = 0; j2 < 4; ++j2) { const int p = lt + 256 * j2, q = p >> 9, row = (p >> 3) & 63, ch = p & 7; goff[j2] = (size_t)row * RD + 8 * ch + (q ? (size_t)((const char*)Hm - (const char*)Gm) / 2 : 0); loff[j2] = q * CK_MAT + (row * CK_LDH + 8 * ch) * 2; }
#define SQ_LD(R, cc) do { _Pragma("unroll") for (int j2 = 0; j2 < 4; ++j2) R[j2] = *(const u32x4*)(Gm + tile0 + (size_t)(cc) * cstep + goff[j2]); } while (0)
#define SQ_ST(R, cc) do { _Pragma("unroll") for (int j2 = 0; j2 < 4; ++j2) *(LAS u32x4*)(lds + ((cc) & 3) * SQ_BUF + loff[j2]) = R[j2]; } while (0)
        SQ_LD(r0, 0); SQ_LD(r1, 1); SQ_LD(r2, 2); SQ_ST(r0, 0); SQ_ST(r1, 1); SQ_ST(r2, 2);
        SQ_LD(r0, 3); SQ_LD(r1, 4); SQ_LD(r2, 5); SQ_LD(r3, 6);
        __syncthreads();
        for (int c = 0; c < NC; c += 4) {
            if (c + 3 < NC) SQ_ST(r0, c + 3); if (c + 7 < NC) SQ_LD(r0, c + 7); __syncthreads();
            if (c + 4 < NC) SQ_ST(r1, c + 4); if (c + 8 < NC) SQ_LD(r1, c + 8); __syncthreads();
            if (c + 5 < NC) SQ_ST(r2, c + 5); if (c + 9 < NC) SQ_LD(r2, c + 9); __syncthreads();
            if (c + 6 < NC) SQ_ST(r3, c + 6); if (c + 10 < NC) SQ_LD(r3, c + 10); __syncthreads();
        }
#undef SQ_LD
#undef SQ_ST
    } else {
        const int row = lane & 15, kg = lane >> 4; const size_t s0 = (size_t)(16 * w + row) * RD + h * 64;
        f32x4 ST[4] = {};
        __syncthreads();
        for (int c = 0; c < NC; ++c) {
            const LAS unsigned char* buf = lds + (c & 3) * SQ_BUF;
            u32x2 pk[4];
#pragma unroll
            for (int kb = 0; kb < 4; ++kb) { pk[kb] = (u32x2){pkh(ST[kb][0], ST[kb][1]), pkh(ST[kb][2], ST[kb][3])}; *(u32x2*)(Sc + s0 + (size_t)c * cstep + 16 * kb + 4 * kg) = pk[kb]; }
            const h16x8 sb0 = mk_frag(pk[0], pk[1]), sb1 = mk_frag(pk[2], pk[3]);
            f32x4 Sn[4];
#pragma unroll
            for (int blk = 0; blk < 4; ++blk) { const LAS unsigned char* gr = buf + ((16 * blk + row) * CK_LDH + 4 * kg) * 2;
                f32x4 acc = h4_to_f4(*(const LAS u32x2*)(buf + CK_MAT + ((16 * w + row) * CK_LDH + 16 * blk + 4 * kg) * 2));
                acc = __builtin_amdgcn_mfma_f32_16x16x32_f16(mk_frag(*(const LAS u32x2*)gr, *(const LAS u32x2*)(gr + 32)), sb0, acc, 0, 0, 0);
                acc = __builtin_amdgcn_mfma_f32_16x16x32_f16(mk_frag(*(const LAS u32x2*)(gr + 64), *(const LAS u32x2*)(gr + 96)), sb1, acc, 0, 0, 0); Sn[blk] = acc; }
#pragma unroll
            for (int blk = 0; blk < 4; ++blk) ST[blk] = Sn[blk];
            __syncthreads();
        }
    }
}
__device__ __forceinline__ void phase_rwkv_out(Frame& F, int l) {
    unsigned char* ws = F.ws; const Args& A = *F.a; const int lane = F.lane, row = lane & 15, kg = lane >> 4;
    const h16* RBm = (const h16*)(ws + WS_LW); const h16* YBm = (const h16*)(ws + WS_ASIG); const h16* V = (const h16*)(ws + WS_V); const h16* G = (const h16*)(ws + WS_G); const float* BS = (const float*)(ws + WS_BS); h16* YA = (h16*)(ws + WS_YAIN);
    const int gw = F.bid * NWAVES + F.wave, NGW = F.G * NWAVES;
    for (int task = gw; task < BATCH * RH * (T / 64) * 4; task += NGW) {
        const int mb = task & 3, c = (task >> 2) & 127, h = (task >> 9) & 7, b = task >> 12;
        const size_t m0 = (size_t)b * T + (size_t)c * 64; const size_t tile = m0 * RD + h * 64;
        const h16* Sc = (const h16*)(ws + (b == 0 ? WS_YRW0 : WS_YRW1)) + (size_t)c * 64 * RD + h * 64;
        const h16x8 a0 = *(const h16x8*)(RBm + tile + (size_t)(16 * mb + row) * RD + 8 * kg), a1 = *(const h16x8*)(RBm + tile + (size_t)(16 * mb + row) * RD + 32 + 8 * kg);
        f32x4 acc[4]; float sum[4] = {0.f, 0.f, 0.f, 0.f};
#pragma unroll
        for (int nb = 0; nb < 4; ++nb) { const h16x8 b0 = *(const h16x8*)(Sc + (size_t)(16 * nb + row) * RD + 8 * kg), b1 = *(const h16x8*)(Sc + (size_t)(16 * nb + row) * RD + 32 + 8 * kg);
            f32x4 ac = h4_to_f4(*(const u32x2*)(YBm + tile + (size_t)(16 * nb + row) * RD + 16 * mb + 4 * kg));
            ac = __builtin_amdgcn_mfma_f32_16x16x32_f16(a0, b0, ac, 0, 0, 0); ac = __builtin_amdgcn_mfma_f32_16x16x32_f16(a1, b1, ac, 0, 0, 0); acc[nb] = ac;
#pragma unroll
            for (int e = 0; e < 4; ++e) sum[e] += ac[e]; }
        float mean[4], rstd[4];
#pragma unroll
        for (int e = 0; e < 4; ++e) { mean[e] = red16(sum[e]) * (1.f / 64.f); float q = 0.f;
#pragma unroll
            for (int nb = 0; nb < 4; ++nb) { const float d = acc[nb][e] - mean[e]; q += d * d; }
            rstd[e] = 1.0f / sqrtf(red16(q) * (1.f / 64.f) + GN_EPS); }
#pragma unroll
        for (int nb = 0; nb < 4; ++nb) { const int ch = h * 64 + 16 * nb + row; const float gg = A.in[I_GNG][l * RD + ch], gb = A.in[I_GNB][l * RD + ch];
#pragma unroll
            for (int e = 0; e < 4; ++e) { const size_t m = m0 + 16 * mb + 4 * kg + e; const float vv = (float)V[m * RD + ch], gt = (float)G[m * RD + ch], bs = BS[m * 8 + h];
                YA[m * RD + ch] = (h16)(((acc[nb][e] - mean[e]) * rstd[e] * gg + gb + bs * vv) * gt); } }
    }
}

constexpr int AT_KB = 64 * 208, AT_VB = 8192, AT_K0 = 0, AT_V0 = 2 * AT_KB, AT_WS = AT_V0 + 2 * AT_VB, AT_TICKET = AT_WS + 8 * 256;
__device__ __forceinline__ int crow(int r, int hi) { return (r & 3) + 8 * (r >> 2) + 4 * hi; }
typedef short v4i16_t __attribute__((ext_vector_type(4)));
__device__ __forceinline__ h16x4 vtr(const LAS unsigned char* p) { return __builtin_bit_cast(h16x4, __builtin_amdgcn_ds_read_tr16_b64_v4i16((LAS v4i16_t*)p)); }
__device__ __forceinline__ void attn_unit(Frame& F, int b, int h, int qb) {
    unsigned char* ws = F.ws; const int tid = F.tid, lane = F.lane, wid = F.wave, r32 = lane & 31, hi = lane >> 5;
    const h16* Qc = (const h16*)(ws + WS_QC); const h16* Kc = (const h16*)(ws + WS_KC); const h16* Va = (const h16*)(ws + WS_VA); h16* O = (h16*)(ws + WS_OATT);
    LAS unsigned char* lds = F.lds; LAS float* wsf = (LAS float*)(lds + AT_WS + wid * 256);
    const size_t rowbase = (size_t)b * T; const int q0 = qb * 256;
    h16x8 qr[6];
    { const h16* Qw = Qc + (rowbase + q0 + wid * 32 + r32) * 768 + h * 96 + hi * 8;
#pragma unroll
        for (int d0 = 0; d0 < 6; ++d0) qr[d0] = *(const h16x8*)(Qw + d0 * 16); }
    const int kp0 = tid, kp1 = tid + 512; const int kk0 = kp0 / 12, kc0 = kp0 % 12, kk1 = kp1 / 12, kc1 = kp1 % 12; const bool has1 = kp1 < 768;
    const h16* ksrc0 = Kc + (rowbase + kk0) * 768 + h * 96 + 8 * kc0; const h16* ksrc1 = Kc + (rowbase + (has1 ? kk1 : 0)) * 768 + h * 96 + 8 * (has1 ? kc1 : 0);
    const int kdst0 = kk0 * 208 + kc0 * 16, kdst1 = kk1 * 208 + kc1 * 16;
    const int vk = tid >> 3, vc = tid & 7; const h16* vsrc = Va + (rowbase + vk) * 512 + h * 64 + 8 * vc;
    const int vdst = (vc >> 2) * 4096 + (vk >> 4) * 1024 + (vk & 15) * 64 + (vc & 3) * 16;
    const int NT = 4 * (qb + 1), my_last = 4 * qb + (wid >> 1);
    float m_run = -1e30f, l_run = 0.f; f32x16 o0 = {}, o1 = {};
    u32x4 kr0, kr1 = {0u, 0u, 0u, 0u}, vr;
    kr0 = *(const u32x4*)ksrc0; if (has1) kr1 = *(const u32x4*)ksrc1; vr = *(const u32x4*)vsrc;
    *(LAS u32x4*)(lds + AT_K0 + kdst0) = kr0; if (has1) *(LAS u32x4*)(lds + AT_K0 + kdst1) = kr1; *(LAS u32x4*)(lds + AT_V0 + vdst) = vr;
    __syncthreads();
    const int vfo = ((lane >> 4) & 1) * 32 + (lane & 3) * 8 + (4 * hi + ((lane & 15) >> 2)) * 64;
    for (int jt = 0; jt < NT; ++jt) {
        const bool more = jt + 1 < NT;
        if (more) { const size_t adv = (size_t)(jt + 1) * 64; kr0 = *(const u32x4*)(ksrc0 + adv * 768); if (has1) kr1 = *(const u32x4*)(ksrc1 + adv * 768); vr = *(const u32x4*)(vsrc + adv * 512); }
        if (jt <= my_last) {
            const LAS unsigned char* Kb = lds + AT_K0 + (jt & 1) * AT_KB; const LAS unsigned char* Vb = lds + AT_V0 + (jt & 1) * AT_VB;
            f32x16 p0 = {}, p1 = {};
#pragma unroll
            for (int d0 = 0; d0 < 6; ++d0) { const h16x8 k0 = *(const LAS h16x8*)(Kb + r32 * 208 + (2 * d0 + hi) * 16), k1 = *(const LAS h16x8*)(Kb + (32 + r32) * 208 + (2 * d0 + hi) * 16);
                p0 = __builtin_amdgcn_mfma_f32_32x32x16_f16(k0, qr[d0], p0, 0, 0, 0); p1 = __builtin_amdgcn_mfma_f32_32x32x16_f16(k1, qr[d0], p1, 0, 0, 0); }
            if (64 * jt + 63 > q0 + 32 * wid) { const int qpos = q0 + 32 * wid + r32, kb = 64 * jt + 4 * hi;
#pragma unroll
                for (int r = 0; r < 16; ++r) { const int kv = kb + (r & 3) + 8 * (r >> 2); if (kv > qpos) p0[r] = -INFINITY; if (kv + 32 > qpos) p1[r] = -INFINITY; } }
            float rm = fmaxf(p0[0], p1[0]);
#pragma unroll
            for (int r = 1; r < 16; ++r) rm = fmaxf(rm, fmaxf(p0[r], p1[r]));
            rm = fmaxf(rm, __shfl_xor(rm, 32));
            const float m_new = fmaxf(m_run, rm), alpha = __builtin_amdgcn_exp2f(m_run - m_new);
            const bool grow = __any(m_new > m_run);
            m_run = m_new;
            float sum = 0.f;
#pragma unroll
            for (int r = 0; r < 16; ++r) { p0[r] = __builtin_amdgcn_exp2f(p0[r] - m_new); p1[r] = __builtin_amdgcn_exp2f(p1[r] - m_new); sum += p0[r] + p1[r]; }
            l_run = l_run * alpha + sum;
            if (grow) { if (hi == 0) wsf[r32] = alpha; asm volatile("s_waitcnt lgkmcnt(0)" ::: "memory");
#pragma unroll
                for (int r = 0; r < 16; ++r) { const float f = wsf[crow(r, hi)]; o0[r] *= f; o1[r] *= f; } }
            h16x8 pa[4];
#pragma unroll
            for (int j = 0; j < 8; ++j) { pa[0][j] = (h16)p0[j]; pa[1][j] = (h16)p0[8 + j]; pa[2][j] = (h16)p1[j]; pa[3][j] = (h16)p1[8 + j]; }
#pragma unroll
            for (int ks = 0; ks < 4; ++ks) {
                const h16x4 a0 = vtr(Vb + vfo + ks * 1024), a1 = vtr(Vb + vfo + ks * 1024 + 512), c0 = vtr(Vb + vfo + 4096 + ks * 1024), c1 = vtr(Vb + vfo + 4096 + ks * 1024 + 512);
                const h16x8 v0 = {a0[0], a0[1], a0[2], a0[3], a1[0], a1[1], a1[2], a1[3]}, v1 = {c0[0], c0[1], c0[2], c0[3], c1[0], c1[1], c1[2], c1[3]};
                o0 = __builtin_amdgcn_mfma_f32_32x32x16_f16(pa[ks], v0, o0, 0, 0, 0); o1 = __builtin_amdgcn_mfma_f32_32x32x16_f16(pa[ks], v1, o1, 0, 0, 0); }
        }
        if (more) { LAS unsigned char* Kn = lds + AT_K0 + ((jt + 1) & 1) * AT_KB; LAS unsigned char* Vn = lds + AT_V0 + ((jt + 1) & 1) * AT_VB;
            *(LAS u32x4*)(Kn + kdst0) = kr0; if (has1) *(LAS u32x4*)(Kn + kdst1) = kr1; *(LAS u32x4*)(Vn + vdst) = vr; }
        __syncthreads();
    }
    l_run += __shfl_xor(l_run, 32);
    if (hi == 0) wsf[r32] = 1.0f / l_run;
    asm volatile("s_waitcnt lgkmcnt(0)" ::: "memory");
    h16* Ow = O + (rowbase + q0 + wid * 32) * 512 + h * 64 + r32;
#pragma unroll
    for (int r = 0; r < 16; ++r) { const int qr_ = crow(r, hi); const float f = wsf[qr_]; Ow[(size_t)qr_ * 512] = (h16)(o0[r] * f); Ow[(size_t)qr_ * 512 + 32] = (h16)(o1[r] * f); }
    __syncthreads();
}


#ifdef DBG_CHUNK
constexpr int CW_DBG = 2048;
__device__ __forceinline__ void dbg_max(Frame& F, float v) {
    v = fmaxf(v, 0.f);
#pragma unroll
    for (int o = 1; o < 64; o <<= 1) v = fmaxf(v, __shfl_xor(v, o));
    if (F.lane == 0) atomicMax((unsigned*)(F.ws + WS_CTL) + CW_DBG, __float_as_uint(v));
}
__device__ __forceinline__ void dbg_emit(Frame& F) {
    if (F.bid == 0 && F.tid == 0) { const float v = __uint_as_float(((unsigned*)(F.ws + WS_CTL))[CW_DBG]);
        int code = v > 1e-6f ? (int)(4.0f * log2f(v * 1e6f) + 0.5f) : 0; code = code > 89 ? 89 : code; F.a->out[0] = (float)((10 + code) * 1000); }
}
__device__ __forceinline__ void dbg_cmp_y(Frame& F) {
    float md = 0.f;
    for (size_t i = (size_t)F.bid * NTHREADS + F.tid; i < (size_t)M * RD; i += (size_t)F.G * NTHREADS) { const int m = (int)(i >> 9), t = m & (T - 1), c = (int)(i & 511);
        if (t >= DBG_TLO && t < DBG_THI) { const float a = (float)((const h16*)(F.ws + (m < T ? WS_YRW0 : WS_YRW1)))[(size_t)t * RD + c], b = (float)((const h16*)(F.ws + (m < T ? YREF0 : YREF1)))[(size_t)t * RD + c];
            md = fmaxf(md, fabsf(a - b) / (1.0f + fabsf(b))); } }
    dbg_max(F, md);
}
#endif

typedef GAS unsigned gu32;
#define XB_TMO      128
#define XB_XCNT(j)  (256  + 64 * (j))
#define XB_XSUB(j)  (1280 + 64 * (j))
#define XB_XGEN(j)  (2304 + 64 * (j))
#define XB_TOP      3328
#define XB_TOPGEN   3392
#define XCD_BAR_WORDS 3456
#define XB_SPIN_CAP (1u << 22)
__device__ __forceinline__ unsigned xb_ld(unsigned* p)              { return __hip_atomic_load(p, __ATOMIC_RELAXED, __HIP_MEMORY_SCOPE_AGENT); }
__device__ __forceinline__ unsigned xb_add(unsigned* p, unsigned v) { return __hip_atomic_fetch_add(p, v, __ATOMIC_RELAXED, __HIP_MEMORY_SCOPE_AGENT); }
__device__ __forceinline__ unsigned xb_xcc_id() { return (unsigned)__builtin_amdgcn_s_getreg((3 << 11) | 20) & 0xFu; }
#define XB_SPIN(cond, bar) do { unsigned _sp = 0; while (cond) { __builtin_amdgcn_s_sleep(1); \
    if ((++_sp & 255u) == 0u) { if (xb_ld(&(bar)[XB_TMO])) break; if (_sp > XB_SPIN_CAP) { atomicAdd(&(bar)[XB_TMO], 1u); break; } } } } while (0)
struct XcdBarrier { unsigned* bar; unsigned x; volatile LAS unsigned* st; };
__device__ __forceinline__ XcdBarrier xcd_barrier_post(unsigned* bar, volatile LAS unsigned* st) {
    XcdBarrier b; b.bar = bar; b.x = xb_xcc_id(); b.st = st;
    if (threadIdx.x == 0) (void)xb_add(&bar[XB_XCNT(b.x)], 1u);
    return b;
}
__device__ __forceinline__ void xcd_barrier_complete(unsigned* bar, unsigned x, unsigned& nloc, unsigned& nx) {
    const unsigned G = gridDim.x * gridDim.y * gridDim.z;
    unsigned sum, cnt, mine, sp = 0u;
    for (;;) {
        sum = 0u; cnt = 0u; mine = 0u;
#pragma unroll
        for (unsigned j = 0; j < 16; ++j) { const unsigned c = xb_ld(&bar[XB_XCNT(j)]); sum += c; cnt += (c > 0u) ? 1u : 0u; mine = (j == x) ? c : mine; }
        if (sum == G) break;
        __builtin_amdgcn_s_sleep(1);
        if ((++sp & 255u) == 0u) { if (xb_ld(&bar[XB_TMO])) break; if (sp > XB_SPIN_CAP) { atomicAdd(&bar[XB_TMO], 1u); break; } }
    }
    nloc = mine > 0u ? mine : 1u; nx = cnt > 0u ? cnt : 1u;
}
__device__ __forceinline__ void xcd_barrier(const XcdBarrier& b) {
    asm volatile("s_waitcnt vmcnt(0)" ::: "memory");
    __syncthreads();
    if (threadIdx.x == 0) {
        unsigned* bar = b.bar;
        __builtin_amdgcn_s_waitcnt(0);
        unsigned nloc = b.st[0], nx = b.st[1];
        if (nloc == 0u) { xcd_barrier_complete(bar, b.x, nloc, nx); b.st[0] = nloc; b.st[1] = nx; }
        const unsigned old = xb_add(&bar[XB_XSUB(b.x)], 1u);
        const unsigned gen = old / nloc;
        if (old + 1u == (gen + 1u) * nloc) {
            __builtin_amdgcn_fence(__ATOMIC_RELEASE, "agent");
            asm volatile("s_waitcnt vmcnt(0)" ::: "memory");
            const unsigned og = xb_add(&bar[XB_TOP], 1u);
            const unsigned tg = og / nx;
            if (og + 1u == (tg + 1u) * nx) xb_add(&bar[XB_TOPGEN], 1u);
            else XB_SPIN(xb_ld(&bar[XB_TOPGEN]) == tg, bar);
            __builtin_amdgcn_fence(__ATOMIC_ACQUIRE, "agent");
            xb_add(&bar[XB_XGEN(b.x)], 1u);
            asm volatile("s_waitcnt vmcnt(0)" ::: "memory");
        } else {
            XB_SPIN(xb_ld(&bar[XB_XGEN(b.x)]) == gen, bar);
            __builtin_amdgcn_fence(__ATOMIC_ACQUIRE, "agent");
            asm volatile("s_waitcnt vmcnt(0)" ::: "memory");
        }
    }
    __syncthreads();
}

constexpr int NPH = 1 + 13 * DEPTH;
__device__ __forceinline__ void run_phase(Frame& F, int ph) {
    { int w_ = F.wave, b_ = F.bid; asm volatile("" : "+v"(F.tid), "+v"(F.lane), "+v"(w_), "+v"(b_)); F.wave = __builtin_amdgcn_readfirstlane(w_); F.bid = __builtin_amdgcn_readfirstlane(b_); }
    unsigned char* ws = F.ws; const Args& A = *F.a; LAS unsigned char* lds = F.lds;
    if (ph == 0) { phase_convert(F, 0); rows_to_h16(F, A.in[I_X], (h16*)(ws + WS_XH)); rope_table(F); return; }
    const int l = (ph - 1) / 13, k = (ph - 1) % 13 + 1;
    const float* xres = (l == 0) ? A.in[I_X] : A.out;
    switch (k) {
    case 1: { pg8::Gemm g{(const h16*)(ws + WS_XH), (const h16*)(ws + WS_WIN), 1024, 1024, 1024}; pg8::StaticOrder S; S.init(M, 2816, F.G, F.bid);
        EpiStoreSplit E{(h16*)(ws + WS_PRWKV), (h16*)(ws + WS_PMLA), (h16*)(ws + WS_U)}; pg8::gemm_phase(lds, g, S, E);
        } break;
    case 2: phase_prep(F, l); phase_s5<1>(F, l); break;
    case 3: {
        { pg8::Gemm g{(const h16*)(ws + WS_ALORA), (const h16*)(ws + WS_WLORA), 256, 256, 256}; pg8::StaticOrder S; S.init(M, 1536, F.G, F.bid);
          EpiLora E{(h16*)(ws + WS_LW), A.in[I_W0] + l * RD, A.in[I_A0] + l * RD}; pg8::gemm_phase(lds, g, S, E); }
        { pg8::Gemm g{(const h16*)(ws + WS_PMLA), (const h16*)(ws + WS_WQ), 512, 256, 256}; pg8::StaticOrder S; S.init(M, 768, F.G, F.bid);
          EpiQ E{(h16*)(ws + WS_QC), (const float*)(ws + WS_RSTDQ), (const float*)(ws + WS_COS), (const float*)(ws + WS_SIN)}; pg8::gemm_phase(lds, g, S, E); }
        { pg8::Gemm g{(const h16*)(ws + WS_PMLA) + 256, (const h16*)(ws + WS_WKV), 512, 128, 128}; pg8::StaticOrder S; S.init(M, 1024, F.G, F.bid);
          EpiKV E{(h16*)(ws + WS_KC), (h16*)(ws + WS_VA), (const float*)(ws + WS_RSTDKV)}; pg8::gemm_phase(lds, g, S, E); }
    } break;
    case 4: phase_s5<2>(F, l); __syncthreads(); phase_rwkv_chunks(F, l); break;
    case 5: {
        if (F.rep != 1) for (int rw = F.bid; rw < 16; rw += F.G) rwkv_seq_unit(F, rw >> 3, rw & 7);
        if (F.rep == 2) break;
#ifdef DBG_CHUNK
        __syncthreads();
        if (F.bid >= 16) for (int rw = F.bid - 16; rw < 64; rw += F.G) rwkv_scan_unit(F, l, rw >> 5, (rw >> 2) & 7, rw & 3);
        break;
#endif
        unsigned* qh = (unsigned*)(ws + WS_CTL) + CW_QUEUE * (1 + l) + 16 * F.rep; LAS unsigned* tk = (LAS unsigned*)(lds + AT_TICKET);
        for (;;) {
            if (F.tid == 0) tk[0] = __hip_atomic_fetch_add(qh, 1u, __ATOMIC_RELAXED, __HIP_MEMORY_SCOPE_AGENT);
            __syncthreads(); const unsigned u = tk[0]; __syncthreads();
            if (u >= 512u) break;
            attn_unit(F, (int)(u & 15u) >> 3, (int)(u & 7u), 31 - (int)(u >> 4));
        }
    } break;
#ifdef DBG_CHUNK
    case 6: if (l == 0) dbg_cmp_y(F); phase_rwkv_post(F, l, xres); break;
#else
    case 6: phase_rwkv_out(F, l); rows_to_h16(F, xres, (h16*)(ws + WS_XH2)); break;
#endif
    case 7: { pg8::Gemm g{(const h16*)(ws + WS_XH2), (const h16*)(ws + WS_WG), 1024, 1024, 1024}; pg8::StaticOrder S; S.init(M, 3072, F.G, F.bid);
        EpiGate E{(h16*)(ws + WS_GATES0), A.in[I_GATEB] + l * 3072}; pg8::gemm_phase(lds, g, S, E);
        } break;
    case 8: { pg8::StaticOrder S; S.init(M, 1024, F.G, F.bid); h16* mg = (h16*)(ws + WS_MERGED);
        for (int i = 0;; ++i) { Unit u; if (!S.next(i, u)) break;
            pg8::ListOrder L1{u, u, 1}; pg8::ListOrder L2{Unit{u.pm, 2 * u.pn}, Unit{u.pm, 2 * u.pn + 1}, 2};
            { pg8::Gemm g{(const h16*)(ws + WS_YAIN), (const h16*)(ws + WS_WRO), 512, 512, 512}; EpiBranch<0> E{mg, (const h16*)(ws + WS_GATES0)}; pg8::gemm_phase(lds, g, L1, E); }
            { pg8::Gemm g{(const h16*)(ws + WS_OATT), (const h16*)(ws + WS_WMO), 512, 512, 512}; EpiBranch<1> E{mg, (const h16*)(ws + WS_GATES1)}; pg8::gemm_phase(lds, g, L1, E); }
            { pg8::Gemm g{(const h16*)(ws + WS_YS5), (const h16*)(ws + WS_WGLU), 512, 512, 512}; EpiBranch<2> E{mg, (const h16*)(ws + WS_GATES2)}; pg8::gemm_phase(lds, g, L2, E); } }
    } break;
    case 9: { pg8::Gemm g{(const h16*)(ws + WS_MERGED), (const h16*)(ws + WS_WO), 1024, 1024, 1024}; pg8::StaticOrder S; S.init(M, 1024, F.G, F.bid);
        EpiPre E{xres, (float*)(ws + WS_PRE)}; pg8::gemm_phase(lds, g, S, E); } break;
    case 10: phase_ln(F, (const float*)(ws + WS_PRE), A.in[I_LN1G] + l * D, A.in[I_LN1B] + l * D, A.out, (h16*)(ws + WS_X1H)); break;
    case 11: { pg8::Gemm g{(const h16*)(ws + WS_X1H), (const h16*)(ws + WS_W13), 1024, 1024, 1024}; pg8::StaticOrder S; S.init(M, 5632, F.G, F.bid);
        EpiSwiGLU E{(h16*)(ws + WS_HB)}; pg8::gemm_phase(lds, g, S, E); } break;
    case 12: { pg8::Gemm g{(const h16*)(ws + WS_HB), (const h16*)(ws + WS_W2), DFF, DFF, DFF}; pg8::StaticOrder S; S.init(M, 1024, F.G, F.bid);
        EpiPre E{A.out, (float*)(ws + WS_PRE2)}; pg8::gemm_phase(lds, g, S, E); } break;
    case 13: phase_ln(F, (const float*)(ws + WS_PRE2), A.in[I_LN2G] + l * D, A.in[I_LN2B] + l * D, A.out, (h16*)(ws + WS_XH)); if (l + 1 < DEPTH) phase_convert(F, l + 1); break;
#ifdef DBG_CHUNK
    case 14: break;
#endif
    }
}
__global__ void __launch_bounds__(NTHREADS, 2) fwd(Args args) {
    extern __shared__ __attribute__((aligned(16))) unsigned char lds_raw[];
    Frame F; F.lds = (LAS unsigned char*)lds_raw; F.tid = threadIdx.x; F.lane = F.tid & 63; F.wave = __builtin_amdgcn_readfirstlane(F.tid >> 6);
    F.G = gridDim.x; F.bid = blockIdx.x; F.ws = args.ws; F.a = &args; F.rep = 0;
    volatile LAS unsigned* MISC = (volatile LAS unsigned*)(F.lds + MISC_OFF);
    if (F.tid < 32) MISC[F.tid] = 0u;
    __syncthreads();
    XcdBarrier bar; bar.bar = (unsigned*)(args.ws + WS_CTL) + CW_BAR; bar.x = 0; bar.st = nullptr;
    if (args.one_launch) bar = xcd_barrier_post((unsigned*)(args.ws + WS_CTL) + CW_BAR, MISC + 8);
    for (int ph = args.ph_lo; ph < args.ph_hi; ++ph) {
        run_phase(F, ph);
#ifdef REPEAT_MASK
        if (ph > 0 && ((REPEAT_MASK >> ((ph - 1) % 13 + 1)) & 1)) { xcd_barrier(bar); F.rep = REPEAT_MODE; run_phase(F, ph); F.rep = 0; }
#endif
        if (ph + 1 < args.ph_hi) xcd_barrier(bar);
    }
#ifdef DBG_CHUNK
    xcd_barrier(bar); dbg_emit(F);
#endif
}

#ifndef MK_ONE_LAUNCH
#define MK_ONE_LAUNCH 1
#endif
extern "C" void kernel_launch(void* const* d_in, const int* in_sizes, int n_in, void* d_out, int out_size, void* d_ws, size_t ws_size, hipStream_t stream) {
    static int grid = 0;
    if (grid == 0) {
        if (n_in != 37 || out_size != M * D || ws_size < WS_END) { fprintf(stderr, "kernel_launch: unexpected shapes n_in %d out %d ws %zu\n", n_in, out_size, ws_size); grid = -1; return; }
        int dev = 0, cus = 0, per_cu = 0;
        if (hipGetDevice(&dev) != hipSuccess || hipDeviceGetAttribute(&cus, hipDeviceAttributeMultiprocessorCount, dev) != hipSuccess) { grid = -1; return; }
        if (hipFuncSetAttribute((const void*)fwd, hipFuncAttributeMaxDynamicSharedMemorySize, LDS_BYTES) != hipSuccess) { fprintf(stderr, "kernel_launch: hipFuncSetAttribute failed\n"); grid = -1; return; }
        if (hipOccupancyMaxActiveBlocksPerMultiprocessor(&per_cu, (const void*)fwd, NTHREADS, LDS_BYTES) != hipSuccess || per_cu < 1) { fprintf(stderr, "kernel_launch: occupancy query says %d\n", per_cu); (void)hipGetLastError(); grid = -1; return; }
        grid = cus;
    }
    if (grid < 0) return;
    (void)hipMemsetAsync((char*)d_ws + WS_CTL, 0, CTL_ZERO_BYTES, stream);
    Args a{};
    for (int i = 0; i < 37; ++i) a.in[i] = (const float*)d_in[i];
    a.out = (float*)d_out; a.ws = (unsigned char*)d_ws;
    for (int i = 0; i < 16; ++i) a.invfreq[i] = (float)pow(10000.0, -(double)i / 16.0);
    a.one_launch = MK_ONE_LAUNCH;
    if (MK_ONE_LAUNCH) { a.ph_lo = 0; a.ph_hi = NPH; hipLaunchKernelGGL(fwd, dim3(grid), dim3(NTHREADS), LDS_BYTES, stream, a); }
    else for (int ph = 0; ph < NPH; ++ph) { a.ph_lo = ph; a.ph_hi = ph + 1; hipLaunchKernelGGL(fwd, dim3(grid), dim3(NTHREADS), LDS_BYTES, stream, a);
    }
}
```
